# Optimizing an MI355X kernel written in HIP

```python
import jax, jax.numpy as jnp
from jax import lax
import numpy as np

D_MODEL = 1024
BATCH = 8
SEQ = 8192
DEPTH = 2

D_MIX = D_MODEL
D_POOL = D_MIX // 2
POOL_WINDOWS = (2, 4, 8, 16)
N_POOL_GROUPS = len(POOL_WINDOWS)
POOL_GROUP = D_POOL // N_POOL_GROUPS
D_ATTN = D_MIX - D_POOL
N_HEADS = 8
HEAD_DIM = D_ATTN // N_HEADS
ROT_DIM = HEAD_DIM // 4
ROPE_THETA = 500000.0
N_IDX_HEADS = 8
IDX_DIM = 64
IDX_ROT = IDX_DIM // 4
TOPK_MAX = 256
Q_BLOCK = 128
N_KEYS = 128
N_EXPERTS = N_KEYS * N_KEYS
PEER_HEADS = 8
PEER_QDIM = 256
PEER_HALF = PEER_QDIM // 2
PEER_TOPK = 16
PEER_CHUNK = 128
EPS = 1e-6
IN_SPLITS = (D_POOL, D_ATTN, D_ATTN, D_ATTN, N_IDX_HEADS * IDX_DIM, IDX_DIM, N_IDX_HEADS)
D_IN = sum(IN_SPLITS)

kernel_name = "hybrid_pool_dsa_peer_adaln"


def rms_norm(x, g):
    xf = x.astype(jnp.float32)
    y = xf * lax.rsqrt(jnp.mean(xf * xf, axis=-1, keepdims=True) + EPS)
    return (y * g.astype(jnp.float32)).astype(x.dtype)


def rope_tables(positions, rot_dim):
    inv = ROPE_THETA ** (-jnp.arange(0, rot_dim, 2, dtype=jnp.float32) / rot_dim)
    ang = positions.astype(jnp.float32)[..., None] * inv
    return jnp.cos(ang), jnp.sin(ang)


def rope_partial(x, cos, sin):
    half = cos.shape[-1]
    rot = 2 * half
    xf = x.astype(jnp.float32)
    x1, x2, xp = xf[..., :half], xf[..., half:rot], xf[..., rot:]
    c, s = cos[:, :, None, :], sin[:, :, None, :]
    return jnp.concatenate([x1 * c - x2 * s, x1 * s + x2 * c, xp], axis=-1).astype(x.dtype)


def multiscale_pool(xp, w_pool, pool_scale):
    B, S, _ = xp.shape
    xf = xp.astype(jnp.float32).reshape(B, S, N_POOL_GROUPS, POOL_GROUP)
    cs = jnp.cumsum(xf, axis=1)
    t = jnp.arange(S)
    outs = []
    for g, w in enumerate(POOL_WINDOWS):
        cs_g = cs[:, :, g]
        lag = jnp.pad(cs_g, ((0, 0), (w, 0), (0, 0)))[:, :S]
        cnt = jnp.minimum(t + 1, w).astype(jnp.float32)[None, :, None]
        outs.append((cs_g - lag) / cnt - xf[:, :, g])
    pooled = jnp.stack(outs, axis=2).astype(xp.dtype)
    mixed = jnp.einsum('bsgc,gcd->bsgd', pooled, w_pool)
    return mixed.reshape(B, S, D_POOL) * pool_scale


def dsa_attention(q, k, v, q_idx, k_idx, w_idx, topk):
    B, S, H, hd = q.shape
    n_blocks = S // Q_BLOCK
    key_pos = jnp.arange(S)
    att_scale = HEAD_DIM ** -0.5
    kf = k_idx.astype(jnp.float32)

    def block(i):
        s0 = i * Q_BLOCK
        qb = lax.dynamic_slice_in_dim(q, s0, Q_BLOCK, axis=1)
        qib = lax.dynamic_slice_in_dim(q_idx, s0, Q_BLOCK, axis=1)
        wib = lax.dynamic_slice_in_dim(w_idx, s0, Q_BLOCK, axis=1)
        qpos = s0 + jnp.arange(Q_BLOCK)
        dots = jnp.einsum('bqhd,bsd->bqhs', qib.astype(jnp.float32), kf)
        score = jnp.einsum('bqhs,bqh->bqs', jax.nn.relu(dots), wib.astype(jnp.float32))
        causal = key_pos[None, :] <= qpos[:, None]
        score = jnp.where(causal[None], score, -jnp.inf)
        _, sel = lax.top_k(score, topk)
        kg = jax.vmap(lambda kk, ii: kk[ii])(k, sel)
        vg = jax.vmap(lambda vv, ii: vv[ii])(v, sel)
        logits = jnp.einsum('bqhd,bqkhd->bqhk', qb, kg).astype(jnp.float32) * att_scale
        valid = sel <= qpos[None, :, None]
        logits = jnp.where(valid[:, :, None, :], logits, -jnp.inf)
        p = jax.nn.softmax(logits, axis=-1).astype(v.dtype)
        return jnp.einsum('bqhk,bqkhd->bqhd', p, vg)

    out = lax.map(block, jnp.arange(n_blocks))
    return out.transpose(1, 0, 2, 3, 4).reshape(B, S, H * hd)


def peer_ffn(h, w_query, sub_keys, expert_u, expert_v):
    B, S, D = h.shape
    tokens = h.reshape(-1, PEER_CHUNK, D)

    def chunk(xc):
        T = xc.shape[0]
        q = (xc @ w_query).reshape(T, PEER_HEADS, 2, PEER_HALF)
        s = jnp.einsum('thpd,hpnd->thpn', q.astype(jnp.float32), sub_keys.astype(jnp.float32))
        sv, si = lax.top_k(s, PEER_TOPK)
        cand = (sv[:, :, 0, :, None] + sv[:, :, 1, None, :]).reshape(T, PEER_HEADS, -1)
        cand_idx = (si[:, :, 0, :, None] * N_KEYS + si[:, :, 1, None, :]).reshape(T, PEER_HEADS, -1)
        top_s, pos = lax.top_k(cand, PEER_TOPK)
        idx = jnp.take_along_axis(cand_idx, pos, axis=-1)
        g = jax.nn.softmax(top_s, axis=-1)
        u = expert_u[idx]
        v = expert_v[idx]
        a = jax.nn.gelu(jnp.einsum('td,thkd->thk', xc, u), approximate=False)
        return jnp.einsum('thk,thkd->td', (g * a).astype(v.dtype), v)

    return lax.map(chunk, tokens).reshape(B, S, D)


def setup_inputs(seed: int = 0) -> dict:
    key = jax.random.key(seed)
    ks = jax.random.split(key, 18)
    f32 = jnp.float32
    n = lambda k, shape, s: jax.random.normal(k, shape, f32) * s
    x = jax.random.normal(ks[0], (BATCH, SEQ, D_MODEL), f32)
    c = jax.random.normal(ks[1], (BATCH, D_MODEL), f32)
    offsets = jax.random.randint(ks[2], (BATCH, 1), 0, 4096, dtype=jnp.int32)
    positions = (offsets + jnp.arange(SEQ, dtype=jnp.int32)[None, :]).astype(jnp.int32)
    return {
        "x": x,
        "c": c,
        "positions": positions,
        "w_ada": n(ks[3], (DEPTH, D_MODEL, 6 * D_MODEL), 0.5 * D_MODEL ** -0.5),
        "b_ada": n(ks[4], (DEPTH, 6 * D_MODEL), 0.02),
        "norm_mix": 1.0 + n(ks[5], (DEPTH, D_MODEL), 0.02),
        "w_in": n(ks[6], (DEPTH, D_MODEL, D_IN), D_MODEL ** -0.5),
        "w_pool": n(ks[7], (DEPTH, N_POOL_GROUPS, POOL_GROUP, POOL_GROUP), POOL_GROUP ** -0.5),
        "pool_scale": 1.0 + n(ks[8], (DEPTH, D_POOL), 0.1),
        "w_out": n(ks[9], (DEPTH, D_MIX, D_MODEL), D_MIX ** -0.5),
        "norm_ffn": 1.0 + n(ks[10], (DEPTH, D_MODEL), 0.02),
        "w_query": n(ks[11], (DEPTH, D_MODEL, PEER_HEADS * PEER_QDIM), D_MODEL ** -0.5),
        "sub_keys": n(ks[12], (DEPTH, PEER_HEADS, 2, N_KEYS, PEER_HALF), PEER_HALF ** -0.5),
        "expert_u": n(ks[13], (DEPTH, N_EXPERTS, D_MODEL), D_MODEL ** -0.5),
        "expert_v": n(ks[14], (DEPTH, N_EXPERTS, D_MODEL), 0.5),
        "final_norm": 1.0 + n(ks[15], (D_MODEL,), 0.02),
    }


def reference(x, c, positions, w_ada, b_ada, norm_mix, w_in, w_pool, pool_scale, w_out,
              norm_ffn, w_query, sub_keys, expert_u, expert_v, final_norm):
    B, S, D = x.shape
    topk = min(TOPK_MAX, S // 4)
    cos, sin = rope_tables(positions, ROT_DIM)
    split_at = list(np.cumsum(IN_SPLITS)[:-1])
    for l in range(DEPTH):
        mod = (jax.nn.silu(c) @ w_ada[l] + b_ada[l])[:, None, :]
        sh1, sc1, g1, sh2, sc2, g2 = jnp.split(mod, 6, axis=-1)
        h = rms_norm(x, norm_mix[l]) * (1 + sc1) + sh1
        proj = h @ w_in[l]
        xp, q, k, v, q_idx, k_idx, w_idx = jnp.split(proj, split_at, axis=-1)
        pool_out = multiscale_pool(xp, w_pool[l], pool_scale[l])
        q = rope_partial(q.reshape(B, S, N_HEADS, HEAD_DIM), cos, sin)
        k = rope_partial(k.reshape(B, S, N_HEADS, HEAD_DIM), cos, sin)
        v = v.reshape(B, S, N_HEADS, HEAD_DIM)
        q_idx = rope_partial(q_idx.reshape(B, S, N_IDX_HEADS, IDX_DIM), cos, sin) * (IDX_DIM ** -0.5)
        k_idx = rope_partial(k_idx[:, :, None, :], cos, sin)[:, :, 0]
        w_idx = w_idx * (N_IDX_HEADS ** -0.5)
        attn_out = dsa_attention(q, k, v, q_idx, k_idx, w_idx, topk)
        mixed = jnp.concatenate([pool_out, attn_out], axis=-1)
        x = x + g1 * (mixed @ w_out[l])
        h = rms_norm(x, norm_ffn[l]) * (1 + sc2) + sh2
        x = x + g2 * peer_ffn(h, w_query[l], sub_keys[l], expert_u[l], expert_v[l])
    return rms_norm(x, final_norm)
```

```cpp
#include <hip/hip_runtime.h>
#include <stdint.h>
#include <stdio.h>

#ifndef MK_MULTI
#define MK_MULTI 0
#endif

#define LAS __attribute__((address_space(3)))
typedef unsigned short bf16_t;
typedef short bf16x8 __attribute__((ext_vector_type(8)));
typedef float f32x16 __attribute__((ext_vector_type(16)));
typedef float f32x4 __attribute__((ext_vector_type(4)));
typedef float f32x2 __attribute__((ext_vector_type(2)));
typedef unsigned u32x4 __attribute__((ext_vector_type(4)));
typedef unsigned u32x2 __attribute__((ext_vector_type(2)));
typedef __bf16 bf16v2 __attribute__((ext_vector_type(2)));
typedef LAS unsigned char* lds_t;

constexpr int D = 1024, NB = 8, S = 8192, T = NB * S, DEPTH = 2;
constexpr int NIN = 2816;
constexpr int DIN = 2632;
constexpr int NEXP = 16384;
constexpr int NTHREADS = 512;
constexpr int LDS_BYTES = 148480;

constexpr size_t MBy = 1u << 20;
constexpr size_t WS_CTL = 0;
constexpr size_t WS_MOD = 64 * 1024;
constexpr size_t WS_ROPE = 1 * MBy;
constexpr size_t WS_WIN = 5 * MBy;
constexpr size_t WS_WOUT = 16 * MBy;
constexpr size_t WS_WQ = 20 * MBy;
constexpr size_t WS_WPOOL = 28 * MBy;
constexpr size_t WS_SK = 29 * MBy;
constexpr size_t WS_EU = 30 * MBy;
constexpr size_t WS_EV = 94 * MBy;
constexpr size_t WS_H = 158 * MBy;
constexpr size_t WS_XP = 286 * MBy;
constexpr size_t WS_Q = 350 * MBy;
constexpr size_t WS_K = 414 * MBy;
constexpr size_t WS_VT = 478 * MBy;
constexpr size_t WS_QP = WS_XP;
constexpr size_t WS_QI = 542 * MBy;
constexpr size_t WS_KI = 606 * MBy;
constexpr size_t WS_WI = 614 * MBy;
constexpr size_t WS_MASK = 616 * MBy;
constexpr size_t WS_PIDX = 680 * MBy;
constexpr size_t WS_PG = 712 * MBy;
constexpr size_t WS_END = 744 * MBy;
constexpr int NPH = 20;

struct Params {
    const float *x, *c; const int* pos;
    const float *w_ada, *b_ada, *norm_mix, *w_in, *w_pool, *pool_scale, *w_out, *norm_ffn, *w_query, *sub_keys, *expert_u, *expert_v, *final_norm;
    float* out; unsigned char* ws; int ph_lo, ph_hi;
};

#define XB_TMO      128
#define XB_XCNT(j)  (256  + 64 * (j))
#define XB_XSUB(j)  (1280 + 64 * (j))
#define XB_XGEN(j)  (2304 + 64 * (j))
#define XB_TOP      3328
#define XB_TOPGEN   3392
#define XCD_BAR_WORDS 3456
#define XB_SPIN_CAP (1u << 22)

__device__ __forceinline__ unsigned xb_ld(unsigned* p)              { return __hip_atomic_load(p, __ATOMIC_RELAXED, __HIP_MEMORY_SCOPE_AGENT); }
__device__ __forceinline__ unsigned xb_add(unsigned* p, unsigned v) { return __hip_atomic_fetch_add(p, v, __ATOMIC_RELAXED, __HIP_MEMORY_SCOPE_AGENT); }
__device__ __forceinline__ unsigned xb_xcc_id() { return (unsigned)__builtin_amdgcn_s_getreg((3 << 11) | 20) & 0xFu; }
#define XB_SPIN(cond, bar) do { unsigned _sp = 0; while (cond) { __builtin_amdgcn_s_sleep(1); \
    if ((++_sp & 255u) == 0u) { if (xb_ld(&(bar)[XB_TMO])) break; if (_sp > XB_SPIN_CAP) { atomicAdd(&(bar)[XB_TMO], 1u); break; } } } } while (0)

struct XcdBarrier { unsigned* bar; unsigned x; volatile LAS unsigned* st; };

__device__ __forceinline__ XcdBarrier xcd_barrier_post(unsigned* bar, volatile LAS unsigned* st) {
    XcdBarrier b; b.bar = bar; b.x = xb_xcc_id(); b.st = st;
    if (threadIdx.x == 0) (void)xb_add(&bar[XB_XCNT(b.x)], 1u);
    return b;
}
__device__ __forceinline__ void xcd_barrier_complete(unsigned* bar, unsigned x, unsigned& nloc, unsigned& nx) {
    const unsigned G = gridDim.x * gridDim.y * gridDim.z;
    unsigned sum, cnt, mine, sp = 0u;
    for (;;) {
        sum = 0u; cnt = 0u; mine = 0u;
#pragma unroll
        for (unsigned j = 0; j < 16; ++j) { const unsigned c = xb_ld(&bar[XB_XCNT(j)]); sum += c; cnt += (c > 0u) ? 1u : 0u; mine = (j == x) ? c : mine; }
        if (sum == G) break;
        __builtin_amdgcn_s_sleep(1);
        if ((++sp & 255u) == 0u) { if (xb_ld(&bar[XB_TMO])) break; if (sp > XB_SPIN_CAP) { atomicAdd(&bar[XB_TMO], 1u); break; } }
    }
    nloc = mine > 0u ? mine : 1u; nx = cnt > 0u ? cnt : 1u;
}
__device__ __forceinline__ void xcd_barrier(const XcdBarrier& b) {
    asm volatile("s_waitcnt vmcnt(0)" ::: "memory");
    __syncthreads();
    if (threadIdx.x == 0) {
        unsigned* bar = b.bar;
        __builtin_amdgcn_s_waitcnt(0);
        unsigned nloc = b.st[0], nx = b.st[1];
        if (nloc == 0u) { xcd_barrier_complete(bar, b.x, nloc, nx); b.st[0] = nloc; b.st[1] = nx; }
        const unsigned old = xb_add(&bar[XB_XSUB(b.x)], 1u);
        const unsigned gen = old / nloc;
        if (old + 1u == (gen + 1u) * nloc) {
            __builtin_amdgcn_fence(__ATOMIC_RELEASE, "agent");
            asm volatile("s_waitcnt vmcnt(0)" ::: "memory");
            const unsigned og = xb_add(&bar[XB_TOP], 1u);
            const unsigned tg = og / nx;
            if (og + 1u == (tg + 1u) * nx) xb_add(&bar[XB_TOPGEN], 1u);
            else XB_SPIN(xb_ld(&bar[XB_TOPGEN]) == tg, bar);
            __builtin_amdgcn_fence(__ATOMIC_ACQUIRE, "agent");
            xb_add(&bar[XB_XGEN(b.x)], 1u);
            asm volatile("s_waitcnt vmcnt(0)" ::: "memory");
        } else {
            XB_SPIN(xb_ld(&bar[XB_XGEN(b.x)]) == gen, bar);
            __builtin_amdgcn_fence(__ATOMIC_ACQUIRE, "agent");
            asm volatile("s_waitcnt vmcnt(0)" ::: "memory");
        }
    }
    __syncthreads();
}

#define MFMA32(a, b, c) __builtin_amdgcn_mfma_f32_32x32x16_bf16((a), (b), (c), 0, 0, 0)
__device__ __forceinline__ unsigned pk_bf16(float lo, float hi) { const f32x2 v = {lo, hi}; return __builtin_bit_cast(unsigned, __builtin_convertvector(v, bf16v2)); }
__device__ __forceinline__ float dot2bf(unsigned a, unsigned b, float c) { return __builtin_amdgcn_fdot2_f32_bf16(__builtin_bit_cast(bf16v2, a), __builtin_bit_cast(bf16v2, b), c, false); }
__device__ __forceinline__ float bf_lo(unsigned u) { return __uint_as_float(u << 16); }
__device__ __forceinline__ float bf_hi(unsigned u) { return __uint_as_float(u & 0xffff0000u); }
__device__ __forceinline__ float wave_sum(float v) {
#pragma unroll
    for (int o = 32; o > 0; o >>= 1) v += __shfl_xor(v, o);
    return v;
}
__device__ __forceinline__ int otid() { int t = threadIdx.x; asm volatile("" : "+v"(t)); return t; }
__device__ __forceinline__ void lds_fence() { asm volatile("s_waitcnt lgkmcnt(0)" ::: "memory"); }

__device__ __forceinline__ void transpose_tile(const float* __restrict__ src, int ldsrc, int Nvalid, bf16_t* __restrict__ dst, int lddst, int k0, int n0, lds_t lds) {
    LAS float* tile = (LAS float*)lds;
    const int tid = otid();
    {
        const int r = tid >> 6, c = tid & 63, n = n0 + c;
#pragma unroll
        for (int i = 0; i < 8; ++i) { const int k = r + 8 * i; tile[k * 65 + c] = (n < Nvalid) ? src[(size_t)(k0 + k) * ldsrc + n] : 0.f; }
    }
    __syncthreads();
    {
        const int nn = tid >> 3, kc = tid & 7;
        float v[8];
#pragma unroll
        for (int j = 0; j < 8; ++j) v[j] = tile[(kc * 8 + j) * 65 + nn];
        u32x4 w; w.x = pk_bf16(v[0], v[1]); w.y = pk_bf16(v[2], v[3]); w.z = pk_bf16(v[4], v[5]); w.w = pk_bf16(v[6], v[7]);
        *(u32x4*)(dst + (size_t)(n0 + nn) * lddst + k0 + kc * 8) = w;
    }
    __syncthreads();
}

__device__ __forceinline__ void convert_bf16(const float* __restrict__ src, bf16_t* __restrict__ dst, size_t n8) {
    const size_t stride = (size_t)gridDim.x * NTHREADS;
    for (size_t i = (size_t)blockIdx.x * NTHREADS + otid(); i < n8; i += stride) {
        const f32x4 a = *(const f32x4*)(src + i * 8), b = *(const f32x4*)(src + i * 8 + 4);
        u32x4 w; w.x = pk_bf16(a[0], a[1]); w.y = pk_bf16(a[2], a[3]); w.z = pk_bf16(b[0], b[1]); w.w = pk_bf16(b[2], b[3]);
        *(u32x4*)(dst + i * 8) = w;
    }
}

__device__ __forceinline__ void sincos_d(double a, float& sn, float& cs) {
    const double kq = rint(a * 0.63661977236758134308);
    double r = fma(-kq, 1.57079632679489655800e+00, a);
    r = fma(-kq, 6.12323399573676603587e-17, r);
    const int q = ((int)kq) & 3;
    const double r2 = r * r;
    double sp = -7.647163731819816476e-13;
    sp = fma(sp, r2, 1.605904383682161460e-10);
    sp = fma(sp, r2, -2.505210838544171878e-08);
    sp = fma(sp, r2, 2.755731922398589065e-06);
    sp = fma(sp, r2, -1.984126984126984127e-04);
    sp = fma(sp, r2, 8.333333333333333333e-03);
    sp = fma(sp, r2, -1.666666666666666667e-01);
    const double s = fma(sp * r2, r, r);
    double cp = 4.779477332387385297e-14;
    cp = fma(cp, r2, -1.147074559772972471e-11);
    cp = fma(cp, r2, 2.087675698786809898e-09);
    cp = fma(cp, r2, -2.755731922398589065e-07);
    cp = fma(cp, r2, 2.480158730158730159e-05);
    cp = fma(cp, r2, -1.388888888888888889e-03);
    cp = fma(cp, r2, 4.166666666666666667e-02);
    cp = fma(cp, r2, -0.5);
    const double c = fma(cp, r2, 1.0);
    const double ss = (q & 1) ? c : s, cc = (q & 1) ? s : c;
    sn = (float)((q & 2) ? -ss : ss);
    cs = (float)(((q + 1) & 2) ? -cc : cc);
}

__device__ __forceinline__ void phase_prologue(const Params& p, lds_t lds) {
    const int tid = otid(), bid = blockIdx.x, G = gridDim.x;
    unsigned char* ws = p.ws;
    {
        const int J_IN = 16 * 44, J_OUT = 16 * 16, J_Q = 16 * 32, J_P = 4;
        const int total = 2 * (J_IN + J_OUT + J_Q) + 8 * J_P;
        for (int j = bid; j < total; j += G) {
            int r = j;
            if (r < 2 * J_IN) { const int l = r / J_IN, t = r % J_IN; transpose_tile(p.w_in + (size_t)l * D * DIN, DIN, DIN, (bf16_t*)(ws + WS_WIN) + (size_t)l * NIN * D, D, (t / 44) * 64, (t % 44) * 64, lds); continue; }
            r -= 2 * J_IN;
            if (r < 2 * J_OUT) { const int l = r / J_OUT, t = r % J_OUT; transpose_tile(p.w_out + (size_t)l * D * D, D, D, (bf16_t*)(ws + WS_WOUT) + (size_t)l * D * D, D, (t / 16) * 64, (t % 16) * 64, lds); continue; }
            r -= 2 * J_OUT;
            if (r < 2 * J_Q) { const int l = r / J_Q, t = r % J_Q; transpose_tile(p.w_query + (size_t)l * D * 2048, 2048, 2048, (bf16_t*)(ws + WS_WQ) + (size_t)l * 2048 * D, D, (t / 32) * 64, (t % 32) * 64, lds); continue; }
            r -= 2 * J_Q;
            { const int m = r / J_P, t = r % J_P; transpose_tile(p.w_pool + (size_t)m * 128 * 128, 128, 128, (bf16_t*)(ws + WS_WPOOL) + (size_t)m * 128 * 128, 128, (t / 2) * 64, (t % 2) * 64, lds); }
        }
    }
    convert_bf16(p.expert_u, (bf16_t*)(ws + WS_EU), (size_t)DEPTH * NEXP * D / 8);
    convert_bf16(p.expert_v, (bf16_t*)(ws + WS_EV), (size_t)DEPTH * NEXP * D / 8);
    convert_bf16(p.sub_keys, (bf16_t*)(ws + WS_SK), (size_t)DEPTH * 16 * 128 * 128 / 8);
    {
        LAS float* sc = (LAS float*)lds;
        LAS float* part = (LAS float*)(lds + 32768);
        for (int i = tid; i < NB * D; i += NTHREADS) { const float v = p.c[i]; sc[i] = v / (1.f + __expf(-v)); }
        __syncthreads();
        const int lane = tid & 63, wid = tid >> 6;
        for (int j = bid; j < DEPTH * 96; j += G) {
            const int l = j / 96, col = (j % 96) * 64 + lane;
            const float* wp = p.w_ada + (size_t)l * D * 6144 + col;
            float a[8] = {0.f, 0.f, 0.f, 0.f, 0.f, 0.f, 0.f, 0.f};
            for (int k = wid * 128; k < wid * 128 + 128; ++k) {
                const float w = wp[(size_t)k * 6144];
#pragma unroll
                for (int b = 0; b < 8; ++b) a[b] = fmaf(sc[b * D + k], w, a[b]);
            }
#pragma unroll
            for (int b = 0; b < 8; ++b) part[(wid * 8 + b) * 64 + lane] = a[b];
            __syncthreads();
            {
                const int b = tid >> 6;
                float s = 0.f;
#pragma unroll
                for (int w = 0; w < 8; ++w) s += part[(w * 8 + b) * 64 + lane];
                ((float*)(ws + WS_MOD))[((size_t)l * NB + b) * 6144 + col] = s + p.b_ada[(size_t)l * 6144 + col];
            }
            __syncthreads();
        }
    }
    {
        const float inv[8] = {1.0f, 0.1939227432012558f, 0.03760603070259094f, 0.007292664609849453f, 0.0014142135623842478f, 0.00027424818836152554f, 5.318296098266728e-05f, 1.0313386155758053e-05f};
        const size_t stride = (size_t)G * NTHREADS;
        for (size_t i = (size_t)bid * NTHREADS + tid; i < (size_t)T * 8; i += stride) {
            const int t = (int)(i >> 3), f = (int)(i & 7);
            float iv = inv[0];
#pragma unroll
            for (int q = 1; q < 8; ++q) iv = (f == q) ? inv[q] : iv;
            const float ang = (float)p.pos[t] * iv;
            float sn, cs; sincos_d((double)ang, sn, cs);
            float* rp = (float*)(ws + WS_ROPE) + (size_t)t * 16;
            rp[f] = cs; rp[8 + f] = sn;
        }
    }
}

template <int MODE>
__device__ __forceinline__ void phase_norm(const float* xin, const float* __restrict__ gw, const float* __restrict__ sh, const float* __restrict__ scl, bf16_t* hout, float* fout) {
    const int tid = otid(), lane = tid & 63, wid = tid >> 6;
    const int nw = gridDim.x * 8;
    for (int gwv = blockIdx.x * 8 + wid; gwv * 32 < T; gwv += nw) {
        const int row0 = gwv * 32, b = row0 / S;
        f32x4 g4[4], a4[4], s4[4];
#pragma unroll
        for (int i = 0; i < 4; ++i) {
            const int col = 4 * lane + 256 * i;
            g4[i] = *(const f32x4*)(gw + col);
            if (MODE == 0) { a4[i] = *(const f32x4*)(scl + (size_t)b * 6144 + col) + 1.0f; s4[i] = *(const f32x4*)(sh + (size_t)b * 6144 + col); }
        }
        for (int r = 0; r < 32; ++r) {
            const float* xr = xin + (size_t)(row0 + r) * D;
            f32x4 v[4]; float ss = 0.f;
#pragma unroll
            for (int i = 0; i < 4; ++i) { v[i] = *(const f32x4*)(xr + 4 * lane + 256 * i); ss += v[i][0] * v[i][0] + v[i][1] * v[i][1] + v[i][2] * v[i][2] + v[i][3] * v[i][3]; }
            ss = wave_sum(ss);
            const float rstd = rsqrtf(ss * (1.0f / D) + 1e-6f);
#pragma unroll
            for (int i = 0; i < 4; ++i) {
                f32x4 y = v[i] * rstd * g4[i];
                if (MODE == 0) {
                    y = y * a4[i] + s4[i];
                    u32x2 w; w.x = pk_bf16(y[0], y[1]); w.y = pk_bf16(y[2], y[3]);
                    *(u32x2*)(hout + (size_t)(row0 + r) * D + 4 * lane + 256 * i) = w;
                } else {
                    *(f32x4*)(fout + (size_t)(row0 + r) * D + 4 * lane + 256 * i) = y;
                }
            }
        }
    }
}
constexpr int GROW = 144;
constexpr int GTILE = 256 * GROW;

__device__ __forceinline__ bool tile_order(int i, int N, int& pm, int& pn) {
    const int nM = T / 256, nN = N / 256, nwg = nM * nN, G = gridDim.x;
    const long L = (long)i * G + blockIdx.x; if (L >= nwg) return false;
    int wgid = (int)L; { const int q = nwg / 8, r = nwg % 8, xcd = wgid % 8, off = wgid / 8; wgid = (xcd < r ? xcd * (q + 1) : r * (q + 1) + (xcd - r) * q) + off; }
    const int nig = 8 * nN, gid = wgid / nig, fm = gid * 8, gsz = (nM - fm) < 8 ? (nM - fm) : 8;
    pm = fm + ((wgid % nig) % gsz); pn = (wgid % nig) / gsz; return true;
}

template <class Epi>
__device__ __forceinline__ void gemm_phase(const bf16_t* __restrict__ A, const bf16_t* __restrict__ Wt, int N, const Epi& epi, lds_t lds) {
    const int tid = otid(), lane = tid & 63, wid = tid >> 6;
    const int wr = wid >> 2, wc = wid & 3, l31 = lane & 31, hh = lane >> 5;
    const int srow = tid >> 3, scc = tid & 7;
    int pm, pn;
    for (int it = 0; tile_order(it, N, pm, pn); ++it) {
        const bf16_t* Ag = A + (size_t)(pm * 256 + srow) * D + scc * 8;
        const bf16_t* Wg = Wt + (size_t)(pn * 256 + srow) * D + scc * 8;
        f32x16 acc[2][4];
#pragma unroll
        for (int a = 0; a < 2; ++a)
#pragma unroll
            for (int b = 0; b < 4; ++b)
#pragma unroll
                for (int r = 0; r < 16; ++r) acc[a][b][r] = 0.f;
        u32x4 ra[4], rw[4];
#pragma unroll
        for (int i = 0; i < 4; ++i) { ra[i] = *(const u32x4*)(Ag + (size_t)i * 64 * D); rw[i] = *(const u32x4*)(Wg + (size_t)i * 64 * D); }
#pragma unroll
        for (int i = 0; i < 4; ++i) { *(LAS u32x4*)(lds + (srow + 64 * i) * GROW + scc * 16) = ra[i]; *(LAS u32x4*)(lds + GTILE + (srow + 64 * i) * GROW + scc * 16) = rw[i]; }
        __syncthreads();
        for (int kt = 0; kt < 16; ++kt) {
            if (kt < 15) {
#pragma unroll
                for (int i = 0; i < 4; ++i) { ra[i] = *(const u32x4*)(Ag + (size_t)i * 64 * D + (kt + 1) * 64); rw[i] = *(const u32x4*)(Wg + (size_t)i * 64 * D + (kt + 1) * 64); }
            }
            const lds_t sb = lds + (kt & 1) * 2 * GTILE;
#pragma unroll
            for (int ks = 0; ks < 4; ++ks) {
                bf16x8 af[4], wf[2];
#pragma unroll
                for (int tt = 0; tt < 4; ++tt) af[tt] = *(LAS bf16x8*)(sb + (wr * 128 + tt * 32 + l31) * GROW + (ks * 2 + hh) * 16);
#pragma unroll
                for (int nt = 0; nt < 2; ++nt) wf[nt] = *(LAS bf16x8*)(sb + GTILE + (wc * 64 + nt * 32 + l31) * GROW + (ks * 2 + hh) * 16);
#pragma unroll
                for (int nt = 0; nt < 2; ++nt)
#pragma unroll
                    for (int tt = 0; tt < 4; ++tt) acc[nt][tt] = MFMA32(wf[nt], af[tt], acc[nt][tt]);
            }
            if (kt < 15) {
                const lds_t nb = lds + ((kt + 1) & 1) * 2 * GTILE;
#pragma unroll
                for (int i = 0; i < 4; ++i) { *(LAS u32x4*)(nb + (srow + 64 * i) * GROW + scc * 16) = ra[i]; *(LAS u32x4*)(nb + GTILE + (srow + 64 * i) * GROW + scc * 16) = rw[i]; }
            }
            __syncthreads();
        }
        epi(acc, pm, pn, wr, wc, l31, hh);
    }
}

struct EpiIn {
    bf16_t *xp, *q, *k, *vt, *qi, *ki; float* wi; const float* rope;
    __device__ __forceinline__ void operator()(const f32x16 (&acc)[2][4], int pm, int pn, int wr, int wc, int l31, int hh) const {
        const int seg = pn >> 1;
        const int cb = (pn & 1) * 256 + wc * 64;
#pragma unroll
        for (int tt = 0; tt < 4; ++tt) {
            const int t = pm * 256 + wr * 128 + tt * 32 + l31;
            if (seg == 0) {
#pragma unroll
                for (int nt = 0; nt < 2; ++nt)
#pragma unroll
                    for (int rq = 0; rq < 4; ++rq) {
                        u32x2 w; w.x = pk_bf16(acc[nt][tt][4 * rq], acc[nt][tt][4 * rq + 1]); w.y = pk_bf16(acc[nt][tt][4 * rq + 2], acc[nt][tt][4 * rq + 3]);
                        *(u32x2*)(xp + (size_t)t * 512 + cb + nt * 32 + 8 * rq + 4 * hh) = w;
                    }
            } else if (seg == 3) {
                const int b = t / S, s = t % S, head = cb >> 6;
                bf16_t* vb = vt + ((size_t)(b * 8 + head) * 64) * S + s;
#pragma unroll
                for (int nt = 0; nt < 2; ++nt)
#pragma unroll
                    for (int r = 0; r < 16; ++r) {
                        const int d = nt * 32 + (r & 3) + 8 * (r >> 2) + 4 * hh;
                        vb[(size_t)d * S] = (bf16_t)(pk_bf16(acc[nt][tt][r], 0.f) & 0xffffu);
                    }
            } else if (seg == 1 || seg == 2 || seg == 4 || (seg == 5 && wc == 0)) {
                const f32x4 cs = *(const f32x4*)(rope + (size_t)t * 16 + 4 * hh), sn = *(const f32x4*)(rope + (size_t)t * 16 + 8 + 4 * hh);
                const float scale = (seg == 1 || seg == 4) ? 0.125f : 1.0f;
                bf16_t* dst; size_t off;
                if (seg == 1) { dst = q; off = (size_t)t * 512 + cb; } else if (seg == 2) { dst = k; off = (size_t)t * 512 + cb; } else if (seg == 4) { dst = qi; off = (size_t)t * 512 + cb; } else { dst = ki; off = (size_t)t * 64; }
                float v0[16];
#pragma unroll
                for (int r = 0; r < 16; ++r) v0[r] = acc[0][tt][r];
#pragma unroll
                for (int j = 0; j < 4; ++j) { const float x1 = acc[0][tt][j], x2 = acc[0][tt][4 + j]; v0[j] = x1 * cs[j] - x2 * sn[j]; v0[4 + j] = x1 * sn[j] + x2 * cs[j]; }
#pragma unroll
                for (int rq = 0; rq < 4; ++rq) {
                    u32x2 w; w.x = pk_bf16(v0[4 * rq] * scale, v0[4 * rq + 1] * scale); w.y = pk_bf16(v0[4 * rq + 2] * scale, v0[4 * rq + 3] * scale);
                    *(u32x2*)(dst + off + 8 * rq + 4 * hh) = w;
                    u32x2 w2; w2.x = pk_bf16(acc[1][tt][4 * rq] * scale, acc[1][tt][4 * rq + 1] * scale); w2.y = pk_bf16(acc[1][tt][4 * rq + 2] * scale, acc[1][tt][4 * rq + 3] * scale);
                    *(u32x2*)(dst + off + 32 + 8 * rq + 4 * hh) = w2;
                }
            } else if (seg == 5 && wc == 1) {
                f32x4 w;
#pragma unroll
                for (int j = 0; j < 4; ++j) w[j] = acc[0][tt][j] * 0.35355339059327373f;
                *(f32x4*)(wi + (size_t)t * 8 + 4 * hh) = w;
            }
        }
    }
};

struct EpiOut {
    const float* xin; float* xout; const float* gate;
    __device__ __forceinline__ void operator()(const f32x16 (&acc)[2][4], int pm, int pn, int wr, int wc, int l31, int hh) const {
        const int b = (pm * 256) / S;
#pragma unroll
        for (int nt = 0; nt < 2; ++nt)
#pragma unroll
            for (int rq = 0; rq < 4; ++rq) {
                const int n0 = pn * 256 + wc * 64 + nt * 32 + 8 * rq + 4 * hh;
                const f32x4 g = *(const f32x4*)(gate + (size_t)b * 6144 + n0);
#pragma unroll
                for (int tt = 0; tt < 4; ++tt) {
                    const int t = pm * 256 + wr * 128 + tt * 32 + l31;
                    const f32x4 xo = *(const f32x4*)(xin + (size_t)t * D + n0);
                    f32x4 a; a[0] = acc[nt][tt][4 * rq]; a[1] = acc[nt][tt][4 * rq + 1]; a[2] = acc[nt][tt][4 * rq + 2]; a[3] = acc[nt][tt][4 * rq + 3];
                    *(f32x4*)(xout + (size_t)t * D + n0) = xo + g * a;
                }
            }
    }
};

struct EpiBf {
    bf16_t* C; int ldc;
    __device__ __forceinline__ void operator()(const f32x16 (&acc)[2][4], int pm, int pn, int wr, int wc, int l31, int hh) const {
#pragma unroll
        for (int tt = 0; tt < 4; ++tt) {
            const int t = pm * 256 + wr * 128 + tt * 32 + l31;
#pragma unroll
            for (int nt = 0; nt < 2; ++nt)
#pragma unroll
                for (int rq = 0; rq < 4; ++rq) {
                    u32x2 w; w.x = pk_bf16(acc[nt][tt][4 * rq], acc[nt][tt][4 * rq + 1]); w.y = pk_bf16(acc[nt][tt][4 * rq + 2], acc[nt][tt][4 * rq + 3]);
                    *(u32x2*)(C + (size_t)t * ldc + pn * 256 + wc * 64 + nt * 32 + 8 * rq + 4 * hh) = w;
                }
        }
    }
};

__device__ __forceinline__ void pool_item(int e, const bf16_t* __restrict__ xp, const bf16_t* __restrict__ wpool  , const float* __restrict__ pscale  , bf16_t* __restrict__ mixed, lds_t lds) {
    const int tid = otid(), lane = tid & 63, wid = tid >> 6, l31 = lane & 31, hh = lane >> 5;
    const int g = e & 3, tile = e >> 2;
    const int t0 = tile * 128, s0 = t0 % S;
    lds_t xs = lds;
    lds_t ps = lds + 144 * 256;
    for (int c = tid; c < 144 * 16; c += NTHREADS) {
        const int r = c >> 4, cc = c & 15;
        u32x4 v = {0u, 0u, 0u, 0u};
        if (s0 - 16 + r >= 0) v = *(const u32x4*)(xp + (size_t)(t0 - 16 + r) * 512 + g * 128 + cc * 8);
        *(LAS u32x4*)(xs + r * 256 + cc * 16) = v;
    }
    __syncthreads();
    {
        const int c = tid & 127, tq = tid >> 7, w = 2 << g;
        for (int tl = tq * 32; tl < tq * 32 + 32; ++tl) {
            const int s = s0 + tl;
            float sum = 0.f;
            for (int j = 0; j < w; ++j) sum += __uint_as_float((unsigned)(*(LAS bf16_t*)(xs + (16 + tl - j) * 256 + c * 2)) << 16);
            const float xc = __uint_as_float((unsigned)(*(LAS bf16_t*)(xs + (16 + tl) * 256 + c * 2)) << 16);
            const float cnt = (float)((s + 1 < w) ? (s + 1) : w);
            const float pooled = sum / cnt - xc;
            *(LAS bf16_t*)(ps + tl * 272 + c * 2) = (bf16_t)(pk_bf16(pooled, 0.f) & 0xffffu);
        }
    }
    __syncthreads();
    {
        const int dt = wid & 3, tb = (wid >> 2) * 2;
        f32x16 acc[2];
#pragma unroll
        for (int a = 0; a < 2; ++a)
#pragma unroll
            for (int r = 0; r < 16; ++r) acc[a][r] = 0.f;
        const bf16_t* wg = wpool + (size_t)g * 128 * 128 + (size_t)(dt * 32 + l31) * 128 + 8 * hh;
#pragma unroll
        for (int ks = 0; ks < 8; ++ks) {
            const bf16x8 wf = *(const bf16x8*)(wg + ks * 16);
#pragma unroll
            for (int a = 0; a < 2; ++a) {
                const bf16x8 pf = *(LAS bf16x8*)(ps + ((tb + a) * 32 + l31) * 272 + (ks * 2 + hh) * 16);
                acc[a] = MFMA32(wf, pf, acc[a]);
            }
        }
#pragma unroll
        for (int a = 0; a < 2; ++a) {
            const int t = t0 + (tb + a) * 32 + l31;
#pragma unroll
            for (int rq = 0; rq < 4; ++rq) {
                const int d = dt * 32 + 8 * rq + 4 * hh;
                const f32x4 sc = *(const f32x4*)(pscale + g * 128 + d);
                u32x2 w; w.x = pk_bf16(acc[a][4 * rq] * sc[0], acc[a][4 * rq + 1] * sc[1]); w.y = pk_bf16(acc[a][4 * rq + 2] * sc[2], acc[a][4 * rq + 3] * sc[3]);
                *(u32x2*)(mixed + (size_t)t * D + g * 128 + d) = w;
            }
        }
    }
    __syncthreads();
}
constexpr int TK_CAP = 512, TK_TRIG = 480;
constexpr int TK_CS = 0;
constexpr int TK_CI = 65536;
constexpr int TK_KST = 98304;
constexpr int TK_HIST = 116736;
constexpr int TK_MROW = 124928;

__device__ __forceinline__ unsigned f2key(float s) { const unsigned b = __float_as_uint(s); return b ^ ((b >> 31) ? 0xffffffffu : 0x80000000u); }
__device__ __forceinline__ float key2f(unsigned k) { return __uint_as_float((k & 0x80000000u) ? (k ^ 0x80000000u) : ~k); }
__device__ __forceinline__ int bcount(bool p) { return __builtin_popcountll(__ballot(p)); }

__device__ __forceinline__ float prune256(LAS float* csq, LAS bf16_t* ciq, int n, LAS unsigned* hist, int lane) {
    unsigned key[8], idx[8];
#pragma unroll
    for (int e = 0; e < 8; ++e) {
        const int i = lane + 64 * e; const bool v = i < n;
        key[e] = v ? f2key(csq[i]) : 0u; idx[e] = v ? (unsigned)ciq[i] : 0xffffu;
    }
    unsigned prefix = 0u; int need = 256;
#pragma unroll
    for (int pass = 3; pass >= 0; --pass) {
        const int sh = pass * 8;
        *(LAS u32x4*)(hist + lane * 4) = (u32x4){0u, 0u, 0u, 0u};
        lds_fence();
#pragma unroll
        for (int e = 0; e < 8; ++e) {
            const bool act = (key[e] != 0u) && (pass == 3 || (key[e] >> (sh + 8)) == (prefix >> (sh + 8)));
            if (act) __hip_atomic_fetch_add(hist + ((key[e] >> sh) & 255u), 1u, __ATOMIC_RELAXED, __HIP_MEMORY_SCOPE_WORKGROUP);
        }
        lds_fence();
        const u32x4 hb = *(LAS u32x4*)(hist + lane * 4);
        const unsigned s = hb.x + hb.y + hb.z + hb.w;
        unsigned suf = s;
#pragma unroll
        for (int d = 1; d < 64; d <<= 1) { const unsigned o = __shfl_down(suf, d); if (lane + d < 64) suf += o; }
        const unsigned long long bm = __ballot(suf >= (unsigned)need);
        const int Ls = 63 - __builtin_clzll(bm | 1ull);
        const unsigned above = __shfl(suf - s, Ls);
        const unsigned b0 = __shfl(hb.x, Ls), b1 = __shfl(hb.y, Ls), b2 = __shfl(hb.z, Ls), b3 = __shfl(hb.w, Ls);
        unsigned c = above; int bin;
        if (c + b3 >= (unsigned)need) bin = 3;
        else { c += b3; if (c + b2 >= (unsigned)need) bin = 2; else { c += b2; if (c + b1 >= (unsigned)need) bin = 1; else { c += b1; bin = 0; } } }
        (void)b0;
        need -= (int)c;
        prefix |= (unsigned)(Ls * 4 + bin) << sh;
    }
    int eq = 0;
#pragma unroll
    for (int e = 0; e < 8; ++e) eq += bcount(key[e] == prefix);
    unsigned ithr = 0xffffu;
    if (eq > need) {
        unsigned lo = 0u;
        for (int bit = 12; bit >= 0; --bit) {
            const unsigned mid = lo + (1u << bit);
            int c = 0;
#pragma unroll
            for (int e = 0; e < 8; ++e) c += bcount(key[e] == prefix && idx[e] < mid);
            if (c < need) lo = mid;
        }
        ithr = lo;
    }
    int base = 0;
#pragma unroll
    for (int e = 0; e < 8; ++e) {
        const bool keep = (key[e] > prefix) || (key[e] == prefix && idx[e] <= ithr);
        const unsigned long long m = __ballot(keep);
        const int pos = base + (int)__builtin_amdgcn_mbcnt_hi((unsigned)(m >> 32), __builtin_amdgcn_mbcnt_lo((unsigned)m, 0u));
        if (keep) { csq[pos] = key2f(key[e]); ciq[pos] = (bf16_t)idx[e]; }
        base += __builtin_popcountll(m);
    }
    lds_fence();
    return key2f(prefix);
}

__device__ __forceinline__ void topk_item(int e, const bf16_t* __restrict__ QI, const bf16_t* __restrict__ KI, const float* __restrict__ WI, unsigned* __restrict__ MASK, lds_t lds) {
    const int tid = otid(), lane = tid & 63, wid = tid >> 6, l31 = lane & 31, hh = lane >> 5;
    const int r8 = e >> 8, c = e & 255, b = c >> 5, j = c & 31;
    const int qb = (r8 < 4) ? (j + 32 * r8) : (255 - (j + 32 * (r8 - 4)));
    const int t0 = qb * 32, tq0 = t0 + 4 * wid;
    const size_t tokb = (size_t)b * S;
    bf16x8 qf[4];
    {
        const int i = l31, qi_ = 2 * ((i >> 2) & 1) + (i >> 4), hd = (i & 3) + 4 * ((i >> 3) & 1);
        const bf16_t* qp = QI + (tokb + tq0 + qi_) * 512 + hd * 64 + 8 * hh;
#pragma unroll
        for (int ks = 0; ks < 4; ++ks) qf[ks] = *(const bf16x8*)(qp + ks * 16);
    }
    float wv[2][8];
#pragma unroll
    for (int a = 0; a < 2; ++a) {
        const f32x4 w0 = *(const f32x4*)(WI + (tokb + tq0 + 2 * hh + a) * 8), w1 = *(const f32x4*)(WI + (tokb + tq0 + 2 * hh + a) * 8 + 4);
#pragma unroll
        for (int q = 0; q < 4; ++q) { wv[a][q] = w0[q]; wv[a][4 + q] = w1[q]; }
    }
    float tau[2] = {-INFINITY, -INFINITY};
    int cnt[4] = {0, 0, 0, 0};
    LAS float* cs = (LAS float*)(lds + TK_CS) + (wid * 4) * TK_CAP;
    LAS bf16_t* ci = (LAS bf16_t*)(lds + TK_CI) + (wid * 4) * TK_CAP;
    LAS unsigned* hist = (LAS unsigned*)(lds + TK_HIST) + wid * 256;
    const int ntiles = qb + 1, nch = (ntiles + 1) >> 1;
    const int srow = tid >> 3, scc = tid & 7;
    const bf16_t* kg = KI + (tokb + srow) * 64 + scc * 8;
    u32x4 kr = *(const u32x4*)kg;
    *(LAS u32x4*)(lds + TK_KST + srow * GROW + scc * 16) = kr;
    __syncthreads();
    for (int ch = 0; ch < nch; ++ch) {
        if (ch + 1 < nch) kr = *(const u32x4*)(kg + (size_t)(ch + 1) * 64 * 64);
        const lds_t kb = lds + TK_KST + (ch & 1) * (64 * GROW);
#pragma unroll
        for (int tl = 0; tl < 2; ++tl) {
            const int tile = 2 * ch + tl;
            if (tile < ntiles) {
                f32x16 acc;
#pragma unroll
                for (int r = 0; r < 16; ++r) acc[r] = 0.f;
#pragma unroll
                for (int ks = 0; ks < 4; ++ks) {
                    const bf16x8 kf = *(LAS bf16x8*)(kb + (tl * 32 + l31) * GROW + (ks * 2 + hh) * 16);
                    acc = MFMA32(qf[ks], kf, acc);
                }
                float sc[2] = {0.f, 0.f};
#pragma unroll
                for (int a = 0; a < 2; ++a)
#pragma unroll
                    for (int h = 0; h < 8; ++h) sc[a] = fmaf(wv[a][h], fmaxf(acc[8 * a + h], 0.f), sc[a]);
                const int key = tile * 32 + l31;
#pragma unroll
                for (int a = 0; a < 2; ++a) {
                    const int tq = tq0 + 2 * hh + a;
                    const bool pass = (sc[a] > tau[a]) && (key <= tq);
                    const unsigned long long m = __ballot(pass);
                    if (m != 0ull) {
                        const unsigned mlo = (unsigned)m, mhi = (unsigned)(m >> 32);
                        const int pre = hh ? (int)__builtin_amdgcn_mbcnt_hi(mhi, 0u) : (int)__builtin_amdgcn_mbcnt_lo(mlo, 0u);
                        const int bc = hh ? cnt[2 + a] : cnt[a];
                        if (pass) { const int pos = (2 * hh + a) * TK_CAP + bc + pre; cs[pos] = sc[a]; ci[pos] = (bf16_t)key; }
                        cnt[a] += __builtin_popcount(mlo); cnt[2 + a] += __builtin_popcount(mhi);
                    }
                }
#pragma unroll
                for (int q = 0; q < 4; ++q) {
                    if (cnt[q] > TK_TRIG) {
                        lds_fence();
                        const float nt_ = prune256(cs + q * TK_CAP, ci + q * TK_CAP, cnt[q], hist, lane);
                        cnt[q] = 256;
                        if ((q >> 1) == hh) { if ((q & 1) == 0) tau[0] = nt_; else tau[1] = nt_; }
                    }
                }
            }
        }
        if (ch + 1 < nch) *(LAS u32x4*)(lds + TK_KST + ((ch + 1) & 1) * (64 * GROW) + srow * GROW + scc * 16) = kr;
        __syncthreads();
    }
    LAS unsigned* mrow = (LAS unsigned*)(lds + TK_MROW) + wid * 256;
#pragma unroll
    for (int q = 0; q < 4; ++q) {
        lds_fence();
        if (cnt[q] > 256) { (void)prune256(cs + q * TK_CAP, ci + q * TK_CAP, cnt[q], hist, lane); cnt[q] = 256; }
        *(LAS u32x4*)(mrow + lane * 4) = (u32x4){0u, 0u, 0u, 0u};
        lds_fence();
#pragma unroll
        for (int e8 = 0; e8 < 8; ++e8) {
            const int i = lane + 64 * e8;
            if (i < cnt[q]) { const unsigned ix = ci[q * TK_CAP + i]; __hip_atomic_fetch_or(mrow + (ix >> 5), 1u << (ix & 31u), __ATOMIC_RELAXED, __HIP_MEMORY_SCOPE_WORKGROUP); }
        }
        lds_fence();
        const u32x4 mv = *(LAS u32x4*)(mrow + lane * 4);
        *(u32x4*)(MASK + (tokb + tq0 + q) * 256 + lane * 4) = mv;
        lds_fence();
    }
    __syncthreads();
}

constexpr int AT_STAGE = 2 * 64 * GROW;

__device__ __forceinline__ void attn_item(int e, const bf16_t* __restrict__ Q, const bf16_t* __restrict__ K, const bf16_t* __restrict__ VT, const unsigned* __restrict__ MASK, bf16_t* __restrict__ mixed, lds_t lds) {
    const int tid = otid(), lane = tid & 63, wid = tid >> 6, l31 = lane & 31, hh = lane >> 5;
    const int r8 = e >> 8, c = e & 255, b = c >> 5, j = c & 31, head = j >> 2, jj = j & 3;
    const int qb = (r8 < 4) ? (jj + 4 * r8) : (31 - (jj + 4 * (r8 - 4)));
    const size_t tokb = (size_t)b * S;
    const int tq = qb * 256 + 32 * wid + l31;
    const size_t tok = tokb + tq;
    bf16x8 qf[4];
#pragma unroll
    for (int ks = 0; ks < 4; ++ks) qf[ks] = *(const bf16x8*)(Q + tok * 512 + head * 64 + ks * 16 + 8 * hh);
    const int nchb = (qb + 1) * 4, nchw = qb * 4 + (wid >> 1) + 1;
    f32x16 O[2];
#pragma unroll
    for (int a = 0; a < 2; ++a)
#pragma unroll
        for (int r = 0; r < 16; ++r) O[a][r] = 0.f;
    float mrun = -1e30f, lrun = 0.f;
    const float L2E = 1.4426950408889634f;
    const int srow = tid >> 3, scc = tid & 7;
    const bf16_t* kg = K + (tokb + srow) * 512 + head * 64 + scc * 8;
    const bf16_t* vg = VT + ((size_t)(b * 8 + head) * 64 + srow) * S + scc * 8;
    const unsigned* mg = MASK + tok * 256;
    const int kap = (l31 & 0x13) | ((l31 & 4) << 1) | ((l31 & 8) >> 1);
    u32x4 kr = *(const u32x4*)kg, vr = *(const u32x4*)vg;
    *(LAS u32x4*)(lds + srow * GROW + scc * 16) = kr;
    *(LAS u32x4*)(lds + 64 * GROW + srow * GROW + scc * 16) = vr;
    __syncthreads();
    for (int ch = 0; ch < nchb; ++ch) {
        if (ch + 1 < nchb) { kr = *(const u32x4*)(kg + (size_t)(ch + 1) * 64 * 512); vr = *(const u32x4*)(vg + (ch + 1) * 64); }
        const lds_t sb = lds + (ch & 1) * AT_STAGE;
        if (ch < nchw) {
            const u32x2 mw = *(const u32x2*)(mg + ch * 2);
            f32x16 sacc[2];
#pragma unroll
            for (int kt = 0; kt < 2; ++kt) {
#pragma unroll
                for (int r = 0; r < 16; ++r) sacc[kt][r] = 0.f;
#pragma unroll
                for (int ks = 0; ks < 4; ++ks) {
                    const bf16x8 kf = *(LAS bf16x8*)(sb + (kt * 32 + kap) * GROW + (ks * 2 + hh) * 16);
                    sacc[kt] = MFMA32(kf, qf[ks], sacc[kt]);
                }
            }
            float mt = -INFINITY;
#pragma unroll
            for (int kt = 0; kt < 2; ++kt) {
                const unsigned wsh = (kt == 0 ? mw.x : mw.y) >> (8 * hh);
#pragma unroll
                for (int r = 0; r < 16; ++r) {
                    const int bit = (r & 7) + 16 * (r >> 3);
                    const unsigned msk = (unsigned)__builtin_amdgcn_sbfe((int)wsh, bit, 1);
                    const float v = __uint_as_float((__float_as_uint(sacc[kt][r]) & msk) | (~msk & 0xff800000u));
                    sacc[kt][r] = v; mt = fmaxf(mt, v);
                }
            }
            mt = fmaxf(mt, __shfl_xor(mt, 32));
            const float mnew = fmaxf(mrun, mt);
            if (__ballot(mnew != mrun) != 0ull) {
                const float alpha = __builtin_amdgcn_exp2f((mrun - mnew) * L2E);
                lrun *= alpha;
#pragma unroll
                for (int a = 0; a < 2; ++a)
#pragma unroll
                    for (int r = 0; r < 16; ++r) O[a][r] *= alpha;
                mrun = mnew;
            }
            const float mb = mrun * L2E;
            bf16x8 pf[2][2];
#pragma unroll
            for (int kt = 0; kt < 2; ++kt) {
                float pv[16];
#pragma unroll
                for (int r = 0; r < 16; ++r) { pv[r] = __builtin_amdgcn_exp2f(fmaf(sacc[kt][r], L2E, -mb)); lrun += pv[r]; }
#pragma unroll
                for (int s = 0; s < 2; ++s) {
                    u32x4 w; w.x = pk_bf16(pv[8 * s], pv[8 * s + 1]); w.y = pk_bf16(pv[8 * s + 2], pv[8 * s + 3]); w.z = pk_bf16(pv[8 * s + 4], pv[8 * s + 5]); w.w = pk_bf16(pv[8 * s + 6], pv[8 * s + 7]);
                    pf[kt][s] = __builtin_bit_cast(bf16x8, w);
                }
            }
#pragma unroll
            for (int dt = 0; dt < 2; ++dt)
#pragma unroll
                for (int kt = 0; kt < 2; ++kt)
#pragma unroll
                    for (int s = 0; s < 2; ++s) {
                        const bf16x8 vf = *(LAS bf16x8*)(sb + 64 * GROW + (dt * 32 + l31) * GROW + (kt * 32 + 16 * s + 8 * hh) * 2);
                        O[dt] = MFMA32(vf, pf[kt][s], O[dt]);
                    }
        }
        if (ch + 1 < nchb) {
            const lds_t nb = lds + ((ch + 1) & 1) * AT_STAGE;
            *(LAS u32x4*)(nb + srow * GROW + scc * 16) = kr;
            *(LAS u32x4*)(nb + 64 * GROW + srow * GROW + scc * 16) = vr;
        }
        __syncthreads();
    }
    const float ltot = lrun + __shfl_xor(lrun, 32);
    const float inv = 1.0f / ltot;
#pragma unroll
    for (int dt = 0; dt < 2; ++dt)
#pragma unroll
        for (int rq = 0; rq < 4; ++rq) {
            u32x2 w; w.x = pk_bf16(O[dt][4 * rq] * inv, O[dt][4 * rq + 1] * inv); w.y = pk_bf16(O[dt][4 * rq + 2] * inv, O[dt][4 * rq + 3] * inv);
            *(u32x2*)(mixed + tok * D + 512 + head * 64 + dt * 32 + 8 * rq + 4 * hh) = w;
        }
}
template <int N> __device__ __forceinline__ void bitonic_desc(int (&a)[N]) {
#pragma unroll
    for (int k = 2; k <= N; k <<= 1)
#pragma unroll
        for (int j = k >> 1; j > 0; j >>= 1)
#pragma unroll
            for (int i = 0; i < N; ++i) {
                const int l = i ^ j;
                if (l > i) {
                    const int hi = max(a[i], a[l]), lo = min(a[i], a[l]);
                    const bool desc = ((i & k) == 0);
                    a[i] = desc ? hi : lo; a[l] = desc ? lo : hi;
                }
            }
}
__device__ __forceinline__ void merge16(int (&a)[16], const int (&b)[16]) {
#pragma unroll
    for (int i = 0; i < 16; ++i) a[i] = max(a[i], b[15 - i]);
#pragma unroll
    for (int j = 8; j > 0; j >>= 1)
#pragma unroll
        for (int i = 0; i < 16; ++i) { const int l = i ^ j; if (l > i) { const int hi = max(a[i], a[l]), lo = min(a[i], a[l]); a[i] = hi; a[l] = lo; } }
}
__device__ __forceinline__ void merge_partner(int (&a)[16]) {
    int b[16];
#pragma unroll
    for (int i = 0; i < 16; ++i) b[i] = __shfl_xor(a[i], 32);
    merge16(a, b);
}
__device__ __forceinline__ int f2skey(float s) { const int b = (int)__float_as_uint(s); return b ^ ((b >> 31) & 0x7fffffff); }
__device__ __forceinline__ float skey2f(int k) { return __uint_as_float((unsigned)(k ^ ((k >> 31) & 0x7fffffff))); }

__device__ __forceinline__ float sel_f(bool c, float a, float b) { asm volatile("" : "+v"(a), "+v"(b)); return c ? a : b; }
__device__ __forceinline__ int sel_i(bool c, int a, int b) { asm volatile("" : "+v"(a), "+v"(b)); return c ? a : b; }
struct CandTab { int ci[64], cj[64]; };
__host__ __device__ constexpr CandTab make_cand() { CandTab t{}; int n = 0; for (int i = 0; i < 16; ++i) for (int j = 0; j < 16; ++j) if ((i + 1) * (j + 1) <= 16) { t.ci[n] = i; t.cj[n] = j; ++n; } return t; }

__device__ __forceinline__ void peersel_item(int tg, int l, const bf16_t* __restrict__ QP, const bf16_t* __restrict__ SK, unsigned* __restrict__ PIDX, float* __restrict__ PG, lds_t lds) {
    const int tid = otid(), lane = tid & 63, head = tid >> 6, l31 = lane & 31, hh = lane >> 5;
    const size_t tok = (size_t)tg * 32 + l31;
    int L[2][16];
#pragma unroll
    for (int p = 0; p < 2; ++p) {
        f32x16 acc[4];
#pragma unroll
        for (int nt = 0; nt < 4; ++nt)
#pragma unroll
            for (int r = 0; r < 16; ++r) acc[nt][r] = 0.f;
        const bf16_t* qp = QP + tok * 2048 + (head * 2 + p) * 128 + 8 * hh;
        const bf16_t* sk = SK + ((size_t)((l * 8 + head) * 2 + p) * 128 + l31) * 128 + 8 * hh;
        asm volatile("" : "+v"(sk));
#pragma unroll 2
        for (int ks = 0; ks < 8; ++ks) {
            const bf16x8 qv = *(const bf16x8*)(qp + ks * 16);
#pragma unroll
            for (int nt = 0; nt < 4; ++nt) { const bf16x8 sv = *(const bf16x8*)(sk + (size_t)nt * 32 * 128 + ks * 16); acc[nt] = MFMA32(sv, qv, acc[nt]); }
        }
#pragma unroll
        for (int nt = 0; nt < 4; ++nt) {
            int g[16];
#pragma unroll
            for (int r = 0; r < 16; ++r) { const int n0 = nt * 32 + (r & 3) + 8 * (r >> 2); g[r] = (f2skey(acc[nt][r]) & ~127) | ((127 - n0) - 4 * hh); }
            bitonic_desc<16>(g);
            if (nt == 0) {
#pragma unroll
                for (int r = 0; r < 16; ++r) L[p][r] = g[r];
            } else merge16(L[p], g);
            __builtin_amdgcn_sched_barrier(0);
        }
        merge_partner(L[p]);
        __builtin_amdgcn_sched_barrier(0);
    }
    LAS unsigned char* nl = (LAS unsigned char*)lds + (size_t)tid * 32;
#pragma unroll
    for (int i = 0; i < 16; ++i) { nl[i] = (unsigned char)(127 - (L[0][i] & 127)); nl[16 + i] = (unsigned char)(127 - (L[1][i] & 127)); }
    float va[16], vb[16];
#pragma unroll
    for (int i = 0; i < 16; ++i) { va[i] = skey2f(L[0][i] & ~127); vb[i] = skey2f(L[1][i] & ~127); }
    constexpr CandTab ct = make_cand();
    int cA[16], cB[16];
#pragma unroll
    for (int m = 0; m < 16; ++m) {
        const float s = sel_f(hh, va[ct.ci[2 * m + 1]], va[ct.ci[2 * m]]) + sel_f(hh, vb[ct.cj[2 * m + 1]], vb[ct.cj[2 * m]]);
        const int code = hh ? (ct.ci[2 * m + 1] * 16 + ct.cj[2 * m + 1]) : (ct.ci[2 * m] * 16 + ct.cj[2 * m]);
        cA[m] = (f2skey(s) & ~255) | (255 - code);
    }
#pragma unroll
    for (int m = 16; m < 32; ++m) {
        if (m < 25) {
            const float s = sel_f(hh, va[ct.ci[2 * m + 1]], va[ct.ci[2 * m]]) + sel_f(hh, vb[ct.cj[2 * m + 1]], vb[ct.cj[2 * m]]);
            const int code = hh ? (ct.ci[2 * m + 1] * 16 + ct.cj[2 * m + 1]) : (ct.ci[2 * m] * 16 + ct.cj[2 * m]);
            cB[m - 16] = (f2skey(s) & ~255) | (255 - code);
        } else cB[m - 16] = (int)0x80000000;
    }
    __builtin_amdgcn_sched_barrier(0);
    bitonic_desc<16>(cA); bitonic_desc<16>(cB);
    merge16(cA, cB);
    merge_partner(cA);
    lds_fence();
    float val[16], ex[16], sum = 0.f;
#pragma unroll
    for (int r = 0; r < 16; ++r) val[r] = skey2f(cA[r] & ~255);
#pragma unroll
    for (int r = 0; r < 16; ++r) { ex[r] = __expf(val[r] - val[0]); sum += ex[r]; }
    const float inv = 1.0f / sum;
#pragma unroll
    for (int r = 0; r < 8; ++r) {
        const int kk = sel_i(hh, cA[8 + r], cA[r]);
        const float gk = sel_f(hh, ex[8 + r], ex[r]) * inv;
        const int code = 255 - (kk & 255);
        const unsigned ia = nl[code >> 4], ib = nl[16 + (code & 15)];
        PIDX[tok * 128 + head * 16 + 8 * hh + r] = ia * 128u + ib;
        PG[tok * 128 + head * 16 + 8 * hh + r] = gk;
    }
}

__device__ __forceinline__ void peer_gather(int l, const bf16_t* __restrict__ H, const unsigned* __restrict__ PIDX, const float* __restrict__ PG, const bf16_t* __restrict__ EU, const bf16_t* __restrict__ EV,
                                            const float* __restrict__ gate  , float* __restrict__ x) {
    const int tid = otid(), lane = tid & 63, wid = tid >> 6, g = lane >> 4, j = lane & 15;
    const int nw = gridDim.x * 8;
    const bf16_t* eu = EU + (size_t)l * NEXP * D;
    const bf16_t* ev = EV + (size_t)l * NEXP * D;
    for (int gw = blockIdx.x * 8 + wid; gw * 32 < T; gw += nw) {
        const int b = (gw * 32) / S;
        for (int tr = 0; tr < 32; ++tr) {
            const size_t t = (size_t)gw * 32 + tr;
            u32x4 hv[8];
#pragma unroll
            for (int i = 0; i < 8; ++i) hv[i] = *(const u32x4*)(H + t * D + (j + 16 * i) * 8);
            const unsigned e0 = PIDX[t * 128 + lane], e1 = PIDX[t * 128 + 64 + lane];
            const float g0 = PG[t * 128 + lane], g1 = PG[t * 128 + 64 + lane];
            float acc[16];
#pragma unroll
            for (int i = 0; i < 16; ++i) acc[i] = 0.f;
            for (int it = 0; it < 32; ++it) {
                const int ent = it * 4 + g;
                const unsigned eid = (unsigned)__shfl((int)(it < 16 ? e0 : e1), ent & 63);
                const float gt = __shfl(it < 16 ? g0 : g1, ent & 63);
                const bf16_t* ur = eu + (size_t)eid * D;
                float part = 0.f;
#pragma unroll
                for (int i = 0; i < 8; ++i) {
                    const u32x4 u = *(const u32x4*)(ur + (j + 16 * i) * 8);
                    part = dot2bf(u[0], hv[i][0], part); part = dot2bf(u[1], hv[i][1], part); part = dot2bf(u[2], hv[i][2], part); part = dot2bf(u[3], hv[i][3], part);
                }
                part += __shfl_xor(part, 1); part += __shfl_xor(part, 2); part += __shfl_xor(part, 4); part += __shfl_xor(part, 8);
                const float act = gt * 0.5f * part * (1.0f + erff(part * 0.70710678118654752f));
#pragma unroll
                for (int gg = 0; gg < 4; ++gg) {
                    const unsigned ve = (unsigned)__builtin_amdgcn_readlane((int)eid, gg * 16);
                    const float av = __uint_as_float((unsigned)__builtin_amdgcn_readlane((int)__float_as_uint(act), gg * 16));
                    const bf16_t* vr = ev + (size_t)ve * D;
                    const u32x4 v0 = *(const u32x4*)(vr + lane * 8), v1 = *(const u32x4*)(vr + 512 + lane * 8);
                    acc[0] = fmaf(av, bf_lo(v0.x), acc[0]); acc[1] = fmaf(av, bf_hi(v0.x), acc[1]); acc[2] = fmaf(av, bf_lo(v0.y), acc[2]); acc[3] = fmaf(av, bf_hi(v0.y), acc[3]);
                    acc[4] = fmaf(av, bf_lo(v0.z), acc[4]); acc[5] = fmaf(av, bf_hi(v0.z), acc[5]); acc[6] = fmaf(av, bf_lo(v0.w), acc[6]); acc[7] = fmaf(av, bf_hi(v0.w), acc[7]);
                    acc[8] = fmaf(av, bf_lo(v1.x), acc[8]); acc[9] = fmaf(av, bf_hi(v1.x), acc[9]); acc[10] = fmaf(av, bf_lo(v1.y), acc[10]); acc[11] = fmaf(av, bf_hi(v1.y), acc[11]);
                    acc[12] = fmaf(av, bf_lo(v1.z), acc[12]); acc[13] = fmaf(av, bf_hi(v1.z), acc[13]); acc[14] = fmaf(av, bf_lo(v1.w), acc[14]); acc[15] = fmaf(av, bf_hi(v1.w), acc[15]);
                }
            }
            float* xr = x + t * D;
            const float* gr = gate + (size_t)b * 6144;
#pragma unroll
            for (int hf = 0; hf < 2; ++hf)
#pragma unroll
                for (int q = 0; q < 2; ++q) {
                    const int col = hf * 512 + lane * 8 + q * 4;
                    const f32x4 xo = *(const f32x4*)(xr + col), gg4 = *(const f32x4*)(gr + col);
                    f32x4 a; a[0] = acc[hf * 8 + q * 4]; a[1] = acc[hf * 8 + q * 4 + 1]; a[2] = acc[hf * 8 + q * 4 + 2]; a[3] = acc[hf * 8 + q * 4 + 3];
                    *(f32x4*)(xr + col) = xo + gg4 * a;
                }
        }
    }
}

__global__ void __launch_bounds__(NTHREADS, 2) mega(Params p) {
    __shared__ __attribute__((aligned(16))) unsigned char smem_raw[LDS_BYTES];
    lds_t lds = (lds_t)smem_raw;
    unsigned char* ws = p.ws;
    volatile LAS unsigned* st = (volatile LAS unsigned*)(lds + 147456);
    if (threadIdx.x == 0) { st[0] = 0u; st[1] = 0u; st[2] = 0u; st[3] = 0u; }
    __syncthreads();
    XcdBarrier bar = xcd_barrier_post((unsigned*)(ws + WS_CTL), st);
    const int lo = p.ph_lo, hi = p.ph_hi, G = gridDim.x, bid = blockIdx.x;
#define RUN(n) ((n) >= lo && (n) < hi)
#define SEAM(n) do { if ((n) >= lo && (n) + 1 < hi) xcd_barrier(bar); } while (0)

    float* modp = (float*)(ws + WS_MOD);
    bf16_t* Hb = (bf16_t*)(ws + WS_H);

    if (RUN(0)) phase_prologue(p, lds);
    SEAM(0);
    for (int l = 0; l < DEPTH; ++l) {
        const int pb = 1 + 9 * l;
        const float* xin = (l == 0) ? p.x : p.out;
        const float* modl = modp + (size_t)l * NB * 6144;
        if (RUN(pb + 0)) phase_norm<0>(xin, p.norm_mix + (size_t)l * D, modl + 0, modl + 1024, Hb, nullptr);
        SEAM(pb + 0);
        if (RUN(pb + 1)) {
            EpiIn ep; ep.xp = (bf16_t*)(ws + WS_XP); ep.q = (bf16_t*)(ws + WS_Q); ep.k = (bf16_t*)(ws + WS_K); ep.vt = (bf16_t*)(ws + WS_VT); ep.qi = (bf16_t*)(ws + WS_QI); ep.ki = (bf16_t*)(ws + WS_KI);
            ep.wi = (float*)(ws + WS_WI); ep.rope = (const float*)(ws + WS_ROPE);
            gemm_phase(Hb, (const bf16_t*)(ws + WS_WIN) + (size_t)l * NIN * D, NIN, ep, lds);
        }
        SEAM(pb + 1);
        if (RUN(pb + 2)) {
            for (int e = bid; e < 2048; e += G) topk_item(e, (const bf16_t*)(ws + WS_QI), (const bf16_t*)(ws + WS_KI), (const float*)(ws + WS_WI), (unsigned*)(ws + WS_MASK), lds);
            for (int e = bid; e < 2048; e += G) pool_item(e, (const bf16_t*)(ws + WS_XP), (const bf16_t*)(ws + WS_WPOOL) + (size_t)l * 4 * 128 * 128, p.pool_scale + (size_t)l * 512, Hb, lds);
        }
        SEAM(pb + 2);
        if (RUN(pb + 3)) {
            for (int e = bid; e < 2048; e += G) attn_item(e, (const bf16_t*)(ws + WS_Q), (const bf16_t*)(ws + WS_K), (const bf16_t*)(ws + WS_VT), (const unsigned*)(ws + WS_MASK), Hb, lds);
        }
        SEAM(pb + 3);
        if (RUN(pb + 4)) {
            EpiOut ep; ep.xin = xin; ep.xout = p.out; ep.gate = modl + 2 * 1024;
            gemm_phase(Hb, (const bf16_t*)(ws + WS_WOUT) + (size_t)l * D * D, D, ep, lds);
        }
        SEAM(pb + 4);
        if (RUN(pb + 5)) phase_norm<0>(p.out, p.norm_ffn + (size_t)l * D, modl + 3 * 1024, modl + 4 * 1024, Hb, nullptr);
        SEAM(pb + 5);
        if (RUN(pb + 6)) {
            EpiBf ep; ep.C = (bf16_t*)(ws + WS_QP); ep.ldc = 2048;
            gemm_phase(Hb, (const bf16_t*)(ws + WS_WQ) + (size_t)l * 2048 * D, 2048, ep, lds);
        }
        SEAM(pb + 6);
        if (RUN(pb + 7)) {
            for (int e = bid; e < 2048; e += G) peersel_item(e, l, (const bf16_t*)(ws + WS_QP), (const bf16_t*)(ws + WS_SK), (unsigned*)(ws + WS_PIDX), (float*)(ws + WS_PG), lds);
        }
        SEAM(pb + 7);
        if (RUN(pb + 8)) peer_gather(l, Hb, (const unsigned*)(ws + WS_PIDX), (const float*)(ws + WS_PG), (const bf16_t*)(ws + WS_EU), (const bf16_t*)(ws + WS_EV), modl + 5 * 1024, p.out);
        SEAM(pb + 8);
    }
    if (RUN(19)) phase_norm<1>(p.out, p.final_norm, nullptr, nullptr, nullptr, p.out);
#undef RUN
#undef SEAM
}


#ifndef MK_CHECK
#define MK_CHECK 0
#endif
#ifndef MK_CHECK_LAYER
#define MK_CHECK_LAYER 0
#endif
#ifndef MK_CHECK_SLOT0
#define MK_CHECK_SLOT0 10
#endif
#if MK_CHECK
__device__ __forceinline__ unsigned hash32(unsigned x) { x ^= x >> 16; x *= 0x7feb352dU; x ^= x >> 15; x *= 0x846ca68bU; x ^= x >> 16; return x; }
__device__ __forceinline__ float bfv(const bf16_t* p, size_t i) { return __uint_as_float((unsigned)p[i] << 16); }
__device__ __forceinline__ bool badrel(float got, float ref, float rtol, float atol) { return !(fabsf(got - ref) <= atol + rtol * fabsf(ref)); }
#define DIAG(p) ((unsigned*)((p).ws + WS_CTL + 32768))
constexpr size_t WS_XCOPY = 744 * MBy;

__global__ void chk_mod(Params p) {
    const unsigned id = blockIdx.x * blockDim.x + threadIdx.x;
    const unsigned h = hash32(id * 3u + 1u);
    const int l = h & 1, b = (h >> 1) & 7, j = (h >> 4) % 6144;
    float s = 0.f;
    for (int k = 0; k < D; ++k) { const float c = p.c[b * D + k]; s += (c / (1.f + expf(-c))) * p.w_ada[((size_t)l * D + k) * 6144 + j]; }
    s += p.b_ada[l * 6144 + j];
    const float got = ((const float*)(p.ws + WS_MOD))[((size_t)l * NB + b) * 6144 + j];
    if (badrel(got, s, 1e-3f, 1e-4f)) atomicAdd(DIAG(p) + 0, 1u);
}
__global__ void chk_norm(Params p, int l, int which, const float* xin, int slot) {
    const unsigned id = blockIdx.x * blockDim.x + threadIdx.x;
    const unsigned h = hash32(id * 7u + 3u);
    const int t = h % T, b = t / S;
    const float* xr = xin + (size_t)t * D;
    float ss = 0.f; for (int k = 0; k < D; ++k) ss += xr[k] * xr[k];
    const float rstd = 1.0f / sqrtf(ss / D + 1e-6f);
    const float* modl = (const float*)(p.ws + WS_MOD) + ((size_t)l * NB + b) * 6144;
    const float* gw = (which ? p.norm_ffn : p.norm_mix) + (size_t)l * D;
    const float* sh = modl + (which ? 3 : 0) * 1024; const float* sc = modl + (which ? 4 : 1) * 1024;
    const bf16_t* hb = (const bf16_t*)(p.ws + WS_H);
    for (int q = 0; q < 4; ++q) {
        const int n = hash32(h + q) % D;
        const float ref = xr[n] * rstd * gw[n] * (1.f + sc[n]) + sh[n];
        if (badrel(bfv(hb, (size_t)t * D + n), ref, 1e-2f, 1e-2f)) atomicAdd(DIAG(p) + slot, 1u);
    }
}
__device__ float dot_h_w(const bf16_t* hrow, const float* w, int ldw, int n) { float s = 0.f; for (int k = 0; k < D; ++k) s += bfv(hrow, k) * w[(size_t)k * ldw + n]; return s; }
__global__ void chk_in(Params p, int l) {
    const unsigned id = blockIdx.x * blockDim.x + threadIdx.x;
    const unsigned h = hash32(id * 11u + 5u);
    const int t = h % T; const int n = hash32(h) % DIN;
    const bf16_t* hrow = (const bf16_t*)(p.ws + WS_H) + (size_t)t * D;
    const float* w = p.w_in + (size_t)l * D * DIN;
    const float* rope = (const float*)(p.ws + WS_ROPE) + (size_t)t * 16;
    const int b = t / S, s = t % S;
    float ref, got; int slot = 2;
    auto roped = [&](int base, int d) -> float {
        if (d >= 16) return dot_h_w(hrow, w, DIN, base + d);
        const int f = d & 7; const float x1 = dot_h_w(hrow, w, DIN, base + f), x2 = dot_h_w(hrow, w, DIN, base + 8 + f);
        return d < 8 ? x1 * rope[f] - x2 * rope[8 + f] : x1 * rope[8 + f] + x2 * rope[f];
    };
    if (n < 512) { ref = dot_h_w(hrow, w, DIN, n); got = bfv((const bf16_t*)(p.ws + WS_XP), (size_t)t * 512 + n); }
    else if (n < 1024) { const int c = n - 512; ref = roped(512 + (c & ~63), c & 63) * 0.125f; got = bfv((const bf16_t*)(p.ws + WS_Q), (size_t)t * 512 + c); }
    else if (n < 1536) { const int c = n - 1024; ref = roped(1024 + (c & ~63), c & 63); got = bfv((const bf16_t*)(p.ws + WS_K), (size_t)t * 512 + c); }
    else if (n < 2048) { const int c = n - 1536; ref = dot_h_w(hrow, w, DIN, n); got = bfv((const bf16_t*)(p.ws + WS_VT), ((size_t)(b * 8 + (c >> 6)) * 64 + (c & 63)) * S + s); }
    else if (n < 2560) { const int c = n - 2048; ref = roped(2048 + (c & ~63), c & 63) * 0.125f; got = bfv((const bf16_t*)(p.ws + WS_QI), (size_t)t * 512 + c); }
    else if (n < 2624) { const int c = n - 2560; ref = roped(2560, c); got = bfv((const bf16_t*)(p.ws + WS_KI), (size_t)t * 64 + c); }
    else { const int c = n - 2624; ref = dot_h_w(hrow, w, DIN, n) * 0.35355339f; got = ((const float*)(p.ws + WS_WI))[(size_t)t * 8 + c]; }
    if (badrel(got, ref, 2e-2f, 3e-2f)) atomicAdd(DIAG(p) + slot, 1u);
}
__global__ void chk_pool(Params p, int l) {
    const unsigned id = blockIdx.x * blockDim.x + threadIdx.x;
    const unsigned h = hash32(id * 13u + 7u);
    const int t = h % T, s = t % S; const int n = hash32(h) % 512, g = n >> 7, d = n & 127, w = 2 << g;
    const bf16_t* xp = (const bf16_t*)(p.ws + WS_XP);
    float ref = 0.f;
    for (int c = 0; c < 128; ++c) {
        float sum = 0.f; int cnt = 0;
        for (int jj = 0; jj < w; ++jj) if (s - jj >= 0) { sum += bfv(xp, (size_t)(t - jj) * 512 + g * 128 + c); ++cnt; }
        const float pooled = sum / (float)cnt - bfv(xp, (size_t)t * 512 + g * 128 + c);
        ref += pooled * p.w_pool[(((size_t)l * 4 + g) * 128 + c) * 128 + d];
    }
    ref *= p.pool_scale[l * 512 + n];
    if (badrel(bfv((const bf16_t*)(p.ws + WS_H), (size_t)t * D + n), ref, 3e-2f, 3e-2f)) atomicAdd(DIAG(p) + 3, 1u);
}
__global__ void __launch_bounds__(512) chk_topk(Params p) {
    __shared__ float sc[S];
    __shared__ int nbad;
    const unsigned h = hash32(blockIdx.x * 17u + 9u);
    const int b = h & 7; int tq = (h >> 3) % S; if (blockIdx.x < 8) tq = blockIdx.x * 40;
    const size_t tokb = (size_t)b * S;
    const bf16_t* QI = (const bf16_t*)(p.ws + WS_QI); const bf16_t* KI = (const bf16_t*)(p.ws + WS_KI); const float* WI = (const float*)(p.ws + WS_WI);
    if (threadIdx.x == 0) nbad = 0;
    for (int s = threadIdx.x; s <= tq; s += 512) {
        float tot = 0.f;
        for (int hd = 0; hd < 8; ++hd) { float dsum = 0.f; for (int d = 0; d < 64; ++d) dsum += bfv(QI, (tokb + tq) * 512 + hd * 64 + d) * bfv(KI, (tokb + s) * 64 + d); tot += WI[(tokb + tq) * 8 + hd] * fmaxf(dsum, 0.f); }
        sc[s] = tot;
    }
    __syncthreads();
    int bad = 0;
    for (int s = threadIdx.x; s < S; s += 512) {
        bool sel = false;
        if (s <= tq) { const float v = sc[s]; int rank = 0; for (int s2 = 0; s2 <= tq; ++s2) { const float v2 = sc[s2]; rank += (v2 > v || (v2 == v && s2 < s)) ? 1 : 0; } sel = rank < 256; }
        const unsigned wmask = ((const unsigned*)(p.ws + WS_MASK))[(tokb + tq) * 256 + (s >> 5)];
        if (((wmask >> (s & 31)) & 1u) != (sel ? 1u : 0u)) ++bad;
    }
    atomicAdd(&nbad, bad);
    __syncthreads();
    if (threadIdx.x == 0 && nbad > 6) atomicAdd(DIAG(p) + 4, 1u);
}
__global__ void chk_attn(Params p) {
    const unsigned id = blockIdx.x * blockDim.x + threadIdx.x;
    const unsigned h = hash32(id * 19u + 11u);
    const int t = h % T, b = t / S, tq = t % S, head = (h >> 20) & 7, d = (h >> 24) & 63;
    const size_t tokb = (size_t)b * S;
    const bf16_t* Q = (const bf16_t*)(p.ws + WS_Q); const bf16_t* K = (const bf16_t*)(p.ws + WS_K); const bf16_t* VT = (const bf16_t*)(p.ws + WS_VT);
    const unsigned* M = (const unsigned*)(p.ws + WS_MASK) + (size_t)t * 256;
    float mx = -1e30f;
    for (int s = 0; s <= tq; ++s) if ((M[s >> 5] >> (s & 31)) & 1u) { float lg = 0.f; for (int e = 0; e < 64; ++e) lg += bfv(Q, (size_t)t * 512 + head * 64 + e) * bfv(K, (tokb + s) * 512 + head * 64 + e); mx = fmaxf(mx, lg); }
    float den = 0.f, num = 0.f;
    for (int s = 0; s <= tq; ++s) if ((M[s >> 5] >> (s & 31)) & 1u) { float lg = 0.f; for (int e = 0; e < 64; ++e) lg += bfv(Q, (size_t)t * 512 + head * 64 + e) * bfv(K, (tokb + s) * 512 + head * 64 + e); const float pe = expf(lg - mx); den += pe; num += pe * bfv(VT, ((size_t)(b * 8 + head) * 64 + d) * S + s); }
    const float ref = num / den;
    if (badrel(bfv((const bf16_t*)(p.ws + WS_H), (size_t)t * D + 512 + head * 64 + d), ref, 3e-2f, 1e-2f)) atomicAdd(DIAG(p) + 5, 1u);
}
__global__ void chk_out(Params p, int l, const float* xin) {
    const unsigned id = blockIdx.x * blockDim.x + threadIdx.x;
    const unsigned h = hash32(id * 23u + 13u);
    const int t = h % T, b = t / S, n = hash32(h) % D;
    const bf16_t* mrow = (const bf16_t*)(p.ws + WS_H) + (size_t)t * D;
    float s = 0.f; for (int k = 0; k < D; ++k) s += bfv(mrow, k) * p.w_out[((size_t)l * D + k) * D + n];
    const float g1 = ((const float*)(p.ws + WS_MOD))[((size_t)l * NB + b) * 6144 + 2048 + n];
    const float ref = xin[(size_t)t * D + n] + g1 * s;
    if (badrel(p.out[(size_t)t * D + n], ref, 1e-2f, 1e-2f)) atomicAdd(DIAG(p) + 6, 1u);
}
__global__ void chk_q(Params p, int l) {
    const unsigned id = blockIdx.x * blockDim.x + threadIdx.x;
    const unsigned h = hash32(id * 29u + 17u);
    const int t = h % T, n = hash32(h) % 2048;
    const bf16_t* hrow = (const bf16_t*)(p.ws + WS_H) + (size_t)t * D;
    const float ref = dot_h_w(hrow, p.w_query + (size_t)l * D * 2048, 2048, n);
    if (badrel(bfv((const bf16_t*)(p.ws + WS_QP), (size_t)t * 2048 + n), ref, 2e-2f, 3e-2f)) atomicAdd(DIAG(p) + 8, 1u);
}
__global__ void __launch_bounds__(64) chk_sel(Params p, int l) {
    __shared__ float tv[2][16][64]; __shared__ int ti[2][16][64]; __shared__ float cv[16][64]; __shared__ int cid[16][64];
    const int x = threadIdx.x;
    const unsigned id = blockIdx.x * blockDim.x + threadIdx.x;
    const unsigned h = hash32(id * 31u + 19u);
    const int t = h % T, head = (h >> 20) & 7;
    const bf16_t* QP = (const bf16_t*)(p.ws + WS_QP);
    for (int pp = 0; pp < 2; ++pp) {
        for (int i = 0; i < 16; ++i) { tv[pp][i][x] = -1e30f; ti[pp][i][x] = -1; }
        for (int n = 0; n < 128; ++n) {
            float s = 0.f; for (int d = 0; d < 128; ++d) s += bfv(QP, (size_t)t * 2048 + (head * 2 + pp) * 128 + d) * p.sub_keys[((((size_t)l * 8 + head) * 2 + pp) * 128 + n) * 128 + d];
            int pos = 16; for (int i = 15; i >= 0; --i) if (s > tv[pp][i][x]) pos = i;
            for (int i = 15; i > pos; --i) { tv[pp][i][x] = tv[pp][i - 1][x]; ti[pp][i][x] = ti[pp][i - 1][x]; }
            if (pos < 16) { tv[pp][pos][x] = s; ti[pp][pos][x] = n; }
        }
    }
    for (int i = 0; i < 16; ++i) { cv[i][x] = -1e30f; cid[i][x] = -1; }
    for (int i = 0; i < 16; ++i) for (int j = 0; j < 16; ++j) {
        const float s = tv[0][i][x] + tv[1][j][x];
        int pos = 16; for (int q = 15; q >= 0; --q) if (s > cv[q][x]) pos = q;
        for (int q = 15; q > pos; --q) { cv[q][x] = cv[q - 1][x]; cid[q][x] = cid[q - 1][x]; }
        if (pos < 16) { cv[pos][x] = s; cid[pos][x] = ti[0][i][x] * 128 + ti[1][j][x]; }
    }
    float den = 0.f; for (int i = 0; i < 16; ++i) den += expf(cv[i][x] - cv[0][x]);
    const unsigned* PI = (const unsigned*)(p.ws + WS_PIDX) + (size_t)t * 128 + head * 16; const float* PGp = (const float*)(p.ws + WS_PG) + (size_t)t * 128 + head * 16;
    int miss = 0;
    for (int i = 0; i < 16; ++i) {
        const float g = expf(cv[i][x] - cv[0][x]) / den; bool found = false;
        for (int q = 0; q < 16; ++q) if ((int)PI[q] == cid[i][x]) { found = true; if (badrel(PGp[q], g, 5e-2f, 2e-3f)) ++miss; }
        if (!found) ++miss;
    }
    if (miss > 2) atomicAdd(DIAG(p) + 9, 1u);
}
__global__ void chk_gather(Params p, int l) {
    const unsigned id = blockIdx.x * blockDim.x + threadIdx.x;
    const unsigned h = hash32(id * 37u + 23u);
    const int t = h % T, b = t / S, n = hash32(h) % D;
    const bf16_t* hrow = (const bf16_t*)(p.ws + WS_H) + (size_t)t * D;
    const unsigned* PI = (const unsigned*)(p.ws + WS_PIDX) + (size_t)t * 128; const float* PGp = (const float*)(p.ws + WS_PG) + (size_t)t * 128;
    float o = 0.f;
    for (int e = 0; e < 128; ++e) {
        const size_t ex = (size_t)l * NEXP + PI[e];
        float a = 0.f; for (int k = 0; k < D; ++k) a += bfv(hrow, k) * p.expert_u[ex * D + k];
        const float act = PGp[e] * 0.5f * a * (1.f + erff(a * 0.70710678f));
        o += act * p.expert_v[ex * D + n];
    }
    const float g2 = ((const float*)(p.ws + WS_MOD))[((size_t)l * NB + b) * 6144 + 5 * 1024 + n];
    const float ref = ((const float*)(p.ws + WS_XCOPY))[(size_t)t * D + n] + g2 * o;
    if (badrel(p.out[(size_t)t * D + n], ref, 1e-2f, 1e-2f)) atomicAdd(DIAG(p) + 10, 1u);
}
__global__ void chk_fill(Params p, int s0) {
    const unsigned* dg = DIAG(p);
    const unsigned total[11] = {4096, 4096, 4096, 4096, 64, 1024, 4096, 4096, 4096, 1024, 512};
    float E = 0.f;
    for (int i = 0; i < 5; ++i) { const int sl = s0 + i; if (sl < 11 && dg[sl] * 50u > total[sl]) E += (float)(1 << i); }
    const size_t n = (size_t)T * D, stride = (size_t)gridDim.x * blockDim.x;
    for (size_t i = (size_t)blockIdx.x * blockDim.x + threadIdx.x; i < n; i += stride) p.out[i] = E;
}
#endif

#ifndef MK_TRUNC
#define MK_TRUNC 0
#endif
#if MK_TRUNC
__global__ void __launch_bounds__(256) dump_kernel(Params p, int which) {
    unsigned char* ws = p.ws;
    const size_t n = (size_t)T * D, stride = (size_t)gridDim.x * 256;
    for (size_t i = (size_t)blockIdx.x * 256 + threadIdx.x; i < n; i += stride) {
        const size_t t = i / D; const int c = (int)(i % D);
        float v = 0.f;
        if (which == 2) {
            const bf16_t* xp = (const bf16_t*)(ws + WS_XP); const bf16_t* q = (const bf16_t*)(ws + WS_Q); const bf16_t* k = (const bf16_t*)(ws + WS_K); const bf16_t* vt = (const bf16_t*)(ws + WS_VT);
            const bf16_t* qi = (const bf16_t*)(ws + WS_QI); const bf16_t* ki = (const bf16_t*)(ws + WS_KI); const float* wi = (const float*)(ws + WS_WI);
            const int cc = c & 511;
            v = bf_lo(xp[t * 512 + cc]) + bf_lo(q[t * 512 + cc]) + bf_lo(k[t * 512 + cc]) + bf_lo(vt[t * 512 + cc]) + bf_lo(qi[t * 512 + cc]) + bf_lo(ki[t * 64 + (cc & 63)]) + wi[t * 8 + (cc & 7)];
        } else if (which == 3) {
            const unsigned* m = (const unsigned*)(ws + WS_MASK); const bf16_t* hb = (const bf16_t*)(ws + WS_H);
            v = (float)(m[t * 256 + (c & 255)] & 0xffffu) + (float)(m[t * 256 + (c & 255)] >> 16) + bf_lo(hb[t * D + (c & 511)]);
        } else if (which == 4) {
            const bf16_t* hb = (const bf16_t*)(ws + WS_H); v = bf_lo(hb[t * D + c]);
        } else if (which == 7) {
            const bf16_t* qp = (const bf16_t*)(ws + WS_QP); v = bf_lo(qp[t * 2048 + c]) + bf_lo(qp[t * 2048 + 1024 + c]);
        } else if (which == 8) {
            const unsigned* pi = (const unsigned*)(ws + WS_PIDX); const float* pg = (const float*)(ws + WS_PG);
            v = (float)pi[t * 128 + (c & 127)] + pg[t * 128 + (c & 127)];
        }
        p.out[i] = v;
    }
}
#endif

extern "C" void kernel_launch(void* const* d_in, const int* in_sizes, int n_in, void* d_out, int out_size, void* d_ws, size_t ws_size, hipStream_t stream) {
    static int grid = 0;
    if (grid == 0) {
        if (n_in != 16 || out_size != T * D || ws_size < WS_END) { fprintf(stderr, "kernel_launch: unexpected shapes (n_in %d, out %d, ws %zu)\n", n_in, out_size, ws_size); grid = -1; return; }
        int dev = 0, cus = 0, per_cu = 0;
        if (hipGetDevice(&dev) != hipSuccess || hipDeviceGetAttribute(&cus, hipDeviceAttributeMultiprocessorCount, dev) != hipSuccess) { grid = -1; return; }
        if (hipOccupancyMaxActiveBlocksPerMultiprocessor(&per_cu, (const void*)mega, NTHREADS, 0) != hipSuccess || per_cu < 1) fprintf(stderr, "kernel_launch: occupancy query says %d\n", per_cu);
        (void)hipGetLastError();
        grid = cus;
    }
    if (grid < 0) return;
    (void)hipMemsetAsync((char*)d_ws + WS_CTL, 0, 64 * 1024, stream);
#ifdef MK_DBG_CLEAR
    (void)hipMemsetAsync((char*)d_ws, 0, WS_END, stream); (void)hipMemsetAsync(d_out, 0, (size_t)T * D * 4, stream);
#endif
    Params p{};
    p.x = (const float*)d_in[0]; p.c = (const float*)d_in[1]; p.pos = (const int*)d_in[2];
    p.w_ada = (const float*)d_in[3]; p.b_ada = (const float*)d_in[4]; p.norm_mix = (const float*)d_in[5]; p.w_in = (const float*)d_in[6]; p.w_pool = (const float*)d_in[7];
    p.pool_scale = (const float*)d_in[8]; p.w_out = (const float*)d_in[9]; p.norm_ffn = (const float*)d_in[10]; p.w_query = (const float*)d_in[11]; p.sub_keys = (const float*)d_in[12];
    p.expert_u = (const float*)d_in[13]; p.expert_v = (const float*)d_in[14]; p.final_norm = (const float*)d_in[15];
    p.out = (float*)d_out; p.ws = (unsigned char*)d_ws;
#if MK_CHECK
    {
        auto run = [&](int ph) { p.ph_lo = ph; p.ph_hi = ph + 1; hipLaunchKernelGGL(mega, dim3(grid), dim3(NTHREADS), 0, stream, p); };
        const int L = MK_CHECK_LAYER; const int pb = 1 + 9 * L;
        for (int ph = 0; ph < pb; ++ph) run(ph);
        const float* xin = (L == 0) ? p.x : p.out;
        hipLaunchKernelGGL(chk_mod, dim3(16), dim3(256), 0, stream, p);
        run(pb + 0); hipLaunchKernelGGL(chk_norm, dim3(4), dim3(256), 0, stream, p, L, 0, xin, 1);
        run(pb + 1); hipLaunchKernelGGL(chk_in, dim3(16), dim3(256), 0, stream, p, L);
        run(pb + 2); hipLaunchKernelGGL(chk_pool, dim3(16), dim3(256), 0, stream, p, L); hipLaunchKernelGGL(chk_topk, dim3(64), dim3(512), 0, stream, p);
        run(pb + 3); hipLaunchKernelGGL(chk_attn, dim3(4), dim3(256), 0, stream, p);
        if (L == 1) (void)hipMemcpyAsync((char*)d_ws + WS_XCOPY, d_out, (size_t)T * D * 4, hipMemcpyDeviceToDevice, stream);
        run(pb + 4); hipLaunchKernelGGL(chk_out, dim3(16), dim3(256), 0, stream, p, L, (L == 0) ? p.x : (const float*)((char*)d_ws + WS_XCOPY));
        run(pb + 5); hipLaunchKernelGGL(chk_norm, dim3(4), dim3(256), 0, stream, p, L, 1, (const float*)p.out, 7);
        run(pb + 6); hipLaunchKernelGGL(chk_q, dim3(16), dim3(256), 0, stream, p, L);
        run(pb + 7); hipLaunchKernelGGL(chk_sel, dim3(16), dim3(64), 0, stream, p, L);
        (void)hipMemcpyAsync((char*)d_ws + WS_XCOPY, d_out, (size_t)T * D * 4, hipMemcpyDeviceToDevice, stream);
        run(pb + 8); hipLaunchKernelGGL(chk_gather, dim3(2), dim3(256), 0, stream, p, L);
        hipLaunchKernelGGL(chk_fill, dim3(2048), dim3(256), 0, stream, p, (int)MK_CHECK_SLOT0);
    }
#elif MK_TRUNC
    for (int ph = 0; ph <= MK_TRUNC; ++ph) { p.ph_lo = ph; p.ph_hi = ph + 1; hipLaunchKernelGGL(mega, dim3(grid), dim3(NTHREADS), 0, stream, p); }
    if (MK_TRUNC != 5 && MK_TRUNC != 9) hipLaunchKernelGGL(dump_kernel, dim3(2048), dim3(256), 0, stream, p, (int)MK_TRUNC);
#elif MK_MULTI
    for (int ph = 0; ph < NPH; ++ph) { p.ph_lo = ph; p.ph_hi = ph + 1; hipLaunchKernelGGL(mega, dim3(grid), dim3(NTHREADS), 0, stream, p); }
#else
    p.ph_lo = 0; p.ph_hi = NPH;
    hipLaunchKernelGGL(mega, dim3(grid), dim3(NTHREADS), 0, stream, p);
#endif
    const hipError_t le = hipPeekAtLastError();
    if (le != hipSuccess) fprintf(stderr, "kernel_launch: launch failed: %s\n", hipGetErrorName(le));
}
```

```cpp
#include <hip/hip_runtime.h>
#include <stdint.h>
#include <stdio.h>

#ifndef MK_MULTI
#define MK_MULTI 0
#endif

#define LAS __attribute__((address_space(3)))
typedef unsigned short bf16_t;
typedef short bf16x8 __attribute__((ext_vector_type(8)));
typedef float f32x16 __attribute__((ext_vector_type(16)));
typedef float f32x4 __attribute__((ext_vector_type(4)));
typedef float f32x2 __attribute__((ext_vector_type(2)));
typedef unsigned u32x4 __attribute__((ext_vector_type(4)));
typedef unsigned u32x2 __attribute__((ext_vector_type(2)));
typedef __bf16 bf16v2 __attribute__((ext_vector_type(2)));
typedef LAS unsigned char* lds_t;

constexpr int D = 1024, NB = 8, S = 8192, T = NB * S, DEPTH = 2;
constexpr int NIN = 2816;
constexpr int DIN = 2632;
constexpr int NEXP = 16384;
constexpr int NTHREADS = 512;
constexpr int LDS_BYTES = 148480;

constexpr size_t MBy = 1u << 20;
constexpr size_t WS_CTL = 0;
constexpr size_t WS_MOD = 64 * 1024;
constexpr size_t WS_ROPE = 1 * MBy;
constexpr size_t WS_WIN = 5 * MBy;
constexpr size_t WS_WOUT = 16 * MBy;
constexpr size_t WS_WQ = 20 * MBy;
constexpr size_t WS_WPOOL = 28 * MBy;
constexpr size_t WS_SK = 29 * MBy;
constexpr size_t WS_EU = 30 * MBy;
constexpr size_t WS_EV = 94 * MBy;
constexpr size_t WS_H = 158 * MBy;
constexpr size_t WS_XP = 286 * MBy;
constexpr size_t WS_Q = 350 * MBy;
constexpr size_t WS_K = 414 * MBy;
constexpr size_t WS_VT = 478 * MBy;
constexpr size_t WS_QP = WS_XP;
constexpr size_t WS_QI = 542 * MBy;
constexpr size_t WS_KI = 606 * MBy;
constexpr size_t WS_WI = 614 * MBy;
constexpr size_t WS_MASK = 616 * MBy;
constexpr size_t WS_PIDX = 680 * MBy;
constexpr size_t WS_PG = 712 * MBy;
constexpr size_t WS_ES = 744 * MBy;
constexpr size_t WS_END = 745 * MBy;
constexpr int NPH = 20;

struct Params {
    const float *x, *c; const int* pos;
    const float *w_ada, *b_ada, *norm_mix, *w_in, *w_pool, *pool_scale, *w_out, *norm_ffn, *w_query, *sub_keys, *expert_u, *expert_v, *final_norm;
    float* out; unsigned char* ws; int ph_lo, ph_hi;
};

#define XB_TMO      128
#define XB_XCNT(j)  (256  + 64 * (j))
#define XB_XSUB(j)  (1280 + 64 * (j))
#define XB_XGEN(j)  (2304 + 64 * (j))
#define XB_TOP      3328
#define XB_TOPGEN   3392
#define XCD_BAR_WORDS 3456
#define XB_SPIN_CAP (1u << 22)

__device__ __forceinline__ unsigned xb_ld(unsigned* p)              { return __hip_atomic_load(p, __ATOMIC_RELAXED, __HIP_MEMORY_SCOPE_AGENT); }
__device__ __forceinline__ unsigned xb_add(unsigned* p, unsigned v) { return __hip_atomic_fetch_add(p, v, __ATOMIC_RELAXED, __HIP_MEMORY_SCOPE_AGENT); }
__device__ __forceinline__ unsigned xb_xcc_id() { return (unsigned)__builtin_amdgcn_s_getreg((3 << 11) | 20) & 0xFu; }
#define XB_SPIN(cond, bar) do { unsigned _sp = 0; while (cond) { __builtin_amdgcn_s_sleep(1); \
    if ((++_sp & 255u) == 0u) { if (xb_ld(&(bar)[XB_TMO])) break; if (_sp > XB_SPIN_CAP) { atomicAdd(&(bar)[XB_TMO], 1u); break; } } } } while (0)

struct XcdBarrier { unsigned* bar; unsigned x; volatile LAS unsigned* st; };

__device__ __forceinline__ XcdBarrier xcd_barrier_post(unsigned* bar, volatile LAS unsigned* st) {
    XcdBarrier b; b.bar = bar; b.x = xb_xcc_id(); b.st = st;
    if (threadIdx.x == 0) (void)xb_add(&bar[XB_XCNT(b.x)], 1u);
    return b;
}
__device__ __forceinline__ void xcd_barrier_complete(unsigned* bar, unsigned x, unsigned& nloc, unsigned& nx) {
    const unsigned G = gridDim.x * gridDim.y * gridDim.z;
    unsigned sum, cnt, mine, sp = 0u;
    for (;;) {
        sum = 0u; cnt = 0u; mine = 0u;
#pragma unroll
        for (unsigned j = 0; j < 16; ++j) { const unsigned c = xb_ld(&bar[XB_XCNT(j)]); sum += c; cnt += (c > 0u) ? 1u : 0u; mine = (j == x) ? c : mine; }
        if (sum == G) break;
        __builtin_amdgcn_s_sleep(1);
        if ((++sp & 255u) == 0u) { if (xb_ld(&bar[XB_TMO])) break; if (sp > XB_SPIN_CAP) { atomicAdd(&bar[XB_TMO], 1u); break; } }
    }
    nloc = mine > 0u ? mine : 1u; nx = cnt > 0u ? cnt : 1u;
}
__device__ __forceinline__ void xcd_barrier(const XcdBarrier& b) {
    asm volatile("s_waitcnt vmcnt(0)" ::: "memory");
    __syncthreads();
    if (threadIdx.x == 0) {
        unsigned* bar = b.bar;
        __builtin_amdgcn_s_waitcnt(0);
        unsigned nloc = b.st[0], nx = b.st[1];
        if (nloc == 0u) { xcd_barrier_complete(bar, b.x, nloc, nx); b.st[0] = nloc; b.st[1] = nx; }
        const unsigned old = xb_add(&bar[XB_XSUB(b.x)], 1u);
        const unsigned gen = old / nloc;
        if (old + 1u == (gen + 1u) * nloc) {
            __builtin_amdgcn_fence(__ATOMIC_RELEASE, "agent");
            asm volatile("s_waitcnt vmcnt(0)" ::: "memory");
            const unsigned og = xb_add(&bar[XB_TOP], 1u);
            const unsigned tg = og / nx;
            if (og + 1u == (tg + 1u) * nx) xb_add(&bar[XB_TOPGEN], 1u);
            else XB_SPIN(xb_ld(&bar[XB_TOPGEN]) == tg, bar);
            __builtin_amdgcn_fence(__ATOMIC_ACQUIRE, "agent");
            xb_add(&bar[XB_XGEN(b.x)], 1u);
            asm volatile("s_waitcnt vmcnt(0)" ::: "memory");
        } else {
            XB_SPIN(xb_ld(&bar[XB_XGEN(b.x)]) == gen, bar);
            __builtin_amdgcn_fence(__ATOMIC_ACQUIRE, "agent");
            asm volatile("s_waitcnt vmcnt(0)" ::: "memory");
        }
    }
    __syncthreads();
}

#define MFMA32(a, b, c) __builtin_amdgcn_mfma_f32_32x32x16_bf16((a), (b), (c), 0, 0, 0)
__device__ __forceinline__ unsigned pk_bf16(float lo, float hi) { const f32x2 v = {lo, hi}; return __builtin_bit_cast(unsigned, __builtin_convertvector(v, bf16v2)); }
__device__ __forceinline__ float dot2bf(unsigned a, unsigned b, float c) { return __builtin_amdgcn_fdot2_f32_bf16(__builtin_bit_cast(bf16v2, a), __builtin_bit_cast(bf16v2, b), c, false); }
__device__ __forceinline__ float bf_lo(unsigned u) { return __uint_as_float(u << 16); }
__device__ __forceinline__ float bf_hi(unsigned u) { return __uint_as_float(u & 0xffff0000u); }
__device__ __forceinline__ float wave_sum(float v) {
#pragma unroll
    for (int o = 32; o > 0; o >>= 1) v += __shfl_xor(v, o);
    return v;
}
__device__ __forceinline__ int otid() { int t = threadIdx.x; asm volatile("" : "+v"(t)); return t; }
__device__ __forceinline__ void lds_fence() { asm volatile("s_waitcnt lgkmcnt(0)" ::: "memory"); }

__device__ __forceinline__ void transpose_tile(const float* __restrict__ src, int ldsrc, int Nvalid, bf16_t* __restrict__ dst, int lddst, int k0, int n0, lds_t lds) {
    LAS float* tile = (LAS float*)lds;
    const int tid = otid();
    {
        const int r = tid >> 6, c = tid & 63, n = n0 + c;
#pragma unroll
        for (int i = 0; i < 8; ++i) { const int k = r + 8 * i; tile[k * 65 + c] = (n < Nvalid) ? src[(size_t)(k0 + k) * ldsrc + n] : 0.f; }
    }
    __syncthreads();
    {
        const int nn = tid >> 3, kc = tid & 7;
        float v[8];
#pragma unroll
        for (int j = 0; j < 8; ++j) v[j] = tile[(kc * 8 + j) * 65 + nn];
        u32x4 w; w.x = pk_bf16(v[0], v[1]); w.y = pk_bf16(v[2], v[3]); w.z = pk_bf16(v[4], v[5]); w.w = pk_bf16(v[6], v[7]);
        *(u32x4*)(dst + (size_t)(n0 + nn) * lddst + k0 + kc * 8) = w;
    }
    __syncthreads();
}

__device__ __forceinline__ void convert_bf16(const float* __restrict__ src, bf16_t* __restrict__ dst, size_t n8) {
    const size_t stride = (size_t)gridDim.x * NTHREADS;
    for (size_t i = (size_t)blockIdx.x * NTHREADS + otid(); i < n8; i += stride) {
        const f32x4 a = *(const f32x4*)(src + i * 8), b = *(const f32x4*)(src + i * 8 + 4);
        u32x4 w; w.x = pk_bf16(a[0], a[1]); w.y = pk_bf16(a[2], a[3]); w.z = pk_bf16(b[0], b[1]); w.w = pk_bf16(b[2], b[3]);
        *(u32x4*)(dst + i * 8) = w;
    }
}

__device__ __forceinline__ void sincos_d(double a, float& sn, float& cs) {
    const double kq = rint(a * 0.63661977236758134308);
    double r = fma(-kq, 1.57079632679489655800e+00, a);
    r = fma(-kq, 6.12323399573676603587e-17, r);
    const int q = ((int)kq) & 3;
    const double r2 = r * r;
    double sp = -7.647163731819816476e-13;
    sp = fma(sp, r2, 1.605904383682161460e-10);
    sp = fma(sp, r2, -2.505210838544171878e-08);
    sp = fma(sp, r2, 2.755731922398589065e-06);
    sp = fma(sp, r2, -1.984126984126984127e-04);
    sp = fma(sp, r2, 8.333333333333333333e-03);
    sp = fma(sp, r2, -1.666666666666666667e-01);
    const double s = fma(sp * r2, r, r);
    double cp = 4.779477332387385297e-14;
    cp = fma(cp, r2, -1.147074559772972471e-11);
    cp = fma(cp, r2, 2.087675698786809898e-09);
    cp = fma(cp, r2, -2.755731922398589065e-07);
    cp = fma(cp, r2, 2.480158730158730159e-05);
    cp = fma(cp, r2, -1.388888888888888889e-03);
    cp = fma(cp, r2, 4.166666666666666667e-02);
    cp = fma(cp, r2, -0.5);
    const double c = fma(cp, r2, 1.0);
    const double ss = (q & 1) ? c : s, cc = (q & 1) ? s : c;
    sn = (float)((q & 2) ? -ss : ss);
    cs = (float)(((q + 1) & 2) ? -cc : cc);
}

__device__ __forceinline__ void phase_prologue(const Params& p, lds_t lds) {
    const int tid = otid(), bid = blockIdx.x, G = gridDim.x;
    unsigned char* ws = p.ws;
    {
        const int J_IN = 16 * 44, J_OUT = 16 * 16, J_Q = 16 * 32, J_P = 4;
        const int total = 2 * (J_IN + J_OUT + J_Q) + 8 * J_P;
        for (int j = bid; j < total; j += G) {
            int r = j;
            if (r < 2 * J_IN) { const int l = r / J_IN, t = r % J_IN; transpose_tile(p.w_in + (size_t)l * D * DIN, DIN, DIN, (bf16_t*)(ws + WS_WIN) + (size_t)l * NIN * D, D, (t / 44) * 64, (t % 44) * 64, lds); continue; }
            r -= 2 * J_IN;
            if (r < 2 * J_OUT) { const int l = r / J_OUT, t = r % J_OUT; transpose_tile(p.w_out + (size_t)l * D * D, D, D, (bf16_t*)(ws + WS_WOUT) + (size_t)l * D * D, D, (t / 16) * 64, (t % 16) * 64, lds); continue; }
            r -= 2 * J_OUT;
            if (r < 2 * J_Q) { const int l = r / J_Q, t = r % J_Q; transpose_tile(p.w_query + (size_t)l * D * 2048, 2048, 2048, (bf16_t*)(ws + WS_WQ) + (size_t)l * 2048 * D, D, (t / 32) * 64, (t % 32) * 64, lds); continue; }
            r -= 2 * J_Q;
            { const int m = r / J_P, t = r % J_P; transpose_tile(p.w_pool + (size_t)m * 128 * 128, 128, 128, (bf16_t*)(ws + WS_WPOOL) + (size_t)m * 128 * 128, 128, (t / 2) * 64, (t % 2) * 64, lds); }
        }
    }
    {
        const int lane = tid & 63, wid = tid >> 6, nw = G * 8;
        for (int r = bid * 8 + wid; r < 2 * DEPTH * NEXP; r += nw) {
            const int tab = r / (DEPTH * NEXP), row = r % (DEPTH * NEXP);
            const float* src = (tab ? p.expert_v : p.expert_u) + (size_t)row * D + lane * 16;
            f32x4 v[4]; float am = 0.f;
#pragma unroll
            for (int i = 0; i < 4; ++i) { v[i] = *(const f32x4*)(src + 4 * i); am = fmaxf(am, fmaxf(fmaxf(fabsf(v[i][0]), fabsf(v[i][1])), fmaxf(fabsf(v[i][2]), fabsf(v[i][3])))); }
#pragma unroll
            for (int o = 32; o > 0; o >>= 1) am = fmaxf(am, __shfl_xor(am, o));
            const unsigned eb = (__float_as_uint(am) >> 23) & 255u;
            const bool ok = eb >= 8u && eb <= 250u;
            const float sc = ok ? __uint_as_float((261u - eb) << 23) : 1.0f, isc = ok ? __uint_as_float((eb - 7u) << 23) : 1.0f;
            u32x4 w;
#pragma unroll
            for (int i = 0; i < 4; ++i) {
                int pk = 0;
                pk = __builtin_amdgcn_cvt_pk_fp8_f32(v[i][0] * sc, v[i][1] * sc, pk, false);
                pk = __builtin_amdgcn_cvt_pk_fp8_f32(v[i][2] * sc, v[i][3] * sc, pk, true);
                w[i] = (unsigned)pk;
            }
            *(u32x4*)(ws + (tab ? WS_EV : WS_EU) + (size_t)row * D + lane * 16) = w;
            if (lane == 0) ((float*)(ws + WS_ES))[(size_t)row * 2 + tab] = isc;
        }
    }
    convert_bf16(p.sub_keys, (bf16_t*)(ws + WS_SK), (size_t)DEPTH * 16 * 128 * 128 / 8);
    {
        LAS float* sc = (LAS float*)lds;
        LAS float* part = (LAS float*)(lds + 32768);
        for (int i = tid; i < NB * D; i += NTHREADS) { const float v = p.c[i]; sc[i] = v / (1.f + __expf(-v)); }
        __syncthreads();
        const int lane = tid & 63, wid = tid >> 6;
        for (int j = bid; j < DEPTH * 96; j += G) {
            const int l = j / 96, col = (j % 96) * 64 + lane;
            const float* wp = p.w_ada + (size_t)l * D * 6144 + col;
            float a[8] = {0.f, 0.f, 0.f, 0.f, 0.f, 0.f, 0.f, 0.f};
            for (int k = wid * 128; k < wid * 128 + 128; ++k) {
                const float w = wp[(size_t)k * 6144];
#pragma unroll
                for (int b = 0; b < 8; ++b) a[b] = fmaf(sc[b * D + k], w, a[b]);
            }
#pragma unroll
            for (int b = 0; b < 8; ++b) part[(wid * 8 + b) * 64 + lane] = a[b];
            __syncthreads();
            {
                const int b = tid >> 6;
                float s = 0.f;
#pragma unroll
                for (int w = 0; w < 8; ++w) s += part[(w * 8 + b) * 64 + lane];
                ((float*)(ws + WS_MOD))[((size_t)l * NB + b) * 6144 + col] = s + p.b_ada[(size_t)l * 6144 + col];
            }
            __syncthreads();
        }
    }
    {
        const float inv[8] = {1.0f, 0.1939227432012558f, 0.03760603070259094f, 0.007292664609849453f, 0.0014142135623842478f, 0.00027424818836152554f, 5.318296098266728e-05f, 1.0313386155758053e-05f};
        const size_t stride = (size_t)G * NTHREADS;
        for (size_t i = (size_t)bid * NTHREADS + tid; i < (size_t)T * 8; i += stride) {
            const int t = (int)(i >> 3), f = (int)(i & 7);
            float iv = inv[0];
#pragma unroll
            for (int q = 1; q < 8; ++q) iv = (f == q) ? inv[q] : iv;
            const float ang = (float)p.pos[t] * iv;
            float sn, cs; sincos_d((double)ang, sn, cs);
            float* rp = (float*)(ws + WS_ROPE) + (size_t)t * 16;
            rp[f] = cs; rp[8 + f] = sn;
        }
    }
}

template <int MODE>
__device__ __forceinline__ void phase_norm(const float* xin, const float* __restrict__ gw, const float* __restrict__ sh, const float* __restrict__ scl, bf16_t* hout, float* fout) {
    const int tid = otid(), lane = tid & 63, wid = tid >> 6;
    const int nw = gridDim.x * 8;
    for (int gwv = blockIdx.x * 8 + wid; gwv * 32 < T; gwv += nw) {
        const int row0 = gwv * 32, b = row0 / S;
        f32x4 g4[4], a4[4], s4[4];
#pragma unroll
        for (int i = 0; i < 4; ++i) {
            const int col = 4 * lane + 256 * i;
            g4[i] = *(const f32x4*)(gw + col);
            if (MODE == 0) { a4[i] = *(const f32x4*)(scl + (size_t)b * 6144 + col) + 1.0f; s4[i] = *(const f32x4*)(sh + (size_t)b * 6144 + col); }
        }
        for (int r = 0; r < 32; ++r) {
            const float* xr = xin + (size_t)(row0 + r) * D;
            f32x4 v[4]; float ss = 0.f;
#pragma unroll
            for (int i = 0; i < 4; ++i) { v[i] = *(const f32x4*)(xr + 4 * lane + 256 * i); ss += v[i][0] * v[i][0] + v[i][1] * v[i][1] + v[i][2] * v[i][2] + v[i][3] * v[i][3]; }
            ss = wave_sum(ss);
            const float rstd = rsqrtf(ss * (1.0f / D) + 1e-6f);
#pragma unroll
            for (int i = 0; i < 4; ++i) {
                f32x4 y = v[i] * rstd * g4[i];
                if (MODE == 0) {
                    y = y * a4[i] + s4[i];
                    u32x2 w; w.x = pk_bf16(y[0], y[1]); w.y = pk_bf16(y[2], y[3]);
                    *(u32x2*)(hout + (size_t)(row0 + r) * D + 4 * lane + 256 * i) = w;
                } else {
                    *(f32x4*)(fout + (size_t)(row0 + r) * D + 4 * lane + 256 * i) = y;
                }
            }
        }
    }
}
constexpr int GROW = 144;
constexpr int GTILE = 256 * GROW;

__device__ __forceinline__ bool tile_order(int i, int N, int& pm, int& pn) {
    const int nM = T / 256, nN = N / 256, nwg = nM * nN, G = gridDim.x;
    const long L = (long)i * G + blockIdx.x; if (L >= nwg) return false;
    int wgid = (int)L; { const int q = nwg / 8, r = nwg % 8, xcd = wgid % 8, off = wgid / 8; wgid = (xcd < r ? xcd * (q + 1) : r * (q + 1) + (xcd - r) * q) + off; }
    const int nig = 8 * nN, gid = wgid / nig, fm = gid * 8, gsz = (nM - fm) < 8 ? (nM - fm) : 8;
    pm = fm + ((wgid % nig) % gsz); pn = (wgid % nig) / gsz; return true;
}

template <class Epi>
__device__ __forceinline__ void gemm_phase(const bf16_t* __restrict__ A, const bf16_t* __restrict__ Wt, int N, const Epi& epi, lds_t lds) {
    const int tid = otid(), lane = tid & 63, wid = tid >> 6;
    const int wr = wid >> 2, wc = wid & 3, l31 = lane & 31, hh = lane >> 5;
    const int srow = tid >> 3, scc = tid & 7;
    int pm, pn;
    for (int it = 0; tile_order(it, N, pm, pn); ++it) {
        const bf16_t* Ag = A + (size_t)(pm * 256 + srow) * D + scc * 8;
        const bf16_t* Wg = Wt + (size_t)(pn * 256 + srow) * D + scc * 8;
        f32x16 acc[2][4];
#pragma unroll
        for (int a = 0; a < 2; ++a)
#pragma unroll
            for (int b = 0; b < 4; ++b)
#pragma unroll
                for (int r = 0; r < 16; ++r) acc[a][b][r] = 0.f;
        u32x4 ra[4], rw[4];
#pragma unroll
        for (int i = 0; i < 4; ++i) { ra[i] = *(const u32x4*)(Ag + (size_t)i * 64 * D); rw[i] = *(const u32x4*)(Wg + (size_t)i * 64 * D); }
#pragma unroll
        for (int i = 0; i < 4; ++i) { *(LAS u32x4*)(lds + (srow + 64 * i) * GROW + scc * 16) = ra[i]; *(LAS u32x4*)(lds + GTILE + (srow + 64 * i) * GROW + scc * 16) = rw[i]; }
        __syncthreads();
        for (int kt = 0; kt < 16; ++kt) {
            if (kt < 15) {
#pragma unroll
                for (int i = 0; i < 4; ++i) { ra[i] = *(const u32x4*)(Ag + (size_t)i * 64 * D + (kt + 1) * 64); rw[i] = *(const u32x4*)(Wg + (size_t)i * 64 * D + (kt + 1) * 64); }
            }
            const lds_t sb = lds + (kt & 1) * 2 * GTILE;
#pragma unroll
            for (int ks = 0; ks < 4; ++ks) {
                bf16x8 af[4], wf[2];
#pragma unroll
                for (int tt = 0; tt < 4; ++tt) af[tt] = *(LAS bf16x8*)(sb + (wr * 128 + tt * 32 + l31) * GROW + (ks * 2 + hh) * 16);
#pragma unroll
                for (int nt = 0; nt < 2; ++nt) wf[nt] = *(LAS bf16x8*)(sb + GTILE + (wc * 64 + nt * 32 + l31) * GROW + (ks * 2 + hh) * 16);
#pragma unroll
                for (int nt = 0; nt < 2; ++nt)
#pragma unroll
                    for (int tt = 0; tt < 4; ++tt) acc[nt][tt] = MFMA32(wf[nt], af[tt], acc[nt][tt]);
            }
            if (kt < 15) {
                const lds_t nb = lds + ((kt + 1) & 1) * 2 * GTILE;
#pragma unroll
                for (int i = 0; i < 4; ++i) { *(LAS u32x4*)(nb + (srow + 64 * i) * GROW + scc * 16) = ra[i]; *(LAS u32x4*)(nb + GTILE + (srow + 64 * i) * GROW + scc * 16) = rw[i]; }
            }
            __syncthreads();
        }
        epi(acc, pm, pn, wr, wc, l31, hh);
    }
}

struct EpiIn {
    bf16_t *xp, *q, *k, *vt, *qi, *ki; float* wi; const float* rope;
    __device__ __forceinline__ void operator()(const f32x16 (&acc)[2][4], int pm, int pn, int wr, int wc, int l31, int hh) const {
        const int seg = pn >> 1;
        const int cb = (pn & 1) * 256 + wc * 64;
#pragma unroll
        for (int tt = 0; tt < 4; ++tt) {
            const int t = pm * 256 + wr * 128 + tt * 32 + l31;
            if (seg == 0) {
#pragma unroll
                for (int nt = 0; nt < 2; ++nt)
#pragma unroll
                    for (int rq = 0; rq < 4; ++rq) {
                        u32x2 w; w.x = pk_bf16(acc[nt][tt][4 * rq], acc[nt][tt][4 * rq + 1]); w.y = pk_bf16(acc[nt][tt][4 * rq + 2], acc[nt][tt][4 * rq + 3]);
                        *(u32x2*)(xp + (size_t)t * 512 + cb + nt * 32 + 8 * rq + 4 * hh) = w;
                    }
            } else if (seg == 3) {
                const int b = t / S, s = t % S, head = cb >> 6;
                bf16_t* vb = vt + ((size_t)(b * 8 + head) * 64) * S + s;
#pragma unroll
                for (int nt = 0; nt < 2; ++nt)
#pragma unroll
                    for (int r = 0; r < 16; ++r) {
                        const int d = nt * 32 + (r & 3) + 8 * (r >> 2) + 4 * hh;
                        vb[(size_t)d * S] = (bf16_t)(pk_bf16(acc[nt][tt][r], 0.f) & 0xffffu);
                    }
            } else if (seg == 1 || seg == 2 || seg == 4 || (seg == 5 && wc == 0)) {
                const f32x4 cs = *(const f32x4*)(rope + (size_t)t * 16 + 4 * hh), sn = *(const f32x4*)(rope + (size_t)t * 16 + 8 + 4 * hh);
                const float scale = (seg == 1 || seg == 4) ? 0.125f : 1.0f;
                bf16_t* dst; size_t off;
                if (seg == 1) { dst = q; off = (size_t)t * 512 + cb; } else if (seg == 2) { dst = k; off = (size_t)t * 512 + cb; } else if (seg == 4) { dst = qi; off = (size_t)t * 512 + cb; } else { dst = ki; off = (size_t)t * 64; }
                float v0[16];
#pragma unroll
                for (int r = 0; r < 16; ++r) v0[r] = acc[0][tt][r];
#pragma unroll
                for (int j = 0; j < 4; ++j) { const float x1 = acc[0][tt][j], x2 = acc[0][tt][4 + j]; v0[j] = x1 * cs[j] - x2 * sn[j]; v0[4 + j] = x1 * sn[j] + x2 * cs[j]; }
#pragma unroll
                for (int rq = 0; rq < 4; ++rq) {
                    u32x2 w; w.x = pk_bf16(v0[4 * rq] * scale, v0[4 * rq + 1] * scale); w.y = pk_bf16(v0[4 * rq + 2] * scale, v0[4 * rq + 3] * scale);
                    *(u32x2*)(dst + off + 8 * rq + 4 * hh) = w;
                    u32x2 w2; w2.x = pk_bf16(acc[1][tt][4 * rq] * scale, acc[1][tt][4 * rq + 1] * scale); w2.y = pk_bf16(acc[1][tt][4 * rq + 2] * scale, acc[1][tt][4 * rq + 3] * scale);
                    *(u32x2*)(dst + off + 32 + 8 * rq + 4 * hh) = w2;
                }
            } else if (seg == 5 && wc == 1) {
                f32x4 w;
#pragma unroll
                for (int j = 0; j < 4; ++j) w[j] = acc[0][tt][j] * 0.35355339059327373f;
                *(f32x4*)(wi + (size_t)t * 8 + 4 * hh) = w;
            }
        }
    }
};

struct EpiOut {
    const float* xin; float* xout; const float* gate;
    __device__ __forceinline__ void operator()(const f32x16 (&acc)[2][4], int pm, int pn, int wr, int wc, int l31, int hh) const {
        const int b = (pm * 256) / S;
#pragma unroll
        for (int nt = 0; nt < 2; ++nt)
#pragma unroll
            for (int rq = 0; rq < 4; ++rq) {
                const int n0 = pn * 256 + wc * 64 + nt * 32 + 8 * rq + 4 * hh;
                const f32x4 g = *(const f32x4*)(gate + (size_t)b * 6144 + n0);
#pragma unroll
                for (int tt = 0; tt < 4; ++tt) {
                    const int t = pm * 256 + wr * 128 + tt * 32 + l31;
                    const f32x4 xo = *(const f32x4*)(xin + (size_t)t * D + n0);
                    f32x4 a; a[0] = acc[nt][tt][4 * rq]; a[1] = acc[nt][tt][4 * rq + 1]; a[2] = acc[nt][tt][4 * rq + 2]; a[3] = acc[nt][tt][4 * rq + 3];
                    *(f32x4*)(xout + (size_t)t * D + n0) = xo + g * a;
                }
            }
    }
};

struct EpiBf {
    bf16_t* C; int ldc;
    __device__ __forceinline__ void operator()(const f32x16 (&acc)[2][4], int pm, int pn, int wr, int wc, int l31, int hh) const {
#pragma unroll
        for (int tt = 0; tt < 4; ++tt) {
            const int t = pm * 256 + wr * 128 + tt * 32 + l31;
#pragma unroll
            for (int nt = 0; nt < 2; ++nt)
#pragma unroll
                for (int rq = 0; rq < 4; ++rq) {
                    u32x2 w; w.x = pk_bf16(acc[nt][tt][4 * rq], acc[nt][tt][4 * rq + 1]); w.y = pk_bf16(acc[nt][tt][4 * rq + 2], acc[nt][tt][4 * rq + 3]);
                    *(u32x2*)(C + (size_t)t * ldc + pn * 256 + wc * 64 + nt * 32 + 8 * rq + 4 * hh) = w;
                }
        }
    }
};

__device__ __forceinline__ void pool_item(int e, const bf16_t* __restrict__ xp, const bf16_t* __restrict__ wpool  , const float* __restrict__ pscale  , bf16_t* __restrict__ mixed, lds_t lds) {
    const int tid = otid(), lane = tid & 63, wid = tid >> 6, l31 = lane & 31, hh = lane >> 5;
    const int g = e & 3, tile = e >> 2;
    const int t0 = tile * 128, s0 = t0 % S;
    lds_t xs = lds;
    lds_t ps = lds + 144 * 256;
    for (int c = tid; c < 144 * 16; c += NTHREADS) {
        const int r = c >> 4, cc = c & 15;
        u32x4 v = {0u, 0u, 0u, 0u};
        if (s0 - 16 + r >= 0) v = *(const u32x4*)(xp + (size_t)(t0 - 16 + r) * 512 + g * 128 + cc * 8);
        *(LAS u32x4*)(xs + r * 256 + cc * 16) = v;
    }
    __syncthreads();
    {
        const int c = tid & 127, tq = tid >> 7, w = 2 << g;
        for (int tl = tq * 32; tl < tq * 32 + 32; ++tl) {
            const int s = s0 + tl;
            float sum = 0.f;
            for (int j = 0; j < w; ++j) sum += __uint_as_float((unsigned)(*(LAS bf16_t*)(xs + (16 + tl - j) * 256 + c * 2)) << 16);
            const float xc = __uint_as_float((unsigned)(*(LAS bf16_t*)(xs + (16 + tl) * 256 + c * 2)) << 16);
            const float cnt = (float)((s + 1 < w) ? (s + 1) : w);
            const float pooled = sum / cnt - xc;
            *(LAS bf16_t*)(ps + tl * 272 + c * 2) = (bf16_t)(pk_bf16(pooled, 0.f) & 0xffffu);
        }
    }
    __syncthreads();
    {
        const int dt = wid & 3, tb = (wid >> 2) * 2;
        f32x16 acc[2];
#pragma unroll
        for (int a = 0; a < 2; ++a)
#pragma unroll
            for (int r = 0; r < 16; ++r) acc[a][r] = 0.f;
        const bf16_t* wg = wpool + (size_t)g * 128 * 128 + (size_t)(dt * 32 + l31) * 128 + 8 * hh;
#pragma unroll
        for (int ks = 0; ks < 8; ++ks) {
            const bf16x8 wf = *(const bf16x8*)(wg + ks * 16);
#pragma unroll
            for (int a = 0; a < 2; ++a) {
                const bf16x8 pf = *(LAS bf16x8*)(ps + ((tb + a) * 32 + l31) * 272 + (ks * 2 + hh) * 16);
                acc[a] = MFMA32(wf, pf, acc[a]);
            }
        }
#pragma unroll
        for (int a = 0; a < 2; ++a) {
            const int t = t0 + (tb + a) * 32 + l31;
#pragma unroll
            for (int rq = 0; rq < 4; ++rq) {
                const int d = dt * 32 + 8 * rq + 4 * hh;
                const f32x4 sc = *(const f32x4*)(pscale + g * 128 + d);
                u32x2 w; w.x = pk_bf16(acc[a][4 * rq] * sc[0], acc[a][4 * rq + 1] * sc[1]); w.y = pk_bf16(acc[a][4 * rq + 2] * sc[2], acc[a][4 * rq + 3] * sc[3]);
                *(u32x2*)(mixed + (size_t)t * D + g * 128 + d) = w;
            }
        }
    }
    __syncthreads();
}
constexpr int TK_CAP = 512, TK_TRIG = 480;
constexpr int TK_CS = 0;
constexpr int TK_CI = 65536;
constexpr int TK_KST = 98304;
constexpr int TK_HIST = 116736;
constexpr int TK_MROW = 124928;

__device__ __forceinline__ unsigned f2key(float s) { const unsigned b = __float_as_uint(s); return b ^ ((b >> 31) ? 0xffffffffu : 0x80000000u); }
__device__ __forceinline__ float key2f(unsigned k) { return __uint_as_float((k & 0x80000000u) ? (k ^ 0x80000000u) : ~k); }
__device__ __forceinline__ int bcount(bool p) { return __builtin_popcountll(__ballot(p)); }

__device__ __forceinline__ float prune256(LAS float* csq, LAS bf16_t* ciq, int n, LAS unsigned* hist, int lane) {
    unsigned key[8], idx[8];
#pragma unroll
    for (int e = 0; e < 8; ++e) {
        const int i = lane + 64 * e; const bool v = i < n;
        key[e] = v ? f2key(csq[i]) : 0u; idx[e] = v ? (unsigned)ciq[i] : 0xffffu;
    }
    unsigned prefix = 0u; int need = 256;
#pragma unroll
    for (int pass = 3; pass >= 0; --pass) {
        const int sh = pass * 8;
        *(LAS u32x4*)(hist + lane * 4) = (u32x4){0u, 0u, 0u, 0u};
        lds_fence();
#pragma unroll
        for (int e = 0; e < 8; ++e) {
            const bool act = (key[e] != 0u) && (pass == 3 || (key[e] >> (sh + 8)) == (prefix >> (sh + 8)));
            if (act) __hip_atomic_fetch_add(hist + ((key[e] >> sh) & 255u), 1u, __ATOMIC_RELAXED, __HIP_MEMORY_SCOPE_WORKGROUP);
        }
        lds_fence();
        const u32x4 hb = *(LAS u32x4*)(hist + lane * 4);
        const unsigned s = hb.x + hb.y + hb.z + hb.w;
        unsigned suf = s;
#pragma unroll
        for (int d = 1; d < 64; d <<= 1) { const unsigned o = __shfl_down(suf, d); if (lane + d < 64) suf += o; }
        const unsigned long long bm = __ballot(suf >= (unsigned)need);
        const int Ls = 63 - __builtin_clzll(bm | 1ull);
        const unsigned above = __shfl(suf - s, Ls);
        const unsigned b0 = __shfl(hb.x, Ls), b1 = __shfl(hb.y, Ls), b2 = __shfl(hb.z, Ls), b3 = __shfl(hb.w, Ls);
        unsigned c = above; int bin;
        if (c + b3 >= (unsigned)need) bin = 3;
        else { c += b3; if (c + b2 >= (unsigned)need) bin = 2; else { c += b2; if (c + b1 >= (unsigned)need) bin = 1; else { c += b1; bin = 0; } } }
        (void)b0;
        need -= (int)c;
        prefix |= (unsigned)(Ls * 4 + bin) << sh;
    }
    int eq = 0;
#pragma unroll
    for (int e = 0; e < 8; ++e) eq += bcount(key[e] == prefix);
    unsigned ithr = 0xffffu;
    if (eq > need) {
        unsigned lo = 0u;
        for (int bit = 12; bit >= 0; --bit) {
            const unsigned mid = lo + (1u << bit);
            int c = 0;
#pragma unroll
            for (int e = 0; e < 8; ++e) c += bcount(key[e] == prefix && idx[e] < mid);
            if (c < need) lo = mid;
        }
        ithr = lo;
    }
    int base = 0;
#pragma unroll
    for (int e = 0; e < 8; ++e) {
        const bool keep = (key[e] > prefix) || (key[e] == prefix && idx[e] <= ithr);
        const unsigned long long m = __ballot(keep);
        const int pos = base + (int)__builtin_amdgcn_mbcnt_hi((unsigned)(m >> 32), __builtin_amdgcn_mbcnt_lo((unsigned)m, 0u));
        if (keep) { csq[pos] = key2f(key[e]); ciq[pos] = (bf16_t)idx[e]; }
        base += __builtin_popcountll(m);
    }
    lds_fence();
    return key2f(prefix);
}

__device__ __forceinline__ void topk_item(int e, const bf16_t* __restrict__ QI, const bf16_t* __restrict__ KI, const float* __restrict__ WI, unsigned* __restrict__ MASK, lds_t lds) {
    const int tid = otid(), lane = tid & 63, wid = tid >> 6, l31 = lane & 31, hh = lane >> 5;
    const int r8 = e >> 8, c = e & 255, b = c >> 5, j = c & 31;
    const int qb = (r8 < 4) ? (j + 32 * r8) : (255 - (j + 32 * (r8 - 4)));
    const int t0 = qb * 32, tq0 = t0 + 4 * wid;
    const size_t tokb = (size_t)b * S;
    bf16x8 qf[4];
    {
        const int i = l31, qi_ = 2 * ((i >> 2) & 1) + (i >> 4), hd = (i & 3) + 4 * ((i >> 3) & 1);
        const bf16_t* qp = QI + (tokb + tq0 + qi_) * 512 + hd * 64 + 8 * hh;
#pragma unroll
        for (int ks = 0; ks < 4; ++ks) qf[ks] = *(const bf16x8*)(qp + ks * 16);
    }
    float wv[2][8];
#pragma unroll
    for (int a = 0; a < 2; ++a) {
        const f32x4 w0 = *(const f32x4*)(WI + (tokb + tq0 + 2 * hh + a) * 8), w1 = *(const f32x4*)(WI + (tokb + tq0 + 2 * hh + a) * 8 + 4);
#pragma unroll
        for (int q = 0; q < 4; ++q) { wv[a][q] = w0[q]; wv[a][4 + q] = w1[q]; }
    }
    float tau[2] = {-INFINITY, -INFINITY};
    int cnt[4] = {0, 0, 0, 0};
    LAS float* cs = (LAS float*)(lds + TK_CS) + (wid * 4) * TK_CAP;
    LAS bf16_t* ci = (LAS bf16_t*)(lds + TK_CI) + (wid * 4) * TK_CAP;
    LAS unsigned* hist = (LAS unsigned*)(lds + TK_HIST) + wid * 256;
    const int ntiles = qb + 1, nch = (ntiles + 1) >> 1;
    const int srow = tid >> 3, scc = tid & 7;
    const bf16_t* kg = KI + (tokb + srow) * 64 + scc * 8;
    u32x4 kr = *(const u32x4*)kg;
    *(LAS u32x4*)(lds + TK_KST + srow * GROW + scc * 16) = kr;
    __syncthreads();
    for (int ch = 0; ch < nch; ++ch) {
        if (ch + 1 < nch) kr = *(const u32x4*)(kg + (size_t)(ch + 1) * 64 * 64);
        const lds_t kb = lds + TK_KST + (ch & 1) * (64 * GROW);
#pragma unroll
        for (int tl = 0; tl < 2; ++tl) {
            const int tile = 2 * ch + tl;
            if (tile < ntiles) {
                f32x16 acc;
#pragma unroll
                for (int r = 0; r < 16; ++r) acc[r] = 0.f;
#pragma unroll
                for (int ks = 0; ks < 4; ++ks) {
                    const bf16x8 kf = *(LAS bf16x8*)(kb + (tl * 32 + l31) * GROW + (ks * 2 + hh) * 16);
                    acc = MFMA32(qf[ks], kf, acc);
                }
                float sc[2] = {0.f, 0.f};
#pragma unroll
                for (int a = 0; a < 2; ++a)
#pragma unroll
                    for (int h = 0; h < 8; ++h) sc[a] = fmaf(wv[a][h], fmaxf(acc[8 * a + h], 0.f), sc[a]);
                const int key = tile * 32 + l31;
#pragma unroll
                for (int a = 0; a < 2; ++a) {
                    const int tq = tq0 + 2 * hh + a;
                    const bool pass = (sc[a] > tau[a]) && (key <= tq);
                    const unsigned long long m = __ballot(pass);
                    if (m != 0ull) {
                        const unsigned mlo = (unsigned)m, mhi = (unsigned)(m >> 32);
                        const int pre = hh ? (int)__builtin_amdgcn_mbcnt_hi(mhi, 0u) : (int)__builtin_amdgcn_mbcnt_lo(mlo, 0u);
                        const int bc = hh ? cnt[2 + a] : cnt[a];
                        if (pass) { const int pos = (2 * hh + a) * TK_CAP + bc + pre; cs[pos] = sc[a]; ci[pos] = (bf16_t)key; }
                        cnt[a] += __builtin_popcount(mlo); cnt[2 + a] += __builtin_popcount(mhi);
                    }
                }
#pragma unroll
                for (int q = 0; q < 4; ++q) {
                    if (cnt[q] > TK_TRIG) {
                        lds_fence();
                        const float nt_ = prune256(cs + q * TK_CAP, ci + q * TK_CAP, cnt[q], hist, lane);
                        cnt[q] = 256;
                        if ((q >> 1) == hh) { if ((q & 1) == 0) tau[0] = nt_; else tau[1] = nt_; }
                    }
                }
            }
        }
        if (ch + 1 < nch) *(LAS u32x4*)(lds + TK_KST + ((ch + 1) & 1) * (64 * GROW) + srow * GROW + scc * 16) = kr;
        __syncthreads();
    }
    LAS unsigned* mrow = (LAS unsigned*)(lds + TK_MROW) + wid * 256;
#pragma unroll
    for (int q = 0; q < 4; ++q) {
        lds_fence();
        if (cnt[q] > 256) { (void)prune256(cs + q * TK_CAP, ci + q * TK_CAP, cnt[q], hist, lane); cnt[q] = 256; }
        *(LAS u32x4*)(mrow + lane * 4) = (u32x4){0u, 0u, 0u, 0u};
        lds_fence();
#pragma unroll
        for (int e8 = 0; e8 < 8; ++e8) {
            const int i = lane + 64 * e8;
            if (i < cnt[q]) { const unsigned ix = ci[q * TK_CAP + i]; __hip_atomic_fetch_or(mrow + (ix >> 5), 1u << (ix & 31u), __ATOMIC_RELAXED, __HIP_MEMORY_SCOPE_WORKGROUP); }
        }
        lds_fence();
        const u32x4 mv = *(LAS u32x4*)(mrow + lane * 4);
        *(u32x4*)(MASK + (tokb + tq0 + q) * 256 + lane * 4) = mv;
        lds_fence();
    }
    __syncthreads();
}

constexpr int AT_STAGE = 2 * 64 * GROW;

__device__ __forceinline__ void attn_item(int e, const bf16_t* __restrict__ Q, const bf16_t* __restrict__ K, const bf16_t* __restrict__ VT, const unsigned* __restrict__ MASK, bf16_t* __restrict__ mixed, lds_t lds) {
    const int tid = otid(), lane = tid & 63, wid = tid >> 6, l31 = lane & 31, hh = lane >> 5;
    const int r8 = e >> 8, c = e & 255, b = c >> 5, j = c & 31, head = j >> 2, jj = j & 3;
    const int qb = (r8 < 4) ? (jj + 4 * r8) : (31 - (jj + 4 * (r8 - 4)));
    const size_t tokb = (size_t)b * S;
    const int tq = qb * 256 + 32 * wid + l31;
    const size_t tok = tokb + tq;
    bf16x8 qf[4];
#pragma unroll
    for (int ks = 0; ks < 4; ++ks) qf[ks] = *(const bf16x8*)(Q + tok * 512 + head * 64 + ks * 16 + 8 * hh);
    const int nchb = (qb + 1) * 4, nchw = qb * 4 + (wid >> 1) + 1;
    f32x16 O[2];
#pragma unroll
    for (int a = 0; a < 2; ++a)
#pragma unroll
        for (int r = 0; r < 16; ++r) O[a][r] = 0.f;
    float mrun = -1e30f, lrun = 0.f;
    const float L2E = 1.4426950408889634f;
    const int srow = tid >> 3, scc = tid & 7;
    const bf16_t* kg = K + (tokb + srow) * 512 + head * 64 + scc * 8;
    const bf16_t* vg = VT + ((size_t)(b * 8 + head) * 64 + srow) * S + scc * 8;
    const unsigned* mg = MASK + tok * 256;
    const int kap = (l31 & 0x13) | ((l31 & 4) << 1) | ((l31 & 8) >> 1);
    u32x4 kr = *(const u32x4*)kg, vr = *(const u32x4*)vg;
    *(LAS u32x4*)(lds + srow * GROW + scc * 16) = kr;
    *(LAS u32x4*)(lds + 64 * GROW + srow * GROW + scc * 16) = vr;
    __syncthreads();
    for (int ch = 0; ch < nchb; ++ch) {
        if (ch + 1 < nchb) { kr = *(const u32x4*)(kg + (size_t)(ch + 1) * 64 * 512); vr = *(const u32x4*)(vg + (ch + 1) * 64); }
        const lds_t sb = lds + (ch & 1) * AT_STAGE;
        if (ch < nchw) {
            const u32x2 mw = *(const u32x2*)(mg + ch * 2);
            f32x16 sacc[2];
#pragma unroll
            for (int kt = 0; kt < 2; ++kt) {
#pragma unroll
                for (int r = 0; r < 16; ++r) sacc[kt][r] = 0.f;
#pragma unroll
                for (int ks = 0; ks < 4; ++ks) {
                    const bf16x8 kf = *(LAS bf16x8*)(sb + (kt * 32 + kap) * GROW + (ks * 2 + hh) * 16);
                    sacc[kt] = MFMA32(kf, qf[ks], sacc[kt]);
                }
            }
            float mt = -INFINITY;
#pragma unroll
            for (int kt = 0; kt < 2; ++kt) {
                const unsigned wsh = (kt == 0 ? mw.x : mw.y) >> (8 * hh);
#pragma unroll
                for (int r = 0; r < 16; ++r) {
                    const int bit = (r & 7) + 16 * (r >> 3);
                    const unsigned msk = (unsigned)__builtin_amdgcn_sbfe((int)wsh, bit, 1);
                    const float v = __uint_as_float((__float_as_uint(sacc[kt][r]) & msk) | (~msk & 0xff800000u));
                    sacc[kt][r] = v; mt = fmaxf(mt, v);
                }
            }
            mt = fmaxf(mt, __shfl_xor(mt, 32));
            const float mnew = fmaxf(mrun, mt);
            if (__ballot(mnew != mrun) != 0ull) {
                const float alpha = __builtin_amdgcn_exp2f((mrun - mnew) * L2E);
                lrun *= alpha;
#pragma unroll
                for (int a = 0; a < 2; ++a)
#pragma unroll
                    for (int r = 0; r < 16; ++r) O[a][r] *= alpha;
                mrun = mnew;
            }
            const float mb = mrun * L2E;
            bf16x8 pf[2][2];
#pragma unroll
            for (int kt = 0; kt < 2; ++kt) {
                float pv[16];
#pragma unroll
                for (int r = 0; r < 16; ++r) { pv[r] = __builtin_amdgcn_exp2f(fmaf(sacc[kt][r], L2E, -mb)); lrun += pv[r]; }
#pragma unroll
                for (int s = 0; s < 2; ++s) {
                    u32x4 w; w.x = pk_bf16(pv[8 * s], pv[8 * s + 1]); w.y = pk_bf16(pv[8 * s + 2], pv[8 * s + 3]); w.z = pk_bf16(pv[8 * s + 4], pv[8 * s + 5]); w.w = pk_bf16(pv[8 * s + 6], pv[8 * s + 7]);
                    pf[kt][s] = __builtin_bit_cast(bf16x8, w);
                }
            }
#pragma unroll
            for (int dt = 0; dt < 2; ++dt)
#pragma unroll
                for (int kt = 0; kt < 2; ++kt)
#pragma unroll
                    for (int s = 0; s < 2; ++s) {
                        const bf16x8 vf = *(LAS bf16x8*)(sb + 64 * GROW + (dt * 32 + l31) * GROW + (kt * 32 + 16 * s + 8 * hh) * 2);
                        O[dt] = MFMA32(vf, pf[kt][s], O[dt]);
                    }
        }
        if (ch + 1 < nchb) {
            const lds_t nb = lds + ((ch + 1) & 1) * AT_STAGE;
            *(LAS u32x4*)(nb + srow * GROW + scc * 16) = kr;
            *(LAS u32x4*)(nb + 64 * GROW + srow * GROW + scc * 16) = vr;
        }
        __syncthreads();
    }
    const float ltot = lrun + __shfl_xor(lrun, 32);
    const float inv = 1.0f / ltot;
#pragma unroll
    for (int dt = 0; dt < 2; ++dt)
#pragma unroll
        for (int rq = 0; rq < 4; ++rq) {
            u32x2 w; w.x = pk_bf16(O[dt][4 * rq] * inv, O[dt][4 * rq + 1] * inv); w.y = pk_bf16(O[dt][4 * rq + 2] * inv, O[dt][4 * rq + 3] * inv);
            *(u32x2*)(mixed + tok * D + 512 + head * 64 + dt * 32 + 8 * rq + 4 * hh) = w;
        }
}
template <int N> __device__ __forceinline__ void bitonic_desc(int (&a)[N]) {
#pragma unroll
    for (int k = 2; k <= N; k <<= 1)
#pragma unroll
        for (int j = k >> 1; j > 0; j >>= 1)
#pragma unroll
            for (int i = 0; i < N; ++i) {
                const int l = i ^ j;
                if (l > i) {
                    const int hi = max(a[i], a[l]), lo = min(a[i], a[l]);
                    const bool desc = ((i & k) == 0);
                    a[i] = desc ? hi : lo; a[l] = desc ? lo : hi;
                }
            }
}
__device__ __forceinline__ void merge16(int (&a)[16], const int (&b)[16]) {
#pragma unroll
    for (int i = 0; i < 16; ++i) a[i] = max(a[i], b[15 - i]);
#pragma unroll
    for (int j = 8; j > 0; j >>= 1)
#pragma unroll
        for (int i = 0; i < 16; ++i) { const int l = i ^ j; if (l > i) { const int hi = max(a[i], a[l]), lo = min(a[i], a[l]); a[i] = hi; a[l] = lo; } }
}
__device__ __forceinline__ void merge_partner(int (&a)[16]) {
    int b[16];
#pragma unroll
    for (int i = 0; i < 16; ++i) b[i] = __shfl_xor(a[i], 32);
    merge16(a, b);
}
__device__ __forceinline__ int f2skey(float s) { const int b = (int)__float_as_uint(s); return b ^ ((b >> 31) & 0x7fffffff); }
__device__ __forceinline__ float skey2f(int k) { return __uint_as_float((unsigned)(k ^ ((k >> 31) & 0x7fffffff))); }

__device__ __forceinline__ float sel_f(bool c, float a, float b) { asm volatile("" : "+v"(a), "+v"(b)); return c ? a : b; }
__device__ __forceinline__ int sel_i(bool c, int a, int b) { asm volatile("" : "+v"(a), "+v"(b)); return c ? a : b; }
struct CandTab { int ci[64], cj[64]; };
__host__ __device__ constexpr CandTab make_cand() { CandTab t{}; int n = 0; for (int i = 0; i < 16; ++i) for (int j = 0; j < 16; ++j) if ((i + 1) * (j + 1) <= 16) { t.ci[n] = i; t.cj[n] = j; ++n; } return t; }

__device__ __forceinline__ void peersel_item(int tg, int l, const bf16_t* __restrict__ QP, const bf16_t* __restrict__ SK, unsigned* __restrict__ PIDX, float* __restrict__ PG, lds_t lds) {
    const int tid = otid(), lane = tid & 63, head = tid >> 6, l31 = lane & 31, hh = lane >> 5;
    const size_t tok = (size_t)tg * 32 + l31;
    int L[2][16];
#pragma unroll
    for (int p = 0; p < 2; ++p) {
        f32x16 acc[4];
#pragma unroll
        for (int nt = 0; nt < 4; ++nt)
#pragma unroll
            for (int r = 0; r < 16; ++r) acc[nt][r] = 0.f;
        const bf16_t* qp = QP + tok * 2048 + (head * 2 + p) * 128 + 8 * hh;
        const bf16_t* sk = SK + ((size_t)((l * 8 + head) * 2 + p) * 128 + l31) * 128 + 8 * hh;
        asm volatile("" : "+v"(sk));
#pragma unroll 2
        for (int ks = 0; ks < 8; ++ks) {
            const bf16x8 qv = *(const bf16x8*)(qp + ks * 16);
#pragma unroll
            for (int nt = 0; nt < 4; ++nt) { const bf16x8 sv = *(const bf16x8*)(sk + (size_t)nt * 32 * 128 + ks * 16); acc[nt] = MFMA32(sv, qv, acc[nt]); }
        }
#pragma unroll
        for (int nt = 0; nt < 4; ++nt) {
            int g[16];
#pragma unroll
            for (int r = 0; r < 16; ++r) { const int n0 = nt * 32 + (r & 3) + 8 * (r >> 2); g[r] = (f2skey(acc[nt][r]) & ~127) | ((127 - n0) - 4 * hh); }
            bitonic_desc<16>(g);
            if (nt == 0) {
#pragma unroll
                for (int r = 0; r < 16; ++r) L[p][r] = g[r];
            } else merge16(L[p], g);
            __builtin_amdgcn_sched_barrier(0);
        }
        merge_partner(L[p]);
        __builtin_amdgcn_sched_barrier(0);
    }
    LAS unsigned char* nl = (LAS unsigned char*)lds + (size_t)tid * 32;
#pragma unroll
    for (int i = 0; i < 16; ++i) { nl[i] = (unsigned char)(127 - (L[0][i] & 127)); nl[16 + i] = (unsigned char)(127 - (L[1][i] & 127)); }
    float va[16], vb[16];
#pragma unroll
    for (int i = 0; i < 16; ++i) { va[i] = skey2f(L[0][i] & ~127); vb[i] = skey2f(L[1][i] & ~127); }
    constexpr CandTab ct = make_cand();
    int cA[16], cB[16];
#pragma unroll
    for (int m = 0; m < 16; ++m) {
        const float s = sel_f(hh, va[ct.ci[2 * m + 1]], va[ct.ci[2 * m]]) + sel_f(hh, vb[ct.cj[2 * m + 1]], vb[ct.cj[2 * m]]);
        const int code = hh ? (ct.ci[2 * m + 1] * 16 + ct.cj[2 * m + 1]) : (ct.ci[2 * m] * 16 + ct.cj[2 * m]);
        cA[m] = (f2skey(s) & ~255) | (255 - code);
    }
#pragma unroll
    for (int m = 16; m < 32; ++m) {
        if (m < 25) {
            const float s = sel_f(hh, va[ct.ci[2 * m + 1]], va[ct.ci[2 * m]]) + sel_f(hh, vb[ct.cj[2 * m + 1]], vb[ct.cj[2 * m]]);
            const int code = hh ? (ct.ci[2 * m + 1] * 16 + ct.cj[2 * m + 1]) : (ct.ci[2 * m] * 16 + ct.cj[2 * m]);
            cB[m - 16] = (f2skey(s) & ~255) | (255 - code);
        } else cB[m - 16] = (int)0x80000000;
    }
    __builtin_amdgcn_sched_barrier(0);
    bitonic_desc<16>(cA); bitonic_desc<16>(cB);
    merge16(cA, cB);
    merge_partner(cA);
    lds_fence();
    float val[16], ex[16], sum = 0.f;
#pragma unroll
    for (int r = 0; r < 16; ++r) val[r] = skey2f(cA[r] & ~255);
#pragma unroll
    for (int r = 0; r < 16; ++r) { ex[r] = __expf(val[r] - val[0]); sum += ex[r]; }
    const float inv = 1.0f / sum;
#pragma unroll
    for (int r = 0; r < 8; ++r) {
        const int kk = sel_i(hh, cA[8 + r], cA[r]);
        const float gk = sel_f(hh, ex[8 + r], ex[r]) * inv;
        const int code = 255 - (kk & 255);
        const unsigned ia = nl[code >> 4], ib = nl[16 + (code & 15)];
        PIDX[tok * 128 + head * 16 + 8 * hh + r] = ia * 128u + ib;
        PG[tok * 128 + head * 16 + 8 * hh + r] = gk;
    }
}

__device__ __forceinline__ void fp8x16_to_f32(const u32x4 w, float (&f)[16]) {
#pragma unroll
    for (int i = 0; i < 4; ++i) {
        const f32x2 lo = __builtin_amdgcn_cvt_pk_f32_fp8((int)w[i], false), hi = __builtin_amdgcn_cvt_pk_f32_fp8((int)w[i], true);
        f[4 * i] = lo[0]; f[4 * i + 1] = lo[1]; f[4 * i + 2] = hi[0]; f[4 * i + 3] = hi[1];
    }
}
__device__ __forceinline__ void peer_gather(int l, const bf16_t* __restrict__ H, const unsigned* __restrict__ PIDX, const float* __restrict__ PG, const unsigned char* __restrict__ EU, const unsigned char* __restrict__ EV,
                                            const float* __restrict__ ES, const float* __restrict__ gate  , float* __restrict__ x) {
    const int tid = otid(), lane = tid & 63, wid = tid >> 6, g = lane >> 4, j = lane & 15;
    const int nw = gridDim.x * 8;
    const unsigned char* eu = EU + (size_t)l * NEXP * D;
    const unsigned char* ev = EV + (size_t)l * NEXP * D;
    const f32x2* es = (const f32x2*)ES + (size_t)l * NEXP;
    for (int gw = blockIdx.x * 8 + wid; gw * 32 < T; gw += nw) {
        const int b = (gw * 32) / S;
        for (int tr = 0; tr < 32; ++tr) {
            const size_t t = (size_t)gw * 32 + tr;
            float hf[4][16];
#pragma unroll
            for (int i = 0; i < 4; ++i) {
                const u32x4 a = *(const u32x4*)(H + t * D + (j + 16 * i) * 16), c = *(const u32x4*)(H + t * D + (j + 16 * i) * 16 + 8);
#pragma unroll
                for (int q = 0; q < 4; ++q) { hf[i][2 * q] = bf_lo(a[q]); hf[i][2 * q + 1] = bf_hi(a[q]); hf[i][8 + 2 * q] = bf_lo(c[q]); hf[i][8 + 2 * q + 1] = bf_hi(c[q]); }
            }
            const unsigned e0 = PIDX[t * 128 + lane], e1 = PIDX[t * 128 + 64 + lane];
            const float g0 = PG[t * 128 + lane], g1 = PG[t * 128 + 64 + lane];
            float acc[16];
#pragma unroll
            for (int i = 0; i < 16; ++i) acc[i] = 0.f;
            unsigned eid_n = (unsigned)__shfl((int)e0, g); float gt_n = __shfl(g0, g);
            u32x4 un[4]; f32x2 sc_n;
            { const unsigned char* ur = eu + (size_t)eid_n * D + j * 16;
#pragma unroll
              for (int i = 0; i < 4; ++i) un[i] = *(const u32x4*)(ur + i * 256);
              sc_n = es[eid_n]; }
            for (int it = 0; it < 32; ++it) {
                const unsigned eid = eid_n; const float gt = gt_n; const f32x2 sc = sc_n;
                u32x4 uc[4];
#pragma unroll
                for (int i = 0; i < 4; ++i) uc[i] = un[i];
                u32x4 vv[4];
#pragma unroll
                for (int gg = 0; gg < 4; ++gg) { const unsigned ve = (unsigned)__builtin_amdgcn_readlane((int)eid, gg * 16); vv[gg] = *(const u32x4*)(ev + (size_t)ve * D + lane * 16); }
                if (it + 1 < 32) {
                    const int ent = (it + 1) * 4 + g;
                    eid_n = (unsigned)__shfl((int)(it + 1 < 16 ? e0 : e1), ent & 63); gt_n = __shfl(it + 1 < 16 ? g0 : g1, ent & 63);
                    const unsigned char* ur = eu + (size_t)eid_n * D + j * 16;
#pragma unroll
                    for (int i = 0; i < 4; ++i) un[i] = *(const u32x4*)(ur + i * 256);
                    sc_n = es[eid_n];
                }
                float part = 0.f;
#pragma unroll
                for (int i = 0; i < 4; ++i) {
                    float uf[16]; fp8x16_to_f32(uc[i], uf);
#pragma unroll
                    for (int q = 0; q < 16; ++q) part = fmaf(uf[q], hf[i][q], part);
                }
                part += __shfl_xor(part, 1); part += __shfl_xor(part, 2); part += __shfl_xor(part, 4); part += __shfl_xor(part, 8);
                const float a = part * sc[0];
                const float act = gt * 0.5f * a * (1.0f + erff(a * 0.70710678118654752f)) * sc[1];
#pragma unroll
                for (int gg = 0; gg < 4; ++gg) {
                    const float av = __uint_as_float((unsigned)__builtin_amdgcn_readlane((int)__float_as_uint(act), gg * 16));
                    float vf[16]; fp8x16_to_f32(vv[gg], vf);
#pragma unroll
                    for (int q = 0; q < 16; ++q) acc[q] = fmaf(av, vf[q], acc[q]);
                }
            }
            float* xr = x + t * D + lane * 16;
            const float* gr = gate + (size_t)b * 6144 + lane * 16;
#pragma unroll
            for (int q = 0; q < 4; ++q) {
                const f32x4 xo = *(const f32x4*)(xr + 4 * q), gg4 = *(const f32x4*)(gr + 4 * q);
                f32x4 a4; a4[0] = acc[4 * q]; a4[1] = acc[4 * q + 1]; a4[2] = acc[4 * q + 2]; a4[3] = acc[4 * q + 3];
                *(f32x4*)(xr + 4 * q) = xo + gg4 * a4;
            }
        }
    }
}

__global__ void __launch_bounds__(NTHREADS, 2) mega(Params p) {
    __shared__ __attribute__((aligned(16))) unsigned char smem_raw[LDS_BYTES];
    lds_t lds = (lds_t)smem_raw;
    unsigned char* ws = p.ws;
    volatile LAS unsigned* st = (volatile LAS unsigned*)(lds + 147456);
    if (threadIdx.x == 0) { st[0] = 0u; st[1] = 0u; st[2] = 0u; st[3] = 0u; }
    __syncthreads();
    XcdBarrier bar = xcd_barrier_post((unsigned*)(ws + WS_CTL), st);
    const int lo = p.ph_lo, hi = p.ph_hi, G = gridDim.x, bid = blockIdx.x;
#define RUN(n) ((n) >= lo && (n) < hi)
#define SEAM(n) do { if ((n) >= lo && (n) + 1 < hi) xcd_barrier(bar); } while (0)

    float* modp = (float*)(ws + WS_MOD);
    bf16_t* Hb = (bf16_t*)(ws + WS_H);

    if (RUN(0)) phase_prologue(p, lds);
    SEAM(0);
    for (int l = 0; l < DEPTH; ++l) {
        const int pb = 1 + 9 * l;
        const float* xin = (l == 0) ? p.x : p.out;
        const float* modl = modp + (size_t)l * NB * 6144;
        if (RUN(pb + 0)) phase_norm<0>(xin, p.norm_mix + (size_t)l * D, modl + 0, modl + 1024, Hb, nullptr);
        SEAM(pb + 0);
        if (RUN(pb + 1)) {
            EpiIn ep; ep.xp = (bf16_t*)(ws + WS_XP); ep.q = (bf16_t*)(ws + WS_Q); ep.k = (bf16_t*)(ws + WS_K); ep.vt = (bf16_t*)(ws + WS_VT); ep.qi = (bf16_t*)(ws + WS_QI); ep.ki = (bf16_t*)(ws + WS_KI);
            ep.wi = (float*)(ws + WS_WI); ep.rope = (const float*)(ws + WS_ROPE);
            gemm_phase(Hb, (const bf16_t*)(ws + WS_WIN) + (size_t)l * NIN * D, NIN, ep, lds);
        }
        SEAM(pb + 1);
        if (RUN(pb + 2)) {
            for (int e = bid; e < 2048; e += G) topk_item(e, (const bf16_t*)(ws + WS_QI), (const bf16_t*)(ws + WS_KI), (const float*)(ws + WS_WI), (unsigned*)(ws + WS_MASK), lds);
            for (int e = bid; e < 2048; e += G) pool_item(e, (const bf16_t*)(ws + WS_XP), (const bf16_t*)(ws + WS_WPOOL) + (size_t)l * 4 * 128 * 128, p.pool_scale + (size_t)l * 512, Hb, lds);
        }
        SEAM(pb + 2);
        if (RUN(pb + 3)) {
            for (int e = bid; e < 2048; e += G) attn_item(e, (const bf16_t*)(ws + WS_Q), (const bf16_t*)(ws + WS_K), (const bf16_t*)(ws + WS_VT), (const unsigned*)(ws + WS_MASK), Hb, lds);
        }
        SEAM(pb + 3);
        if (RUN(pb + 4)) {
            EpiOut ep; ep.xin = xin; ep.xout = p.out; ep.gate = modl + 2 * 1024;
            gemm_phase(Hb, (const bf16_t*)(ws + WS_WOUT) + (size_t)l * D * D, D, ep, lds);
        }
        SEAM(pb + 4);
        if (RUN(pb + 5)) phase_norm<0>(p.out, p.norm_ffn + (size_t)l * D, modl + 3 * 1024, modl + 4 * 1024, Hb, nullptr);
        SEAM(pb + 5);
        if (RUN(pb + 6)) {
            EpiBf ep; ep.C = (bf16_t*)(ws + WS_QP); ep.ldc = 2048;
            gemm_phase(Hb, (const bf16_t*)(ws + WS_WQ) + (size_t)l * 2048 * D, 2048, ep, lds);
        }
        SEAM(pb + 6);
        if (RUN(pb + 7)) {
            for (int e = bid; e < 2048; e += G) peersel_item(e, l, (const bf16_t*)(ws + WS_QP), (const bf16_t*)(ws + WS_SK), (unsigned*)(ws + WS_PIDX), (float*)(ws + WS_PG), lds);
        }
        SEAM(pb + 7);
        if (RUN(pb + 8)) peer_gather(l, Hb, (const unsigned*)(ws + WS_PIDX), (const float*)(ws + WS_PG), (const unsigned char*)(ws + WS_EU), (const unsigned char*)(ws + WS_EV), (const float*)(ws + WS_ES), modl + 5 * 1024, p.out);
        SEAM(pb + 8);
    }
    if (RUN(19)) phase_norm<1>(p.out, p.final_norm, nullptr, nullptr, nullptr, p.out);
#undef RUN
#undef SEAM
}


#ifndef MK_CHECK
#define MK_CHECK 0
#endif
#ifndef MK_CHECK_LAYER
#define MK_CHECK_LAYER 0
#endif
#ifndef MK_CHECK_SLOT0
#define MK_CHECK_SLOT0 10
#endif
#if MK_CHECK
__device__ __forceinline__ unsigned hash32(unsigned x) { x ^= x >> 16; x *= 0x7feb352dU; x ^= x >> 15; x *= 0x846ca68bU; x ^= x >> 16; return x; }
__device__ __forceinline__ float bfv(const bf16_t* p, size_t i) { return __uint_as_float((unsigned)p[i] << 16); }
__device__ __forceinline__ bool badrel(float got, float ref, float rtol, float atol) { return !(fabsf(got - ref) <= atol + rtol * fabsf(ref)); }
#define DIAG(p) ((unsigned*)((p).ws + WS_CTL + 32768))
constexpr size_t WS_XCOPY = 746 * MBy;

__global__ void chk_mod(Params p) {
    const unsigned id = blockIdx.x * blockDim.x + threadIdx.x;
    const unsigned h = hash32(id * 3u + 1u);
    const int l = h & 1, b = (h >> 1) & 7, j = (h >> 4) % 6144;
    float s = 0.f;
    for (int k = 0; k < D; ++k) { const float c = p.c[b * D + k]; s += (c / (1.f + expf(-c))) * p.w_ada[((size_t)l * D + k) * 6144 + j]; }
    s += p.b_ada[l * 6144 + j];
    const float got = ((const float*)(p.ws + WS_MOD))[((size_t)l * NB + b) * 6144 + j];
    if (badrel(got, s, 1e-3f, 1e-4f)) atomicAdd(DIAG(p) + 0, 1u);
}
__global__ void chk_norm(Params p, int l, int which, const float* xin, int slot) {
    const unsigned id = blockIdx.x * blockDim.x + threadIdx.x;
    const unsigned h = hash32(id * 7u + 3u);
    const int t = h % T, b = t / S;
    const float* xr = xin + (size_t)t * D;
    float ss = 0.f; for (int k = 0; k < D; ++k) ss += xr[k] * xr[k];
    const float rstd = 1.0f / sqrtf(ss / D + 1e-6f);
    const float* modl = (const float*)(p.ws + WS_MOD) + ((size_t)l * NB + b) * 6144;
    const float* gw = (which ? p.norm_ffn : p.norm_mix) + (size_t)l * D;
    const float* sh = modl + (which ? 3 : 0) * 1024; const float* sc = modl + (which ? 4 : 1) * 1024;
    const bf16_t* hb = (const bf16_t*)(p.ws + WS_H);
    for (int q = 0; q < 4; ++q) {
        const int n = hash32(h + q) % D;
        const float ref = xr[n] * rstd * gw[n] * (1.f + sc[n]) + sh[n];
        if (badrel(bfv(hb, (size_t)t * D + n), ref, 1e-2f, 1e-2f)) atomicAdd(DIAG(p) + slot, 1u);
    }
}
__device__ float dot_h_w(const bf16_t* hrow, const float* w, int ldw, int n) { float s = 0.f; for (int k = 0; k < D; ++k) s += bfv(hrow, k) * w[(size_t)k * ldw + n]; return s; }
__global__ void chk_in(Params p, int l) {
    const unsigned id = blockIdx.x * blockDim.x + threadIdx.x;
    const unsigned h = hash32(id * 11u + 5u);
    const int t = h % T; const int n = hash32(h) % DIN;
    const bf16_t* hrow = (const bf16_t*)(p.ws + WS_H) + (size_t)t * D;
    const float* w = p.w_in + (size_t)l * D * DIN;
    const float* rope = (const float*)(p.ws + WS_ROPE) + (size_t)t * 16;
    const int b = t / S, s = t % S;
    float ref, got; int slot = 2;
    auto roped = [&](int base, int d) -> float {
        if (d >= 16) return dot_h_w(hrow, w, DIN, base + d);
        const int f = d & 7; const float x1 = dot_h_w(hrow, w, DIN, base + f), x2 = dot_h_w(hrow, w, DIN, base + 8 + f);
        return d < 8 ? x1 * rope[f] - x2 * rope[8 + f] : x1 * rope[8 + f] + x2 * rope[f];
    };
    if (n < 512) { ref = dot_h_w(hrow, w, DIN, n); got = bfv((const bf16_t*)(p.ws + WS_XP), (size_t)t * 512 + n); }
    else if (n < 1024) { const int c = n - 512; ref = roped(512 + (c & ~63), c & 63) * 0.125f; got = bfv((const bf16_t*)(p.ws + WS_Q), (size_t)t * 512 + c); }
    else if (n < 1536) { const int c = n - 1024; ref = roped(1024 + (c & ~63), c & 63); got = bfv((const bf16_t*)(p.ws + WS_K), (size_t)t * 512 + c); }
    else if (n < 2048) { const int c = n - 1536; ref = dot_h_w(hrow, w, DIN, n); got = bfv((const bf16_t*)(p.ws + WS_VT), ((size_t)(b * 8 + (c >> 6)) * 64 + (c & 63)) * S + s); }
    else if (n < 2560) { const int c = n - 2048; ref = roped(2048 + (c & ~63), c & 63) * 0.125f; got = bfv((const bf16_t*)(p.ws + WS_QI), (size_t)t * 512 + c); }
    else if (n < 2624) { const int c = n - 2560; ref = roped(2560, c); got = bfv((const bf16_t*)(p.ws + WS_KI), (size_t)t * 64 + c); }
    else { const int c = n - 2624; ref = dot_h_w(hrow, w, DIN, n) * 0.35355339f; got = ((const float*)(p.ws + WS_WI))[(size_t)t * 8 + c]; }
    if (badrel(got, ref, 2e-2f, 3e-2f)) atomicAdd(DIAG(p) + slot, 1u);
}
__global__ void chk_pool(Params p, int l) {
    const unsigned id = blockIdx.x * blockDim.x + threadIdx.x;
    const unsigned h = hash32(id * 13u + 7u);
    const int t = h % T, s = t % S; const int n = hash32(h) % 512, g = n >> 7, d = n & 127, w = 2 << g;
    const bf16_t* xp = (const bf16_t*)(p.ws + WS_XP);
    float ref = 0.f;
    for (int c = 0; c < 128; ++c) {
        float sum = 0.f; int cnt = 0;
        for (int jj = 0; jj < w; ++jj) if (s - jj >= 0) { sum += bfv(xp, (size_t)(t - jj) * 512 + g * 128 + c); ++cnt; }
        const float pooled = sum / (float)cnt - bfv(xp, (size_t)t * 512 + g * 128 + c);
        ref += pooled * p.w_pool[(((size_t)l * 4 + g) * 128 + c) * 128 + d];
    }
    ref *= p.pool_scale[l * 512 + n];
    if (badrel(bfv((const bf16_t*)(p.ws + WS_H), (size_t)t * D + n), ref, 3e-2f, 3e-2f)) atomicAdd(DIAG(p) + 3, 1u);
}
__global__ void __launch_bounds__(512) chk_topk(Params p) {
    __shared__ float sc[S];
    __shared__ int nbad;
    const unsigned h = hash32(blockIdx.x * 17u + 9u);
    const int b = h & 7; int tq = (h >> 3) % S; if (blockIdx.x < 8) tq = blockIdx.x * 40;
    const size_t tokb = (size_t)b * S;
    const bf16_t* QI = (const bf16_t*)(p.ws + WS_QI); const bf16_t* KI = (const bf16_t*)(p.ws + WS_KI); const float* WI = (const float*)(p.ws + WS_WI);
    if (threadIdx.x == 0) nbad = 0;
    for (int s = threadIdx.x; s <= tq; s += 512) {
        float tot = 0.f;
        for (int hd = 0; hd < 8; ++hd) { float dsum = 0.f; for (int d = 0; d < 64; ++d) dsum += bfv(QI, (tokb + tq) * 512 + hd * 64 + d) * bfv(KI, (tokb + s) * 64 + d); tot += WI[(tokb + tq) * 8 + hd] * fmaxf(dsum, 0.f); }
        sc[s] = tot;
    }
    __syncthreads();
    int bad = 0;
    for (int s = threadIdx.x; s < S; s += 512) {
        bool sel = false;
        if (s <= tq) { const float v = sc[s]; int rank = 0; for (int s2 = 0; s2 <= tq; ++s2) { const float v2 = sc[s2]; rank += (v2 > v || (v2 == v && s2 < s)) ? 1 : 0; } sel = rank < 256; }
        const unsigned wmask = ((const unsigned*)(p.ws + WS_MASK))[(tokb + tq) * 256 + (s >> 5)];
        if (((wmask >> (s & 31)) & 1u) != (sel ? 1u : 0u)) ++bad;
    }
    atomicAdd(&nbad, bad);
    __syncthreads();
    if (threadIdx.x == 0 && nbad > 6) atomicAdd(DIAG(p) + 4, 1u);
}
__global__ void chk_attn(Params p) {
    const unsigned id = blockIdx.x * blockDim.x + threadIdx.x;
    const unsigned h = hash32(id * 19u + 11u);
    const int t = h % T, b = t / S, tq = t % S, head = (h >> 20) & 7, d = (h >> 24) & 63;
    const size_t tokb = (size_t)b * S;
    const bf16_t* Q = (const bf16_t*)(p.ws + WS_Q); const bf16_t* K = (const bf16_t*)(p.ws + WS_K); const bf16_t* VT = (const bf16_t*)(p.ws + WS_VT);
    const unsigned* M = (const unsigned*)(p.ws + WS_MASK) + (size_t)t * 256;
    float mx = -1e30f;
    for (int s = 0; s <= tq; ++s) if ((M[s >> 5] >> (s & 31)) & 1u) { float lg = 0.f; for (int e = 0; e < 64; ++e) lg += bfv(Q, (size_t)t * 512 + head * 64 + e) * bfv(K, (tokb + s) * 512 + head * 64 + e); mx = fmaxf(mx, lg); }
    float den = 0.f, num = 0.f;
    for (int s = 0; s <= tq; ++s) if ((M[s >> 5] >> (s & 31)) & 1u) { float lg = 0.f; for (int e = 0; e < 64; ++e) lg += bfv(Q, (size_t)t * 512 + head * 64 + e) * bfv(K, (tokb + s) * 512 + head * 64 + e); const float pe = expf(lg - mx); den += pe; num += pe * bfv(VT, ((size_t)(b * 8 + head) * 64 + d) * S + s); }
    const float ref = num / den;
    if (badrel(bfv((const bf16_t*)(p.ws + WS_H), (size_t)t * D + 512 + head * 64 + d), ref, 3e-2f, 1e-2f)) atomicAdd(DIAG(p) + 5, 1u);
}
__global__ void chk_out(Params p, int l, const float* xin) {
    const unsigned id = blockIdx.x * blockDim.x + threadIdx.x;
    const unsigned h = hash32(id * 23u + 13u);
    const int t = h % T, b = t / S, n = hash32(h) % D;
    const bf16_t* mrow = (const bf16_t*)(p.ws + WS_H) + (size_t)t * D;
    float s = 0.f; for (int k = 0; k < D; ++k) s += bfv(mrow, k) * p.w_out[((size_t)l * D + k) * D + n];
    const float g1 = ((const float*)(p.ws + WS_MOD))[((size_t)l * NB + b) * 6144 + 2048 + n];
    const float ref = xin[(size_t)t * D + n] + g1 * s;
    if (badrel(p.out[(size_t)t * D + n], ref, 1e-2f, 1e-2f)) atomicAdd(DIAG(p) + 6, 1u);
}
__global__ void chk_q(Params p, int l) {
    const unsigned id = blockIdx.x * blockDim.x + threadIdx.x;
    const unsigned h = hash32(id * 29u + 17u);
    const int t = h % T, n = hash32(h) % 2048;
    const bf16_t* hrow = (const bf16_t*)(p.ws + WS_H) + (size_t)t * D;
    const float ref = dot_h_w(hrow, p.w_query + (size_t)l * D * 2048, 2048, n);
    if (badrel(bfv((const bf16_t*)(p.ws + WS_QP), (size_t)t * 2048 + n), ref, 2e-2f, 3e-2f)) atomicAdd(DIAG(p) + 8, 1u);
}
__global__ void __launch_bounds__(64) chk_sel(Params p, int l) {
    __shared__ float tv[2][16][64]; __shared__ int ti[2][16][64]; __shared__ float cv[16][64]; __shared__ int cid[16][64];
    const int x = threadIdx.x;
    const unsigned id = blockIdx.x * blockDim.x + threadIdx.x;
    const unsigned h = hash32(id * 31u + 19u);
    const int t = h % T, head = (h >> 20) & 7;
    const bf16_t* QP = (const bf16_t*)(p.ws + WS_QP);
    for (int pp = 0; pp < 2; ++pp) {
        for (int i = 0; i < 16; ++i) { tv[pp][i][x] = -1e30f; ti[pp][i][x] = -1; }
        for (int n = 0; n < 128; ++n) {
            float s = 0.f; for (int d = 0; d < 128; ++d) s += bfv(QP, (size_t)t * 2048 + (head * 2 + pp) * 128 + d) * p.sub_keys[((((size_t)l * 8 + head) * 2 + pp) * 128 + n) * 128 + d];
            int pos = 16; for (int i = 15; i >= 0; --i) if (s > tv[pp][i][x]) pos = i;
            for (int i = 15; i > pos; --i) { tv[pp][i][x] = tv[pp][i - 1][x]; ti[pp][i][x] = ti[pp][i - 1][x]; }
            if (pos < 16) { tv[pp][pos][x] = s; ti[pp][pos][x] = n; }
        }
    }
    for (int i = 0; i < 16; ++i) { cv[i][x] = -1e30f; cid[i][x] = -1; }
    for (int i = 0; i < 16; ++i) for (int j = 0; j < 16; ++j) {
        const float s = tv[0][i][x] + tv[1][j][x];
        int pos = 16; for (int q = 15; q >= 0; --q) if (s > cv[q][x]) pos = q;
        for (int q = 15; q > pos; --q) { cv[q][x] = cv[q - 1][x]; cid[q][x] = cid[q - 1][x]; }
        if (pos < 16) { cv[pos][x] = s; cid[pos][x] = ti[0][i][x] * 128 + ti[1][j][x]; }
    }
    float den = 0.f; for (int i = 0; i < 16; ++i) den += expf(cv[i][x] - cv[0][x]);
    const unsigned* PI = (const unsigned*)(p.ws + WS_PIDX) + (size_t)t * 128 + head * 16; const float* PGp = (const float*)(p.ws + WS_PG) + (size_t)t * 128 + head * 16;
    int miss = 0;
    for (int i = 0; i < 16; ++i) {
        const float g = expf(cv[i][x] - cv[0][x]) / den; bool found = false;
        for (int q = 0; q < 16; ++q) if ((int)PI[q] == cid[i][x]) { found = true; if (badrel(PGp[q], g, 5e-2f, 2e-3f)) ++miss; }
        if (!found) ++miss;
    }
    if (miss > 2) atomicAdd(DIAG(p) + 9, 1u);
}
__global__ void chk_gather(Params p, int l) {
    const unsigned id = blockIdx.x * blockDim.x + threadIdx.x;
    const unsigned h = hash32(id * 37u + 23u);
    const int t = h % T, b = t / S, n = hash32(h) % D;
    const bf16_t* hrow = (const bf16_t*)(p.ws + WS_H) + (size_t)t * D;
    const unsigned* PI = (const unsigned*)(p.ws + WS_PIDX) + (size_t)t * 128; const float* PGp = (const float*)(p.ws + WS_PG) + (size_t)t * 128;
    float o = 0.f;
    for (int e = 0; e < 128; ++e) {
        const size_t ex = (size_t)l * NEXP + PI[e];
        float a = 0.f; for (int k = 0; k < D; ++k) a += bfv(hrow, k) * p.expert_u[ex * D + k];
        const float act = PGp[e] * 0.5f * a * (1.f + erff(a * 0.70710678f));
        o += act * p.expert_v[ex * D + n];
    }
    const float g2 = ((const float*)(p.ws + WS_MOD))[((size_t)l * NB + b) * 6144 + 5 * 1024 + n];
    const float ref = ((const float*)(p.ws + WS_XCOPY))[(size_t)t * D + n] + g2 * o;
    if (badrel(p.out[(size_t)t * D + n], ref, 1e-2f, 1e-2f)) atomicAdd(DIAG(p) + 10, 1u);
}
__global__ void chk_fill(Params p, int s0) {
    const unsigned* dg = DIAG(p);
    const unsigned total[11] = {4096, 4096, 4096, 4096, 64, 1024, 4096, 4096, 4096, 1024, 512};
    float E = 0.f;
    for (int i = 0; i < 5; ++i) { const int sl = s0 + i; if (sl < 11 && dg[sl] * 50u > total[sl]) E += (float)(1 << i); }
    const size_t n = (size_t)T * D, stride = (size_t)gridDim.x * blockDim.x;
    for (size_t i = (size_t)blockIdx.x * blockDim.x + threadIdx.x; i < n; i += stride) p.out[i] = E;
}
#endif

#ifndef MK_TRUNC
#define MK_TRUNC 0
#endif
#if MK_TRUNC
__global__ void __launch_bounds__(256) dump_kernel(Params p, int which) {
    unsigned char* ws = p.ws;
    const size_t n = (size_t)T * D, stride = (size_t)gridDim.x * 256;
    for (size_t i = (size_t)blockIdx.x * 256 + threadIdx.x; i < n; i += stride) {
        const size_t t = i / D; const int c = (int)(i % D);
        float v = 0.f;
        if (which == 2) {
            const bf16_t* xp = (const bf16_t*)(ws + WS_XP); const bf16_t* q = (const bf16_t*)(ws + WS_Q); const bf16_t* k = (const bf16_t*)(ws + WS_K); const bf16_t* vt = (const bf16_t*)(ws + WS_VT);
            const bf16_t* qi = (const bf16_t*)(ws + WS_QI); const bf16_t* ki = (const bf16_t*)(ws + WS_KI); const float* wi = (const float*)(ws + WS_WI);
            const int cc = c & 511;
            v = bf_lo(xp[t * 512 + cc]) + bf_lo(q[t * 512 + cc]) + bf_lo(k[t * 512 + cc]) + bf_lo(vt[t * 512 + cc]) + bf_lo(qi[t * 512 + cc]) + bf_lo(ki[t * 64 + (cc & 63)]) + wi[t * 8 + (cc & 7)];
        } else if (which == 3) {
            const unsigned* m = (const unsigned*)(ws + WS_MASK); const bf16_t* hb = (const bf16_t*)(ws + WS_H);
            v = (float)(m[t * 256 + (c & 255)] & 0xffffu) + (float)(m[t * 256 + (c & 255)] >> 16) + bf_lo(hb[t * D + (c & 511)]);
        } else if (which == 4) {
            const bf16_t* hb = (const bf16_t*)(ws + WS_H); v = bf_lo(hb[t * D + c]);
        } else if (which == 7) {
            const bf16_t* qp = (const bf16_t*)(ws + WS_QP); v = bf_lo(qp[t * 2048 + c]) + bf_lo(qp[t * 2048 + 1024 + c]);
        } else if (which == 8) {
            const unsigned* pi = (const unsigned*)(ws + WS_PIDX); const float* pg = (const float*)(ws + WS_PG);
            v = (float)pi[t * 128 + (c & 127)] + pg[t * 128 + (c & 127)];
        }
        p.out[i] = v;
    }
}
#endif

extern "C" void kernel_launch(void* const* d_in, const int* in_sizes, int n_in, void* d_out, int out_size, void* d_ws, size_t ws_size, hipStream_t stream) {
    static int grid = 0;
    if (grid == 0) {
        if (n_in != 16 || out_size != T * D || ws_size < WS_END) { fprintf(stderr, "kernel_launch: unexpected shapes (n_in %d, out %d, ws %zu)\n", n_in, out_size, ws_size); grid = -1; return; }
        int dev = 0, cus = 0, per_cu = 0;
        if (hipGetDevice(&dev) != hipSuccess || hipDeviceGetAttribute(&cus, hipDeviceAttributeMultiprocessorCount, dev) != hipSuccess) { grid = -1; return; }
        if (hipOccupancyMaxActiveBlocksPerMultiprocessor(&per_cu, (const void*)mega, NTHREADS, 0) != hipSuccess || per_cu < 1) fprintf(stderr, "kernel_launch: occupancy query says %d\n", per_cu);
        (void)hipGetLastError();
        grid = cus;
    }
    if (grid < 0) return;
    (void)hipMemsetAsync((char*)d_ws + WS_CTL, 0, 64 * 1024, stream);
#ifdef MK_DBG_CLEAR
    (void)hipMemsetAsync((char*)d_ws, 0, WS_END, stream); (void)hipMemsetAsync(d_out, 0, (size_t)T * D * 4, stream);
#endif
    Params p{};
    p.x = (const float*)d_in[0]; p.c = (const float*)d_in[1]; p.pos = (const int*)d_in[2];
    p.w_ada = (const float*)d_in[3]; p.b_ada = (const float*)d_in[4]; p.norm_mix = (const float*)d_in[5]; p.w_in = (const float*)d_in[6]; p.w_pool = (const float*)d_in[7];
    p.pool_scale = (const float*)d_in[8]; p.w_out = (const float*)d_in[9]; p.norm_ffn = (const float*)d_in[10]; p.w_query = (const float*)d_in[11]; p.sub_keys = (const float*)d_in[12];
    p.expert_u = (const float*)d_in[13]; p.expert_v = (const float*)d_in[14]; p.final_norm = (const float*)d_in[15];
    p.out = (float*)d_out; p.ws = (unsigned char*)d_ws;
#if MK_CHECK
    {
        auto run = [&](int ph) { p.ph_lo = ph; p.ph_hi = ph + 1; hipLaunchKernelGGL(mega, dim3(grid), dim3(NTHREADS), 0, stream, p); };
        const int L = MK_CHECK_LAYER; const int pb = 1 + 9 * L;
        for (int ph = 0; ph < pb; ++ph) run(ph);
        const float* xin = (L == 0) ? p.x : p.out;
        hipLaunchKernelGGL(chk_mod, dim3(16), dim3(256), 0, stream, p);
        run(pb + 0); hipLaunchKernelGGL(chk_norm, dim3(4), dim3(256), 0, stream, p, L, 0, xin, 1);
        run(pb + 1); hipLaunchKernelGGL(chk_in, dim3(16), dim3(256), 0, stream, p, L);
        run(pb + 2); hipLaunchKernelGGL(chk_pool, dim3(16), dim3(256), 0, stream, p, L); hipLaunchKernelGGL(chk_topk, dim3(64), dim3(512), 0, stream, p);
        run(pb + 3); hipLaunchKernelGGL(chk_attn, dim3(4), dim3(256), 0, stream, p);
        if (L == 1) (void)hipMemcpyAsync((char*)d_ws + WS_XCOPY, d_out, (size_t)T * D * 4, hipMemcpyDeviceToDevice, stream);
        run(pb + 4); hipLaunchKernelGGL(chk_out, dim3(16), dim3(256), 0, stream, p, L, (L == 0) ? p.x : (const float*)((char*)d_ws + WS_XCOPY));
        run(pb + 5); hipLaunchKernelGGL(chk_norm, dim3(4), dim3(256), 0, stream, p, L, 1, (const float*)p.out, 7);
        run(pb + 6); hipLaunchKernelGGL(chk_q, dim3(16), dim3(256), 0, stream, p, L);
        run(pb + 7); hipLaunchKernelGGL(chk_sel, dim3(16), dim3(64), 0, stream, p, L);
        (void)hipMemcpyAsync((char*)d_ws + WS_XCOPY, d_out, (size_t)T * D * 4, hipMemcpyDeviceToDevice, stream);
        run(pb + 8); hipLaunchKernelGGL(chk_gather, dim3(2), dim3(256), 0, stream, p, L);
        hipLaunchKernelGGL(chk_fill, dim3(2048), dim3(256), 0, stream, p, (int)MK_CHECK_SLOT0);
    }
#elif MK_TRUNC
    for (int ph = 0; ph <= MK_TRUNC; ++ph) { p.ph_lo = ph; p.ph_hi = ph + 1; hipLaunchKernelGGL(mega, dim3(grid), dim3(NTHREADS), 0, stream, p); }
    if (MK_TRUNC != 5 && MK_TRUNC != 9) hipLaunchKernelGGL(dump_kernel, dim3(2048), dim3(256), 0, stream, p, (int)MK_TRUNC);
#elif MK_MULTI
    for (int ph = 0; ph < NPH; ++ph) { p.ph_lo = ph; p.ph_hi = ph + 1; hipLaunchKernelGGL(mega, dim3(grid), dim3(NTHREADS), 0, stream, p); }
#else
    p.ph_lo = 0; p.ph_hi = NPH;
    hipLaunchKernelGGL(mega, dim3(grid), dim3(NTHREADS), 0, stream, p);
#endif
    const hipError_t le = hipPeekAtLastError();
    if (le != hipSuccess) fprintf(stderr, "kernel_launch: launch failed: %s\n", hipGetErrorName(le));
}
```

```cpp
#include <hip/hip_runtime.h>
#include <stdint.h>
#include <stdio.h>

#ifndef MK_DUP
#define MK_DUP 0
#endif
#ifndef MK_DUPVAR
#define MK_DUPVAR 0
#endif
#ifndef MK_MULTI
#define MK_MULTI 0
#endif

#define LAS __attribute__((address_space(3)))
typedef unsigned short bf16_t;
typedef short bf16x8 __attribute__((ext_vector_type(8)));
typedef float f32x16 __attribute__((ext_vector_type(16)));
typedef float f32x4 __attribute__((ext_vector_type(4)));
typedef float f32x2 __attribute__((ext_vector_type(2)));
typedef unsigned u32x4 __attribute__((ext_vector_type(4)));
typedef unsigned u32x2 __attribute__((ext_vector_type(2)));
typedef __bf16 bf16v2 __attribute__((ext_vector_type(2)));
typedef LAS unsigned char* lds_t;

constexpr int D = 1024, NB = 8, S = 8192, T = NB * S, DEPTH = 2;
constexpr int NIN = 2816;
constexpr int DIN = 2632;
constexpr int NEXP = 16384;
constexpr int NTHREADS = 512;
constexpr int LDS_BYTES = 148480;

constexpr size_t MBy = 1u << 20;
constexpr size_t WS_CTL = 0;
constexpr size_t WS_MOD = 64 * 1024;
constexpr size_t WS_ROPE = 1 * MBy;
constexpr size_t WS_WIN = 5 * MBy;
constexpr size_t WS_WOUT = 16 * MBy;
constexpr size_t WS_WQ = 20 * MBy;
constexpr size_t WS_WPOOL = 28 * MBy;
constexpr size_t WS_SK = 29 * MBy;
constexpr size_t WS_EU = 30 * MBy;
constexpr size_t WS_EV = 94 * MBy;
constexpr size_t WS_H = 158 * MBy;
constexpr size_t WS_XP = 286 * MBy;
constexpr size_t WS_Q = 350 * MBy;
constexpr size_t WS_K = 414 * MBy;
constexpr size_t WS_VT = 478 * MBy;
constexpr size_t WS_QP = WS_XP;
constexpr size_t WS_QI = 542 * MBy;
constexpr size_t WS_KI = 606 * MBy;
constexpr size_t WS_WI = 614 * MBy;
constexpr size_t WS_MASK = 616 * MBy;
constexpr size_t WS_PIDX = 680 * MBy;
constexpr size_t WS_PG = 712 * MBy;
constexpr size_t WS_ES = 744 * MBy;
constexpr size_t WS_END = 745 * MBy;
constexpr int NPH = 20;

struct Params {
    const float *x, *c; const int* pos;
    const float *w_ada, *b_ada, *norm_mix, *w_in, *w_pool, *pool_scale, *w_out, *norm_ffn, *w_query, *sub_keys, *expert_u, *expert_v, *final_norm;
    float* out; unsigned char* ws; int ph_lo, ph_hi;
};

#define XB_TMO      128
#define XB_XCNT(j)  (256  + 64 * (j))
#define XB_XSUB(j)  (1280 + 64 * (j))
#define XB_XGEN(j)  (2304 + 64 * (j))
#define XB_TOP      3328
#define XB_TOPGEN   3392
#define XCD_BAR_WORDS 3456
#define XB_SPIN_CAP (1u << 22)

__device__ __forceinline__ unsigned xb_ld(unsigned* p)              { return __hip_atomic_load(p, __ATOMIC_RELAXED, __HIP_MEMORY_SCOPE_AGENT); }
__device__ __forceinline__ unsigned xb_add(unsigned* p, unsigned v) { return __hip_atomic_fetch_add(p, v, __ATOMIC_RELAXED, __HIP_MEMORY_SCOPE_AGENT); }
__device__ __forceinline__ unsigned xb_xcc_id() { return (unsigned)__builtin_amdgcn_s_getreg((3 << 11) | 20) & 0xFu; }
#define XB_SPIN(cond, bar) do { unsigned _sp = 0; while (cond) { __builtin_amdgcn_s_sleep(1); \
    if ((++_sp & 255u) == 0u) { if (xb_ld(&(bar)[XB_TMO])) break; if (_sp > XB_SPIN_CAP) { atomicAdd(&(bar)[XB_TMO], 1u); break; } } } } while (0)

struct XcdBarrier { unsigned* bar; unsigned x; volatile LAS unsigned* st; };

__device__ __forceinline__ XcdBarrier xcd_barrier_post(unsigned* bar, volatile LAS unsigned* st) {
    XcdBarrier b; b.bar = bar; b.x = xb_xcc_id(); b.st = st;
    if (threadIdx.x == 0) (void)xb_add(&bar[XB_XCNT(b.x)], 1u);
    return b;
}
__device__ __forceinline__ void xcd_barrier_complete(unsigned* bar, unsigned x, unsigned& nloc, unsigned& nx) {
    const unsigned G = gridDim.x * gridDim.y * gridDim.z;
    unsigned sum, cnt, mine, sp = 0u;
    for (;;) {
        sum = 0u; cnt = 0u; mine = 0u;
#pragma unroll
        for (unsigned j = 0; j < 16; ++j) { const unsigned c = xb_ld(&bar[XB_XCNT(j)]); sum += c; cnt += (c > 0u) ? 1u : 0u; mine = (j == x) ? c : mine; }
        if (sum == G) break;
        __builtin_amdgcn_s_sleep(1);
        if ((++sp & 255u) == 0u) { if (xb_ld(&bar[XB_TMO])) break; if (sp > XB_SPIN_CAP) { atomicAdd(&bar[XB_TMO], 1u); break; } }
    }
    nloc = mine > 0u ? mine : 1u; nx = cnt > 0u ? cnt : 1u;
}
__device__ __forceinline__ void xcd_barrier(const XcdBarrier& b) {
    asm volatile("s_waitcnt vmcnt(0)" ::: "memory");
    __syncthreads();
    if (threadIdx.x == 0) {
        unsigned* bar = b.bar;
        __builtin_amdgcn_s_waitcnt(0);
        unsigned nloc = b.st[0], nx = b.st[1];
        if (nloc == 0u) { xcd_barrier_complete(bar, b.x, nloc, nx); b.st[0] = nloc; b.st[1] = nx; }
        const unsigned old = xb_add(&bar[XB_XSUB(b.x)], 1u);
        const unsigned gen = old / nloc;
        if (old + 1u == (gen + 1u) * nloc) {
            __builtin_amdgcn_fence(__ATOMIC_RELEASE, "agent");
            asm volatile("s_waitcnt vmcnt(0)" ::: "memory");
            const unsigned og = xb_add(&bar[XB_TOP], 1u);
            const unsigned tg = og / nx;
            if (og + 1u == (tg + 1u) * nx) xb_add(&bar[XB_TOPGEN], 1u);
            else XB_SPIN(xb_ld(&bar[XB_TOPGEN]) == tg, bar);
            __builtin_amdgcn_fence(__ATOMIC_ACQUIRE, "agent");
            xb_add(&bar[XB_XGEN(b.x)], 1u);
            asm volatile("s_waitcnt vmcnt(0)" ::: "memory");
        } else {
            XB_SPIN(xb_ld(&bar[XB_XGEN(b.x)]) == gen, bar);
            __builtin_amdgcn_fence(__ATOMIC_ACQUIRE, "agent");
            asm volatile("s_waitcnt vmcnt(0)" ::: "memory");
        }
    }
    __syncthreads();
}

#define MFMA32(a, b, c) __builtin_amdgcn_mfma_f32_32x32x16_bf16((a), (b), (c), 0, 0, 0)
__device__ __forceinline__ unsigned pk_bf16(float lo, float hi) { const f32x2 v = {lo, hi}; return __builtin_bit_cast(unsigned, __builtin_convertvector(v, bf16v2)); }
__device__ __forceinline__ float dot2bf(unsigned a, unsigned b, float c) { return __builtin_amdgcn_fdot2_f32_bf16(__builtin_bit_cast(bf16v2, a), __builtin_bit_cast(bf16v2, b), c, false); }
__device__ __forceinline__ float bf_lo(unsigned u) { return __uint_as_float(u << 16); }
__device__ __forceinline__ float bf_hi(unsigned u) { return __uint_as_float(u & 0xffff0000u); }
__device__ __forceinline__ float wave_sum(float v) {
#pragma unroll
    for (int o = 32; o > 0; o >>= 1) v += __shfl_xor(v, o);
    return v;
}
__device__ __forceinline__ int otid() { int t = threadIdx.x; asm volatile("" : "+v"(t)); return t; }
__device__ __forceinline__ void lds_fence() { asm volatile("s_waitcnt lgkmcnt(0)" ::: "memory"); }

__device__ __forceinline__ void transpose_tile(const float* __restrict__ src, int ldsrc, int Nvalid, bf16_t* __restrict__ dst, int lddst, int k0, int n0, lds_t lds) {
    LAS float* tile = (LAS float*)lds;
    const int tid = otid();
    {
        const int r = tid >> 6, c = tid & 63, n = n0 + c;
#pragma unroll
        for (int i = 0; i < 8; ++i) { const int k = r + 8 * i; tile[k * 65 + c] = (n < Nvalid) ? src[(size_t)(k0 + k) * ldsrc + n] : 0.f; }
    }
    __syncthreads();
    {
        const int nn = tid >> 3, kc = tid & 7;
        float v[8];
#pragma unroll
        for (int j = 0; j < 8; ++j) v[j] = tile[(kc * 8 + j) * 65 + nn];
        u32x4 w; w.x = pk_bf16(v[0], v[1]); w.y = pk_bf16(v[2], v[3]); w.z = pk_bf16(v[4], v[5]); w.w = pk_bf16(v[6], v[7]);
        *(u32x4*)(dst + (size_t)(n0 + nn) * lddst + k0 + kc * 8) = w;
    }
    __syncthreads();
}

__device__ __forceinline__ void convert_bf16(const float* __restrict__ src, bf16_t* __restrict__ dst, size_t n8) {
    const size_t stride = (size_t)gridDim.x * NTHREADS;
    for (size_t i = (size_t)blockIdx.x * NTHREADS + otid(); i < n8; i += stride) {
        const f32x4 a = *(const f32x4*)(src + i * 8), b = *(const f32x4*)(src + i * 8 + 4);
        u32x4 w; w.x = pk_bf16(a[0], a[1]); w.y = pk_bf16(a[2], a[3]); w.z = pk_bf16(b[0], b[1]); w.w = pk_bf16(b[2], b[3]);
        *(u32x4*)(dst + i * 8) = w;
    }
}

__device__ __forceinline__ void sincos_d(double a, float& sn, float& cs) {
    const double kq = rint(a * 0.63661977236758134308);
    double r = fma(-kq, 1.57079632679489655800e+00, a);
    r = fma(-kq, 6.12323399573676603587e-17, r);
    const int q = ((int)kq) & 3;
    const double r2 = r * r;
    double sp = -7.647163731819816476e-13;
    sp = fma(sp, r2, 1.605904383682161460e-10);
    sp = fma(sp, r2, -2.505210838544171878e-08);
    sp = fma(sp, r2, 2.755731922398589065e-06);
    sp = fma(sp, r2, -1.984126984126984127e-04);
    sp = fma(sp, r2, 8.333333333333333333e-03);
    sp = fma(sp, r2, -1.666666666666666667e-01);
    const double s = fma(sp * r2, r, r);
    double cp = 4.779477332387385297e-14;
    cp = fma(cp, r2, -1.147074559772972471e-11);
    cp = fma(cp, r2, 2.087675698786809898e-09);
    cp = fma(cp, r2, -2.755731922398589065e-07);
    cp = fma(cp, r2, 2.480158730158730159e-05);
    cp = fma(cp, r2, -1.388888888888888889e-03);
    cp = fma(cp, r2, 4.166666666666666667e-02);
    cp = fma(cp, r2, -0.5);
    const double c = fma(cp, r2, 1.0);
    const double ss = (q & 1) ? c : s, cc = (q & 1) ? s : c;
    sn = (float)((q & 2) ? -ss : ss);
    cs = (float)(((q + 1) & 2) ? -cc : cc);
}

__device__ __forceinline__ void phase_prologue(const Params& p, lds_t lds) {
    const int tid = otid(), bid = blockIdx.x, G = gridDim.x;
    unsigned char* ws = p.ws;
    {
        const int J_IN = 16 * 44, J_OUT = 16 * 16, J_Q = 16 * 32, J_P = 4;
        const int total = 2 * (J_IN + J_OUT + J_Q) + 8 * J_P;
        for (int j = bid; j < total; j += G) {
            int r = j;
            if (r < 2 * J_IN) { const int l = r / J_IN, t = r % J_IN; transpose_tile(p.w_in + (size_t)l * D * DIN, DIN, DIN, (bf16_t*)(ws + WS_WIN) + (size_t)l * NIN * D, D, (t / 44) * 64, (t % 44) * 64, lds); continue; }
            r -= 2 * J_IN;
            if (r < 2 * J_OUT) { const int l = r / J_OUT, t = r % J_OUT; transpose_tile(p.w_out + (size_t)l * D * D, D, D, (bf16_t*)(ws + WS_WOUT) + (size_t)l * D * D, D, (t / 16) * 64, (t % 16) * 64, lds); continue; }
            r -= 2 * J_OUT;
            if (r < 2 * J_Q) { const int l = r / J_Q, t = r % J_Q; transpose_tile(p.w_query + (size_t)l * D * 2048, 2048, 2048, (bf16_t*)(ws + WS_WQ) + (size_t)l * 2048 * D, D, (t / 32) * 64, (t % 32) * 64, lds); continue; }
            r -= 2 * J_Q;
            { const int m = r / J_P, t = r % J_P; transpose_tile(p.w_pool + (size_t)m * 128 * 128, 128, 128, (bf16_t*)(ws + WS_WPOOL) + (size_t)m * 128 * 128, 128, (t / 2) * 64, (t % 2) * 64, lds); }
        }
    }
    {
        const int lane = tid & 63, wid = tid >> 6, nw = G * 8;
        for (int r = bid * 8 + wid; r < 2 * DEPTH * NEXP; r += nw) {
            const int tab = r / (DEPTH * NEXP), row = r % (DEPTH * NEXP);
            const float* src = (tab ? p.expert_v : p.expert_u) + (size_t)row * D + lane * 16;
            f32x4 v[4]; float am = 0.f;
#pragma unroll
            for (int i = 0; i < 4; ++i) { v[i] = *(const f32x4*)(src + 4 * i); am = fmaxf(am, fmaxf(fmaxf(fabsf(v[i][0]), fabsf(v[i][1])), fmaxf(fabsf(v[i][2]), fabsf(v[i][3])))); }
#pragma unroll
            for (int o = 32; o > 0; o >>= 1) am = fmaxf(am, __shfl_xor(am, o));
            const unsigned eb = (__float_as_uint(am) >> 23) & 255u;
            const bool ok = eb >= 8u && eb <= 250u;
            const float sc = ok ? __uint_as_float((261u - eb) << 23) : 1.0f, isc = ok ? __uint_as_float((eb - 7u) << 23) : 1.0f;
            u32x4 w;
#pragma unroll
            for (int i = 0; i < 4; ++i) {
                int pk = 0;
                pk = __builtin_amdgcn_cvt_pk_fp8_f32(v[i][0] * sc, v[i][1] * sc, pk, false);
                pk = __builtin_amdgcn_cvt_pk_fp8_f32(v[i][2] * sc, v[i][3] * sc, pk, true);
                w[i] = (unsigned)pk;
            }
            *(u32x4*)(ws + (tab ? WS_EV : WS_EU) + (size_t)row * D + lane * 16) = w;
            if (lane == 0) ((float*)(ws + WS_ES))[(size_t)row * 2 + tab] = isc;
        }
    }
    convert_bf16(p.sub_keys, (bf16_t*)(ws + WS_SK), (size_t)DEPTH * 16 * 128 * 128 / 8);
    {
        LAS float* sc = (LAS float*)lds;
        LAS float* part = (LAS float*)(lds + 32768);
        for (int i = tid; i < NB * D; i += NTHREADS) { const float v = p.c[i]; sc[i] = v / (1.f + __expf(-v)); }
        __syncthreads();
        const int lane = tid & 63, wid = tid >> 6;
        for (int j = bid; j < DEPTH * 96; j += G) {
            const int l = j / 96, col = (j % 96) * 64 + lane;
            const float* wp = p.w_ada + (size_t)l * D * 6144 + col;
            float a[8] = {0.f, 0.f, 0.f, 0.f, 0.f, 0.f, 0.f, 0.f};
            for (int k = wid * 128; k < wid * 128 + 128; ++k) {
                const float w = wp[(size_t)k * 6144];
#pragma unroll
                for (int b = 0; b < 8; ++b) a[b] = fmaf(sc[b * D + k], w, a[b]);
            }
#pragma unroll
            for (int b = 0; b < 8; ++b) part[(wid * 8 + b) * 64 + lane] = a[b];
            __syncthreads();
            {
                const int b = tid >> 6;
                float s = 0.f;
#pragma unroll
                for (int w = 0; w < 8; ++w) s += part[(w * 8 + b) * 64 + lane];
                ((float*)(ws + WS_MOD))[((size_t)l * NB + b) * 6144 + col] = s + p.b_ada[(size_t)l * 6144 + col];
            }
            __syncthreads();
        }
    }
    {
        const float inv[8] = {1.0f, 0.1939227432012558f, 0.03760603070259094f, 0.007292664609849453f, 0.0014142135623842478f, 0.00027424818836152554f, 5.318296098266728e-05f, 1.0313386155758053e-05f};
        const size_t stride = (size_t)G * NTHREADS;
        for (size_t i = (size_t)bid * NTHREADS + tid; i < (size_t)T * 8; i += stride) {
            const int t = (int)(i >> 3), f = (int)(i & 7);
            float iv = inv[0];
#pragma unroll
            for (int q = 1; q < 8; ++q) iv = (f == q) ? inv[q] : iv;
            const float ang = (float)p.pos[t] * iv;
            float sn, cs; sincos_d((double)ang, sn, cs);
            float* rp = (float*)(ws + WS_ROPE) + (size_t)t * 16;
            rp[f] = cs; rp[8 + f] = sn;
        }
    }
}

template <int MODE>
__device__ __forceinline__ void phase_norm(const float* xin, const float* __restrict__ gw, const float* __restrict__ sh, const float* __restrict__ scl, bf16_t* hout, float* fout) {
    const int tid = otid(), lane = tid & 63, wid = tid >> 6;
    const int nw = gridDim.x * 8;
    for (int gwv = blockIdx.x * 8 + wid; gwv * 32 < T; gwv += nw) {
        const int row0 = gwv * 32, b = row0 / S;
        f32x4 g4[4], a4[4], s4[4];
#pragma unroll
        for (int i = 0; i < 4; ++i) {
            const int col = 4 * lane + 256 * i;
            g4[i] = *(const f32x4*)(gw + col);
            if (MODE == 0) { a4[i] = *(const f32x4*)(scl + (size_t)b * 6144 + col) + 1.0f; s4[i] = *(const f32x4*)(sh + (size_t)b * 6144 + col); }
        }
        for (int r = 0; r < 32; ++r) {
            const float* xr = xin + (size_t)(row0 + r) * D;
            f32x4 v[4]; float ss = 0.f;
#pragma unroll
            for (int i = 0; i < 4; ++i) { v[i] = *(const f32x4*)(xr + 4 * lane + 256 * i); ss += v[i][0] * v[i][0] + v[i][1] * v[i][1] + v[i][2] * v[i][2] + v[i][3] * v[i][3]; }
            ss = wave_sum(ss);
            const float rstd = rsqrtf(ss * (1.0f / D) + 1e-6f);
            int ozn = 0; asm volatile("" : "+v"(ozn));
#pragma unroll
            for (int i = 0; i < 4; ++i) {
                f32x4 y = v[i] * rstd * g4[i];
                if (MODE == 0) {
                    y = y * a4[i] + s4[i];
                    u32x2 w; w.x = pk_bf16(y[0], y[1]); w.y = pk_bf16(y[2], y[3]);
                    *(u32x2*)(hout + (size_t)(row0 + r) * D + 4 * lane + 256 * i) = w;
                } else {
                    *(f32x4*)(fout + (size_t)(row0 + r) * D + 4 * lane + 256 * i) = y;
                }
            }
        }
    }
}
constexpr int GROW = 144;
constexpr int GTILE = 256 * GROW;

__device__ __forceinline__ bool tile_order(int i, int N, int& pm, int& pn) {
    const int nM = T / 256, nN = N / 256, nwg = nM * nN, G = gridDim.x;
    const long L = (long)i * G + blockIdx.x; if (L >= nwg) return false;
    int wgid = (int)L; { const int q = nwg / 8, r = nwg % 8, xcd = wgid % 8, off = wgid / 8; wgid = (xcd < r ? xcd * (q + 1) : r * (q + 1) + (xcd - r) * q) + off; }
    const int nig = 8 * nN, gid = wgid / nig, fm = gid * 8, gsz = (nM - fm) < 8 ? (nM - fm) : 8;
    pm = fm + ((wgid % nig) % gsz); pn = (wgid % nig) / gsz; return true;
}

template <int MODE = 0, class Epi>
__device__ __forceinline__ void gemm_phase(const bf16_t* __restrict__ A, const bf16_t* __restrict__ Wt, int N, const Epi& epi, lds_t lds) {
    const int tid = otid(), lane = tid & 63, wid = tid >> 6;
    const int wr = wid >> 2, wc = wid & 3, l31 = lane & 31, hh = lane >> 5;
    const int srow = tid >> 3, scc = tid & 7;
    int pm, pn;
    for (int it = 0; tile_order(it, N, pm, pn); ++it) {
        const bf16_t* Ag = A + (size_t)(pm * 256 + srow) * D + scc * 8;
        const bf16_t* Wg = Wt + (size_t)(pn * 256 + srow) * D + scc * 8;
        f32x16 acc[2][4];
#pragma unroll
        for (int a = 0; a < 2; ++a)
#pragma unroll
            for (int b = 0; b < 4; ++b)
#pragma unroll
                for (int r = 0; r < 16; ++r) acc[a][b][r] = 0.f;
        u32x4 ra[4], rw[4];
#pragma unroll
        for (int i = 0; i < 4; ++i) { ra[i] = *(const u32x4*)(Ag + (size_t)i * 64 * D); rw[i] = *(const u32x4*)(Wg + (size_t)i * 64 * D); }
#pragma unroll
        for (int i = 0; i < 4; ++i) { *(LAS u32x4*)(lds + (srow + 64 * i) * GROW + scc * 16) = ra[i]; *(LAS u32x4*)(lds + GTILE + (srow + 64 * i) * GROW + scc * 16) = rw[i]; }
        __syncthreads();
        for (int kt = 0; kt < 16; ++kt) {
            if (kt < 15 && MODE != 1) {
#pragma unroll
                for (int i = 0; i < 4; ++i) { ra[i] = *(const u32x4*)(Ag + (size_t)i * 64 * D + (kt + 1) * 64); rw[i] = *(const u32x4*)(Wg + (size_t)i * 64 * D + (kt + 1) * 64); }
            }
            __builtin_amdgcn_sched_barrier(0);
            const lds_t sb = lds + (kt & 1) * 2 * GTILE;
#pragma unroll
            for (int ks = 0; ks < (MODE == 2 ? 0 : 4); ++ks) {
                bf16x8 af[4], wf[2];
#pragma unroll
                for (int tt = 0; tt < 4; ++tt) af[tt] = *(LAS bf16x8*)(sb + (wr * 128 + tt * 32 + l31) * GROW + (ks * 2 + hh) * 16);
#pragma unroll
                for (int nt = 0; nt < 2; ++nt) wf[nt] = *(LAS bf16x8*)(sb + GTILE + (wc * 64 + nt * 32 + l31) * GROW + (ks * 2 + hh) * 16);
#pragma unroll
                for (int nt = 0; nt < 2; ++nt)
#pragma unroll
                    for (int tt = 0; tt < 4; ++tt) acc[nt][tt] = MFMA32(wf[nt], af[tt], acc[nt][tt]);
            }
            __builtin_amdgcn_sched_barrier(0);
            if (kt < 15 && MODE != 1) {
                const lds_t nb = lds + ((kt + 1) & 1) * 2 * GTILE;
#pragma unroll
                for (int i = 0; i < 4; ++i) { *(LAS u32x4*)(nb + (srow + 64 * i) * GROW + scc * 16) = ra[i]; *(LAS u32x4*)(nb + GTILE + (srow + 64 * i) * GROW + scc * 16) = rw[i]; }
            }
            if (MODE != 1) __syncthreads();
        }
        if (MODE == 1) __syncthreads();
        epi(acc, pm, pn, wr, wc, l31, hh);
    }
}

struct EpiIn {
    bf16_t *xp, *q, *k, *vt, *qi, *ki; float* wi; const float* rope;
    __device__ __forceinline__ void operator()(const f32x16 (&acc)[2][4], int pm, int pn, int wr, int wc, int l31, int hh) const {
        const int seg = pn >> 1;
        const int cb = (pn & 1) * 256 + wc * 64;
#pragma unroll
        for (int tt = 0; tt < 4; ++tt) {
            const int t = pm * 256 + wr * 128 + tt * 32 + l31;
            if (seg == 0) {
#pragma unroll
                for (int nt = 0; nt < 2; ++nt)
#pragma unroll
                    for (int rq = 0; rq < 4; ++rq) {
                        u32x2 w; w.x = pk_bf16(acc[nt][tt][4 * rq], acc[nt][tt][4 * rq + 1]); w.y = pk_bf16(acc[nt][tt][4 * rq + 2], acc[nt][tt][4 * rq + 3]);
                        *(u32x2*)(xp + (size_t)t * 512 + cb + nt * 32 + 8 * rq + 4 * hh) = w;
                    }
            } else if (seg == 3) {
                const int b = t / S, s = t % S, head = cb >> 6;
                bf16_t* vb = vt + ((size_t)(b * 8 + head) * 64) * S + s;
#pragma unroll
                for (int nt = 0; nt < 2; ++nt)
#pragma unroll
                    for (int r = 0; r < 16; ++r) {
                        const int d = nt * 32 + (r & 3) + 8 * (r >> 2) + 4 * hh;
                        vb[(size_t)d * S] = (bf16_t)(pk_bf16(acc[nt][tt][r], 0.f) & 0xffffu);
                    }
            } else if (seg == 1 || seg == 2 || seg == 4 || (seg == 5 && wc == 0)) {
                const f32x4 cs = *(const f32x4*)(rope + (size_t)t * 16 + 4 * hh), sn = *(const f32x4*)(rope + (size_t)t * 16 + 8 + 4 * hh);
                const float scale = (seg == 1 || seg == 4) ? 0.125f : 1.0f;
                bf16_t* dst; size_t off;
                if (seg == 1) { dst = q; off = (size_t)t * 512 + cb; } else if (seg == 2) { dst = k; off = (size_t)t * 512 + cb; } else if (seg == 4) { dst = qi; off = (size_t)t * 512 + cb; } else { dst = ki; off = (size_t)t * 64; }
                float v0[16];
#pragma unroll
                for (int r = 0; r < 16; ++r) v0[r] = acc[0][tt][r];
#pragma unroll
                for (int j = 0; j < 4; ++j) { const float x1 = acc[0][tt][j], x2 = acc[0][tt][4 + j]; v0[j] = x1 * cs[j] - x2 * sn[j]; v0[4 + j] = x1 * sn[j] + x2 * cs[j]; }
#pragma unroll
                for (int rq = 0; rq < 4; ++rq) {
                    u32x2 w; w.x = pk_bf16(v0[4 * rq] * scale, v0[4 * rq + 1] * scale); w.y = pk_bf16(v0[4 * rq + 2] * scale, v0[4 * rq + 3] * scale);
                    *(u32x2*)(dst + off + 8 * rq + 4 * hh) = w;
                    u32x2 w2; w2.x = pk_bf16(acc[1][tt][4 * rq] * scale, acc[1][tt][4 * rq + 1] * scale); w2.y = pk_bf16(acc[1][tt][4 * rq + 2] * scale, acc[1][tt][4 * rq + 3] * scale);
                    *(u32x2*)(dst + off + 32 + 8 * rq + 4 * hh) = w2;
                }
            } else if (seg == 5 && wc == 1) {
                f32x4 w;
#pragma unroll
                for (int j = 0; j < 4; ++j) w[j] = acc[0][tt][j] * 0.35355339059327373f;
                *(f32x4*)(wi + (size_t)t * 8 + 4 * hh) = w;
            }
        }
    }
};

struct EpiOut {
    const float* xin; float* xout; const float* gate;
    __device__ __forceinline__ void operator()(const f32x16 (&acc)[2][4], int pm, int pn, int wr, int wc, int l31, int hh) const {
        const int b = (pm * 256) / S;
#pragma unroll
        for (int nt = 0; nt < 2; ++nt)
#pragma unroll
            for (int rq = 0; rq < 4; ++rq) {
                const int n0 = pn * 256 + wc * 64 + nt * 32 + 8 * rq + 4 * hh;
                const f32x4 g = *(const f32x4*)(gate + (size_t)b * 6144 + n0);
#pragma unroll
                for (int tt = 0; tt < 4; ++tt) {
                    const int t = pm * 256 + wr * 128 + tt * 32 + l31;
                    const f32x4 xo = *(const f32x4*)(xin + (size_t)t * D + n0);
                    f32x4 a; a[0] = acc[nt][tt][4 * rq]; a[1] = acc[nt][tt][4 * rq + 1]; a[2] = acc[nt][tt][4 * rq + 2]; a[3] = acc[nt][tt][4 * rq + 3];
                    *(f32x4*)(xout + (size_t)t * D + n0) = xo + g * a;
                }
            }
    }
};

struct EpiNull { float* sink; __device__ __forceinline__ void operator()(const f32x16 (&acc)[2][4], int pm, int pn, int wr, int wc, int l31, int hh) const { float t = 0.f;
#pragma unroll
    for (int a = 0; a < 2; ++a)
#pragma unroll
        for (int b = 0; b < 4; ++b)
#pragma unroll
            for (int r = 0; r < 16; ++r) t += acc[a][b][r];
    sink[((size_t)(pm * 11 + pn) * 512 + (wr * 4 + wc) * 64 + hh * 32 + l31)] = t; } };
struct EpiBf {
    bf16_t* C; int ldc;
    __device__ __forceinline__ void operator()(const f32x16 (&acc)[2][4], int pm, int pn, int wr, int wc, int l31, int hh) const {
#pragma unroll
        for (int tt = 0; tt < 4; ++tt) {
            const int t = pm * 256 + wr * 128 + tt * 32 + l31;
#pragma unroll
            for (int nt = 0; nt < 2; ++nt)
#pragma unroll
                for (int rq = 0; rq < 4; ++rq) {
                    u32x2 w; w.x = pk_bf16(acc[nt][tt][4 * rq], acc[nt][tt][4 * rq + 1]); w.y = pk_bf16(acc[nt][tt][4 * rq + 2], acc[nt][tt][4 * rq + 3]);
                    *(u32x2*)(C + (size_t)t * ldc + pn * 256 + wc * 64 + nt * 32 + 8 * rq + 4 * hh) = w;
                }
        }
    }
};

__device__ __forceinline__ void pool_item(int e, const bf16_t* __restrict__ xp, const bf16_t* __restrict__ wpool  , const float* __restrict__ pscale  , bf16_t* __restrict__ mixed, lds_t lds) {
    const int tid = otid(), lane = tid & 63, wid = tid >> 6, l31 = lane & 31, hh = lane >> 5;
    const int g = e & 3, tile = e >> 2;
    const int t0 = tile * 128, s0 = t0 % S;
    lds_t xs = lds;
    lds_t ps = lds + 144 * 256;
    for (int c = tid; c < 144 * 16; c += NTHREADS) {
        const int r = c >> 4, cc = c & 15;
        u32x4 v = {0u, 0u, 0u, 0u};
        if (s0 - 16 + r >= 0) v = *(const u32x4*)(xp + (size_t)(t0 - 16 + r) * 512 + g * 128 + cc * 8);
        *(LAS u32x4*)(xs + r * 256 + cc * 16) = v;
    }
    __syncthreads();
    {
        const int c = tid & 127, tq = tid >> 7, w = 2 << g;
        for (int tl = tq * 32; tl < tq * 32 + 32; ++tl) {
            const int s = s0 + tl;
            float sum = 0.f;
            for (int j = 0; j < w; ++j) sum += __uint_as_float((unsigned)(*(LAS bf16_t*)(xs + (16 + tl - j) * 256 + c * 2)) << 16);
            const float xc = __uint_as_float((unsigned)(*(LAS bf16_t*)(xs + (16 + tl) * 256 + c * 2)) << 16);
            const float cnt = (float)((s + 1 < w) ? (s + 1) : w);
            const float pooled = sum / cnt - xc;
            *(LAS bf16_t*)(ps + tl * 272 + c * 2) = (bf16_t)(pk_bf16(pooled, 0.f) & 0xffffu);
        }
    }
    __syncthreads();
    {
        const int dt = wid & 3, tb = (wid >> 2) * 2;
        f32x16 acc[2];
#pragma unroll
        for (int a = 0; a < 2; ++a)
#pragma unroll
            for (int r = 0; r < 16; ++r) acc[a][r] = 0.f;
        const bf16_t* wg = wpool + (size_t)g * 128 * 128 + (size_t)(dt * 32 + l31) * 128 + 8 * hh;
#pragma unroll
        for (int ks = 0; ks < 8; ++ks) {
            const bf16x8 wf = *(const bf16x8*)(wg + ks * 16);
#pragma unroll
            for (int a = 0; a < 2; ++a) {
                const bf16x8 pf = *(LAS bf16x8*)(ps + ((tb + a) * 32 + l31) * 272 + (ks * 2 + hh) * 16);
                acc[a] = MFMA32(wf, pf, acc[a]);
            }
        }
#pragma unroll
        for (int a = 0; a < 2; ++a) {
            const int t = t0 + (tb + a) * 32 + l31;
#pragma unroll
            for (int rq = 0; rq < 4; ++rq) {
                const int d = dt * 32 + 8 * rq + 4 * hh;
                const f32x4 sc = *(const f32x4*)(pscale + g * 128 + d);
                u32x2 w; w.x = pk_bf16(acc[a][4 * rq] * sc[0], acc[a][4 * rq + 1] * sc[1]); w.y = pk_bf16(acc[a][4 * rq + 2] * sc[2], acc[a][4 * rq + 3] * sc[3]);
                *(u32x2*)(mixed + (size_t)t * D + g * 128 + d) = w;
            }
        }
    }
    __syncthreads();
}
constexpr int TK_CAP = 576, TK_NE = 9, TK_TRIG = 512, TK_SOFT = 448;
constexpr int TK_FLAG = 145408;
constexpr int TK_CS = 0;
constexpr int TK_CI = 73728;
constexpr int TK_KST = 110592;
constexpr int TK_HIST = 129024;

__device__ __forceinline__ unsigned f2key(float s) { const unsigned b = __float_as_uint(s); return b ^ ((b >> 31) ? 0xffffffffu : 0x80000000u); }
__device__ __forceinline__ float key2f(unsigned k) { return __uint_as_float((k & 0x80000000u) ? (k ^ 0x80000000u) : ~k); }
__device__ __forceinline__ int bcount(bool p) { return __builtin_popcountll(__ballot(p)); }

template <int CTRL> __device__ __forceinline__ unsigned dpp_z(unsigned v) { return (unsigned)__builtin_amdgcn_update_dpp(0, (int)v, CTRL, 0xf, 0xf, true); }
__device__ __forceinline__ unsigned rdl(unsigned v, int l) { return (unsigned)__builtin_amdgcn_readlane((int)v, l); }

__device__ __forceinline__ void prune4(LAS float* cs, LAS bf16_t* ci, int (&cnt)[4], float (&tau)[2], LAS unsigned* hist, int lane, int hh) {
    unsigned key[4][TK_NE], idx[4][TK_NE];
    bool act[4];
#pragma unroll
    for (int q = 0; q < 4; ++q) {
        act[q] = cnt[q] > 256;
#pragma unroll
        for (int e = 0; e < TK_NE; ++e) {
            const int i = lane + 64 * e; const bool v = act[q] && i < cnt[q];
            const float sv_ = cs[q * TK_CAP + i]; const unsigned iv_ = ci[q * TK_CAP + i];
            key[q][e] = v ? f2key(sv_) : 0u; idx[q][e] = v ? iv_ : 0xffffu;
        }
    }
    unsigned prefix[4] = {0u, 0u, 0u, 0u}; int need[4] = {256, 256, 256, 256};
    const int row = lane >> 4;
#pragma unroll
    for (int pass = 3; pass >= 0; --pass) {
        const int sh = pass * 8;
        *(LAS u32x4*)(hist + lane * 8) = (u32x4){0u, 0u, 0u, 0u}; *(LAS u32x4*)(hist + lane * 8 + 4) = (u32x4){0u, 0u, 0u, 0u};
        lds_fence();
#pragma unroll
        for (int q = 0; q < 4; ++q)
#pragma unroll
            for (int e = 0; e < TK_NE; ++e) {
                const bool a = (key[q][e] != 0u) && (pass == 3 ? true : (((key[q][e] ^ prefix[q]) >> ((sh + 8) & 31)) == 0u));
                const unsigned b = (key[q][e] >> sh) & 255u;
                __hip_atomic_fetch_add(hist + (b >> 2) * 8 + q * 2 + ((b >> 1) & 1u), a ? (1u << (16 * (b & 1u))) : 0u, __ATOMIC_RELAXED, __HIP_MEMORY_SCOPE_WORKGROUP);
            }
        lds_fence();
        const u32x4 w0 = *(LAS u32x4*)(hist + lane * 8), w1 = *(LAS u32x4*)(hist + lane * 8 + 4);
#pragma unroll
        for (int q = 0; q < 4; ++q) {
            const unsigned wk0 = q == 0 ? w0[0] : q == 1 ? w0[2] : q == 2 ? w1[0] : w1[2], wk1 = q == 0 ? w0[1] : q == 1 ? w0[3] : q == 2 ? w1[1] : w1[3];
            const unsigned b0 = wk0 & 0xffffu, b1 = wk0 >> 16, b2 = wk1 & 0xffffu, b3 = wk1 >> 16, sb = b0 + b1 + b2 + b3;
            unsigned P = sb;
            P += dpp_z<0x111>(P); P += dpp_z<0x112>(P); P += dpp_z<0x114>(P); P += dpp_z<0x118>(P);
            const unsigned R0 = rdl(P, 15), R1 = rdl(P, 31), R2 = rdl(P, 47), R3 = rdl(P, 63);
            const unsigned Gp = P + (row > 0 ? R0 : 0u) + (row > 1 ? R1 : 0u) + (row > 2 ? R2 : 0u);
            const unsigned suf = (R0 + R1 + R2 + R3) - Gp + sb;
            const unsigned long long bm = __ballot(suf >= (unsigned)need[q]);
            const int Ls = 63 - __builtin_clzll(bm | 1ull);
            const unsigned above = rdl(suf - sb, Ls), c1 = rdl(b1, Ls), c2 = rdl(b2, Ls), c3 = rdl(b3, Ls);
            unsigned c = above; int bin;
            if (c + c3 >= (unsigned)need[q]) bin = 3;
            else { c += c3; if (c + c2 >= (unsigned)need[q]) bin = 2; else { c += c2; if (c + c1 >= (unsigned)need[q]) bin = 1; else { c += c1; bin = 0; } } }
            need[q] -= (int)c;
            prefix[q] |= (unsigned)(Ls * 4 + bin) << sh;
        }
    }
#pragma unroll
    for (int q = 0; q < 4; ++q) {
        if (act[q]) {
            int eq = 0;
#pragma unroll
            for (int e = 0; e < TK_NE; ++e) eq += bcount(key[q][e] == prefix[q]);
            unsigned ithr = 0xffffu;
            if (eq > need[q]) {
                unsigned lo = 0u;
                for (int bit = 12; bit >= 0; --bit) {
                    const unsigned mid = lo + (1u << bit);
                    int c = 0;
#pragma unroll
                    for (int e = 0; e < TK_NE; ++e) c += bcount(key[q][e] == prefix[q] && idx[q][e] < mid);
                    if (c < need[q]) lo = mid;
                }
                ithr = lo;
            }
            int base = 0;
#pragma unroll
            for (int e = 0; e < TK_NE; ++e) {
                const bool keep = (key[q][e] > prefix[q]) || (key[q][e] == prefix[q] && idx[q][e] <= ithr);
                const unsigned long long m = __ballot(keep);
                const int pos = base + (int)__builtin_amdgcn_mbcnt_hi((unsigned)(m >> 32), __builtin_amdgcn_mbcnt_lo((unsigned)m, 0u));
                if (keep) { cs[q * TK_CAP + pos] = key2f(key[q][e]); ci[q * TK_CAP + pos] = (bf16_t)idx[q][e]; }
                base += __builtin_popcountll(m);
            }
            cnt[q] = 256;
            const float nt_ = key2f(prefix[q]);
            if ((q >> 1) == hh) { if ((q & 1) == 0) tau[0] = nt_; else tau[1] = nt_; }
        }
    }
    lds_fence();
}


__device__ __forceinline__ float wave_max_f(float v) {
    v = fmaxf(v, __uint_as_float((unsigned)__builtin_amdgcn_update_dpp((int)__float_as_uint(v), (int)__float_as_uint(v), 0x111, 0xf, 0xf, false)));
    v = fmaxf(v, __uint_as_float((unsigned)__builtin_amdgcn_update_dpp((int)__float_as_uint(v), (int)__float_as_uint(v), 0x112, 0xf, 0xf, false)));
    v = fmaxf(v, __uint_as_float((unsigned)__builtin_amdgcn_update_dpp((int)__float_as_uint(v), (int)__float_as_uint(v), 0x114, 0xf, 0xf, false)));
    v = fmaxf(v, __uint_as_float((unsigned)__builtin_amdgcn_update_dpp((int)__float_as_uint(v), (int)__float_as_uint(v), 0x118, 0xf, 0xf, false)));
    const float a = __uint_as_float(rdl(__float_as_uint(v), 15)), b = __uint_as_float(rdl(__float_as_uint(v), 31)), c = __uint_as_float(rdl(__float_as_uint(v), 47)), d = __uint_as_float(rdl(__float_as_uint(v), 63));
    return fmaxf(fmaxf(a, b), fmaxf(c, d));
}
__device__ __forceinline__ void prune4_fast(LAS float* cs, LAS bf16_t* ci, int (&cnt)[4], float (&tau)[2], LAS unsigned* hist, int lane, int hh) {
    float sv[4][TK_NE]; unsigned idx[4][TK_NE]; bool val[4][TK_NE];
    float lo[4], scale[4];
#pragma unroll
    for (int q = 0; q < 4; ++q) {
        float mx = -INFINITY, mn = INFINITY;
#pragma unroll
        for (int e = 0; e < TK_NE; ++e) {
            const int i = lane + 64 * e; val[q][e] = i < cnt[q];
            sv[q][e] = cs[q * TK_CAP + i]; idx[q][e] = ci[q * TK_CAP + i];
            mx = fmaxf(mx, val[q][e] ? sv[q][e] : -INFINITY); mn = fminf(mn, val[q][e] ? sv[q][e] : INFINITY);
        }
        mx = wave_max_f(mx); mn = -wave_max_f(-mn);
        lo[q] = mn; const float d = mx - mn; scale[q] = d > 0.f ? 255.9f / d : 0.f;
    }
    *(LAS u32x4*)(hist + lane * 8) = (u32x4){0u, 0u, 0u, 0u}; *(LAS u32x4*)(hist + lane * 8 + 4) = (u32x4){0u, 0u, 0u, 0u};
    lds_fence();
    unsigned bin[4][TK_NE];
#pragma unroll
    for (int q = 0; q < 4; ++q)
#pragma unroll
        for (int e = 0; e < TK_NE; ++e) {
            int b = (int)((sv[q][e] - lo[q]) * scale[q]); b = b < 0 ? 0 : (b > 255 ? 255 : b);
            bin[q][e] = val[q][e] ? (unsigned)b : 0u;
            __hip_atomic_fetch_add(hist + (bin[q][e] >> 2) * 8 + q * 2 + ((bin[q][e] >> 1) & 1u), val[q][e] ? (1u << (16 * (bin[q][e] & 1u))) : 0u, __ATOMIC_RELAXED, __HIP_MEMORY_SCOPE_WORKGROUP);
        }
    lds_fence();
    const u32x4 w0 = *(LAS u32x4*)(hist + lane * 8), w1 = *(LAS u32x4*)(hist + lane * 8 + 4);
    const int row = lane >> 4;
    bool fail = false;
#pragma unroll
    for (int q = 0; q < 4; ++q) {
        const unsigned wk0 = q == 0 ? w0[0] : q == 1 ? w0[2] : q == 2 ? w1[0] : w1[2], wk1 = q == 0 ? w0[1] : q == 1 ? w0[3] : q == 2 ? w1[1] : w1[3];
        const unsigned b0 = wk0 & 0xffffu, b1 = wk0 >> 16, b2 = wk1 & 0xffffu, b3 = wk1 >> 16, sb = b0 + b1 + b2 + b3;
        unsigned P = sb;
        P += dpp_z<0x111>(P); P += dpp_z<0x112>(P); P += dpp_z<0x114>(P); P += dpp_z<0x118>(P);
        const unsigned R0 = rdl(P, 15), R1 = rdl(P, 31), R2 = rdl(P, 47), R3 = rdl(P, 63);
        const unsigned Gp = P + (row > 0 ? R0 : 0u) + (row > 1 ? R1 : 0u) + (row > 2 ? R2 : 0u);
        const unsigned suf = (R0 + R1 + R2 + R3) - Gp + sb;
        const unsigned long long bm = __ballot(suf >= 256u);
        const int Ls = 63 - __builtin_clzll(bm | 1ull);
        const unsigned above = rdl(suf - sb, Ls), c1 = rdl(b1, Ls), c2 = rdl(b2, Ls), c3 = rdl(b3, Ls);
        unsigned c = above; int bsel;
        if (c + c3 >= 256u) bsel = 3;
        else { c += c3; if (c + c2 >= 256u) bsel = 2; else { c += c2; if (c + c1 >= 256u) bsel = 1; else bsel = 0; } }
        const unsigned B = (unsigned)(Ls * 4 + bsel);
        if (cnt[q] > 256) {
            int base = 0; float kmin = INFINITY;
#pragma unroll
            for (int e = 0; e < TK_NE; ++e) {
                const bool keep = val[q][e] && bin[q][e] >= B;
                const unsigned long long m = __ballot(keep);
                const int pos = base + (int)__builtin_amdgcn_mbcnt_hi((unsigned)(m >> 32), __builtin_amdgcn_mbcnt_lo((unsigned)m, 0u));
                if (keep) { cs[q * TK_CAP + pos] = sv[q][e]; ci[q * TK_CAP + pos] = (bf16_t)idx[q][e]; }
                kmin = fminf(kmin, keep ? sv[q][e] : INFINITY);
                base += __builtin_popcountll(m);
            }
            kmin = -wave_max_f(-kmin);
            if (base > TK_TRIG - 64) fail = true;
            cnt[q] = base;
            const float nt_ = key2f(f2key(kmin) - 1u);
            if ((q >> 1) == hh) { if ((q & 1) == 0) tau[0] = nt_; else tau[1] = nt_; }
        }
    }
    lds_fence();
    if (fail) prune4(cs, ci, cnt, tau, hist, lane, hh);
}

template <int VAR>
__device__ __forceinline__ void topk_item(int e, const bf16_t* __restrict__ QI, const bf16_t* __restrict__ KI, const float* __restrict__ WI, unsigned* __restrict__ MASK, lds_t lds) {
    const int tid = otid(), lane = tid & 63, wid = tid >> 6, l31 = lane & 31, hh = lane >> 5;
    const int r8 = e >> 8, c = e & 255, b = c >> 5, j = c & 31;
    const int qb = (r8 < 4) ? (j + 32 * r8) : (255 - (j + 32 * (r8 - 4)));
    const int t0 = qb * 32, tq0 = t0 + 4 * wid;
    const size_t tokb = (size_t)b * S;
    bf16x8 qf[4];
    {
        const int i = l31, qi_ = 2 * ((i >> 2) & 1) + (i >> 4), hd = (i & 3) + 4 * ((i >> 3) & 1);
        const bf16_t* qp = QI + (tokb + tq0 + qi_) * 512 + hd * 64 + 8 * hh;
#pragma unroll
        for (int ks = 0; ks < 4; ++ks) qf[ks] = *(const bf16x8*)(qp + ks * 16);
    }
    float wv[2][8];
#pragma unroll
    for (int a = 0; a < 2; ++a) {
        const f32x4 w0 = *(const f32x4*)(WI + (tokb + tq0 + 2 * hh + a) * 8), w1 = *(const f32x4*)(WI + (tokb + tq0 + 2 * hh + a) * 8 + 4);
#pragma unroll
        for (int q = 0; q < 4; ++q) { wv[a][q] = w0[q]; wv[a][4 + q] = w1[q]; }
    }
    float tau[2] = {-INFINITY, -INFINITY};
    int cnt[4] = {0, 0, 0, 0};
    LAS float* cs = (LAS float*)(lds + TK_CS) + (wid * 4) * TK_CAP;
    LAS bf16_t* ci = (LAS bf16_t*)(lds + TK_CI) + (wid * 4) * TK_CAP;
    LAS unsigned* hist = (LAS unsigned*)(lds + TK_HIST) + wid * 512;
    volatile LAS unsigned* flag = (volatile LAS unsigned*)(lds + TK_FLAG);
    if (tid < 3) flag[tid] = 0u;
    const int ntiles = qb + 1, nch = (ntiles + 1) >> 1;
    const int srow = tid >> 3, scc = tid & 7;
    const bf16_t* kg = KI + (tokb + srow) * 64 + scc * 8;
    u32x4 kr = *(const u32x4*)kg, kr2 = kr, kr3 = kr;
    if (1 < nch) kr2 = *(const u32x4*)(kg + (size_t)1 * 64 * 64);
    if (2 < nch) kr3 = *(const u32x4*)(kg + (size_t)2 * 64 * 64);
    *(LAS u32x4*)(lds + TK_KST + srow * GROW + scc * 16) = kr;
    kr = kr2; kr2 = kr3;
    __syncthreads();
    for (int ch = 0; ch < nch; ++ch) {
        if (ch + 3 < nch) kr3 = *(const u32x4*)(kg + (size_t)(ch + 3) * 64 * 64);
        const lds_t kb = lds + TK_KST + (ch & 1) * (64 * GROW);
        {
            f32x16 acc[2];
#pragma unroll
            for (int tl = 0; tl < 2; ++tl)
#pragma unroll
                for (int r = 0; r < 16; ++r) acc[tl][r] = 0.f;
            bf16x8 kf[2][4];
#pragma unroll
            for (int tl = 0; tl < 2; ++tl)
#pragma unroll
                for (int ks = 0; ks < 4; ++ks) kf[tl][ks] = *(LAS bf16x8*)(kb + (tl * 32 + l31) * GROW + (ks * 2 + hh) * 16);
            __builtin_amdgcn_sched_barrier(0);
#pragma unroll
            for (int ks = 0; ks < 4; ++ks)
#pragma unroll
                for (int tl = 0; tl < 2; ++tl) acc[tl] = MFMA32(qf[ks], kf[tl][ks], acc[tl]);
            float sc[2][2];
#pragma unroll
            for (int tl = 0; tl < 2; ++tl)
#pragma unroll
                for (int a = 0; a < 2; ++a) {
                    float sv = 0.f;
#pragma unroll
                    for (int h = 0; h < 8; ++h) sv = fmaf(wv[a][h], __int_as_float(max(__float_as_int(acc[tl][8 * a + h]), 0)), sv);
                    sc[tl][a] = sv;
                }
            const int key0 = ch * 64 + l31;
#pragma unroll
            for (int a = 0; a < 2; ++a) {
                const int tq = tq0 + 2 * hh + a;
                const bool p0 = (sc[0][a] > tau[a]) && (key0 <= tq), p1 = (sc[1][a] > tau[a]) && (key0 + 32 <= tq);
                const unsigned long long m0 = __ballot(p0), m1 = __ballot(p1);
                if ((m0 | m1) != 0ull) {
                    const unsigned m0h = hh ? (unsigned)(m0 >> 32) : (unsigned)m0;
                    const int p0i = hh ? (int)__builtin_amdgcn_mbcnt_hi((unsigned)(m0 >> 32), 0u) : (int)__builtin_amdgcn_mbcnt_lo((unsigned)m0, 0u);
                    const int p1i = hh ? (int)__builtin_amdgcn_mbcnt_hi((unsigned)(m1 >> 32), 0u) : (int)__builtin_amdgcn_mbcnt_lo((unsigned)m1, 0u);
                    const int bc = (hh ? cnt[2 + a] : cnt[a]) + (2 * hh + a) * TK_CAP;
                    if (VAR == 0 || VAR == 3) {
                        if (p0) { cs[bc + p0i] = sc[0][a]; ci[bc + p0i] = (bf16_t)key0; }
                        if (p1) { const int pos = bc + __builtin_popcount(m0h) + p1i; cs[pos] = sc[1][a]; ci[pos] = (bf16_t)(key0 + 32); }
                    } else if (VAR == 2 || VAR == 4) {
                        const int qo = (2 * hh + a) * TK_CAP, rel = (hh ? cnt[2 + a] : cnt[a]);
                        if (p0) { const int pp = qo + ((rel + p0i) % TK_CAP); cs[pp] = sc[0][a]; ci[pp] = (bf16_t)key0; }
                        if (p1) { const int pp = qo + ((rel + __builtin_popcount(m0h) + p1i) % TK_CAP); cs[pp] = sc[1][a]; ci[pp] = (bf16_t)(key0 + 32); }
                    }
                    cnt[a] += __builtin_popcount((unsigned)m0) + __builtin_popcount((unsigned)m1);
                    cnt[2 + a] += __builtin_popcount((unsigned)(m0 >> 32)) + __builtin_popcount((unsigned)(m1 >> 32));
                }
            }
            if (VAR == 0 || VAR == 3) { if (cnt[0] > TK_SOFT || cnt[1] > TK_SOFT || cnt[2] > TK_SOFT || cnt[3] > TK_SOFT) { if (lane == 0) flag[ch % 3] = 1u; } }
        }
        if (ch + 1 < nch) *(LAS u32x4*)(lds + TK_KST + ((ch + 1) & 1) * (64 * GROW) + srow * GROW + scc * 16) = kr;
        kr = kr2; kr2 = kr3;
        if (tid == 0) flag[(ch + 1) % 3] = 0u;
        __syncthreads();
        if (VAR == 0 || VAR == 3) { if (flag[ch % 3] != 0u) { prune4_fast(cs, ci, cnt, tau, hist, lane, hh); } }
    }
    if (VAR == 1 || VAR == 2 || VAR == 3) { if (lane == 0) MASK[(tokb + tq0) * 256] = (unsigned)(cnt[0] + cnt[1] + cnt[2] + cnt[3]); __syncthreads(); return; }
    if (VAR == 4) {
#pragma unroll
        for (int q = 0; q < 4; ++q) cnt[q] = cnt[q] > TK_CAP ? TK_CAP : cnt[q];
    }
    lds_fence();
    prune4(cs, ci, cnt, tau, hist, lane, hh);
    LAS unsigned* mrow = hist;
#pragma unroll
    for (int q = 0; q < 4; ++q) {
        *(LAS u32x4*)(mrow + lane * 4) = (u32x4){0u, 0u, 0u, 0u};
        lds_fence();
#pragma unroll
        for (int e8 = 0; e8 < 8; ++e8) {
            const int i = lane + 64 * e8;
            if (i < cnt[q]) { const unsigned ix = ci[q * TK_CAP + i]; __hip_atomic_fetch_or(mrow + (ix >> 5), 1u << (ix & 31u), __ATOMIC_RELAXED, __HIP_MEMORY_SCOPE_WORKGROUP); }
        }
        lds_fence();
        const u32x4 mv = *(LAS u32x4*)(mrow + lane * 4);
        *(u32x4*)(MASK + (tokb + tq0 + q) * 256 + lane * 4) = mv;
        lds_fence();
    }
    __syncthreads();
}

constexpr int AT_STAGE = 2 * 64 * GROW;

__device__ __forceinline__ void attn_qk(f32x16 (&sacc)[2], const bf16x8 (&qf)[4], lds_t sb, int kap, int hh) {
#pragma unroll
    for (int kt = 0; kt < 2; ++kt)
#pragma unroll
        for (int r = 0; r < 16; ++r) sacc[kt][r] = 0.f;
#pragma unroll
    for (int ks = 0; ks < 4; ++ks)
#pragma unroll
        for (int kt = 0; kt < 2; ++kt) {
            const bf16x8 kf = *(LAS bf16x8*)(sb + (kt * 32 + kap) * GROW + (ks * 2 + hh) * 16);
            sacc[kt] = MFMA32(kf, qf[ks], sacc[kt]);
        }
}
__device__ __forceinline__ void attn_item(int e, const bf16_t* __restrict__ Q, const bf16_t* __restrict__ K, const bf16_t* __restrict__ VT, const unsigned* __restrict__ MASK, bf16_t* __restrict__ mixed, lds_t lds) {
    const int tid = otid(), lane = tid & 63, wid = tid >> 6, l31 = lane & 31, hh = lane >> 5;
    const int r8 = e >> 8, c = e & 255, b = c >> 5, j = c & 31, head = j >> 2, jj = j & 3;
    const int qb = (r8 < 4) ? (jj + 4 * r8) : (31 - (jj + 4 * (r8 - 4)));
    const size_t tokb = (size_t)b * S;
    const int tq = qb * 256 + 32 * wid + l31;
    const size_t tok = tokb + tq;
    bf16x8 qf[4];
#pragma unroll
    for (int ks = 0; ks < 4; ++ks) qf[ks] = *(const bf16x8*)(Q + tok * 512 + head * 64 + ks * 16 + 8 * hh);
    const int nchb = (qb + 1) * 4, nchw = qb * 4 + (wid >> 1) + 1;
    f32x16 O[2];
#pragma unroll
    for (int a = 0; a < 2; ++a)
#pragma unroll
        for (int r = 0; r < 16; ++r) O[a][r] = 0.f;
    float mrun = -1e30f, lrun = 0.f;
    const float L2E = 1.4426950408889634f;
    const int srow = tid >> 3, scc = tid & 7;
    const bf16_t* kg = K + (tokb + srow) * 512 + head * 64 + scc * 8;
    const bf16_t* vg = VT + ((size_t)(b * 8 + head) * 64 + srow) * S + scc * 8;
    const unsigned* mg = MASK + tok * 256;
    const int kap = (l31 & 0x13) | ((l31 & 4) << 1) | ((l31 & 8) >> 1);
    u32x4 kr = *(const u32x4*)kg, vr = *(const u32x4*)vg, kr2, vr2;
    kr2 = *(const u32x4*)(kg + (size_t)1 * 64 * 512); vr2 = *(const u32x4*)(vg + 1 * 64);
    *(LAS u32x4*)(lds + srow * GROW + scc * 16) = kr;
    *(LAS u32x4*)(lds + 64 * GROW + srow * GROW + scc * 16) = vr;
    *(LAS u32x4*)(lds + AT_STAGE + srow * GROW + scc * 16) = kr2;
    *(LAS u32x4*)(lds + AT_STAGE + 64 * GROW + srow * GROW + scc * 16) = vr2;
    kr = *(const u32x4*)(kg + (size_t)2 * 64 * 512); vr = *(const u32x4*)(vg + 2 * 64);
    u32x2 mwn = *(const u32x2*)mg;
    __syncthreads();
    f32x16 scur[2];
    attn_qk(scur, qf, lds, kap, hh);
    for (int ch = 0; ch < nchb; ++ch) {
        if (ch + 3 < nchb) { kr2 = *(const u32x4*)(kg + (size_t)(ch + 3) * 64 * 512); vr2 = *(const u32x4*)(vg + (ch + 3) * 64); }
        const lds_t sb = lds + (ch % 3) * AT_STAGE;
        if (ch < nchw) {
            const u32x2 mw = mwn;
            if (ch + 1 < nchw) mwn = *(const u32x2*)(mg + (ch + 1) * 2);
            f32x16 snext[2];
            if (ch + 1 < nchw) attn_qk(snext, qf, lds + ((ch + 1) % 3) * AT_STAGE, kap, hh);
            float mt = -INFINITY;
#pragma unroll
            for (int kt = 0; kt < 2; ++kt) {
                const unsigned wsh = (kt == 0 ? mw.x : mw.y) >> (8 * hh);
#pragma unroll
                for (int r = 0; r < 16; ++r) {
                    const int bit = (r & 7) + 16 * (r >> 3);
                    const unsigned msk = (unsigned)__builtin_amdgcn_sbfe((int)wsh, bit, 1);
                    const float v = __uint_as_float((__float_as_uint(scur[kt][r]) & msk) | (~msk & 0xff800000u));
                    scur[kt][r] = v; mt = fmaxf(mt, v);
                }
            }
            mt = fmaxf(mt, __shfl_xor(mt, 32));
            const float mnew = fmaxf(mrun, mt);
            if (__ballot(mnew != mrun) != 0ull) {
                const float alpha = __builtin_amdgcn_exp2f((mrun - mnew) * L2E);
                lrun *= alpha;
#pragma unroll
                for (int a = 0; a < 2; ++a)
#pragma unroll
                    for (int r = 0; r < 16; ++r) O[a][r] *= alpha;
                mrun = mnew;
            }
            const float mb = mrun * L2E;
            bf16x8 pf[2][2];
#pragma unroll
            for (int kt = 0; kt < 2; ++kt) {
                float pv[16];
#pragma unroll
                for (int r = 0; r < 16; ++r) { pv[r] = __builtin_amdgcn_exp2f(fmaf(scur[kt][r], L2E, -mb)); lrun += pv[r]; }
#pragma unroll
                for (int s2 = 0; s2 < 2; ++s2) {
                    u32x4 w; w.x = pk_bf16(pv[8 * s2], pv[8 * s2 + 1]); w.y = pk_bf16(pv[8 * s2 + 2], pv[8 * s2 + 3]); w.z = pk_bf16(pv[8 * s2 + 4], pv[8 * s2 + 5]); w.w = pk_bf16(pv[8 * s2 + 6], pv[8 * s2 + 7]);
                    pf[kt][s2] = __builtin_bit_cast(bf16x8, w);
                }
            }
#pragma unroll
            for (int dt = 0; dt < 2; ++dt)
#pragma unroll
                for (int kt = 0; kt < 2; ++kt)
#pragma unroll
                    for (int s2 = 0; s2 < 2; ++s2) {
                        const bf16x8 vf = *(LAS bf16x8*)(sb + 64 * GROW + (dt * 32 + l31) * GROW + (kt * 32 + 16 * s2 + 8 * hh) * 2);
                        O[dt] = MFMA32(vf, pf[kt][s2], O[dt]);
                    }
            if (ch + 1 < nchw) {
#pragma unroll
                for (int kt = 0; kt < 2; ++kt) scur[kt] = snext[kt];
            }
        }
        if (ch + 2 < nchb) {
            const lds_t nb = lds + ((ch + 2) % 3) * AT_STAGE;
            *(LAS u32x4*)(nb + srow * GROW + scc * 16) = kr;
            *(LAS u32x4*)(nb + 64 * GROW + srow * GROW + scc * 16) = vr;
        }
        kr = kr2; vr = vr2;
        __syncthreads();
    }
    const float ltot = lrun + __shfl_xor(lrun, 32);
    const float inv = 1.0f / ltot;
#pragma unroll
    for (int dt = 0; dt < 2; ++dt)
#pragma unroll
        for (int rq = 0; rq < 4; ++rq) {
            u32x2 w; w.x = pk_bf16(O[dt][4 * rq] * inv, O[dt][4 * rq + 1] * inv); w.y = pk_bf16(O[dt][4 * rq + 2] * inv, O[dt][4 * rq + 3] * inv);
            *(u32x2*)(mixed + tok * D + 512 + head * 64 + dt * 32 + 8 * rq + 4 * hh) = w;
        }
}

template <int N> __device__ __forceinline__ void bitonic_desc(int (&a)[N]) {
#pragma unroll
    for (int k = 2; k <= N; k <<= 1)
#pragma unroll
        for (int j = k >> 1; j > 0; j >>= 1)
#pragma unroll
            for (int i = 0; i < N; ++i) {
                const int l = i ^ j;
                if (l > i) {
                    const int hi = max(a[i], a[l]), lo = min(a[i], a[l]);
                    const bool desc = ((i & k) == 0);
                    a[i] = desc ? hi : lo; a[l] = desc ? lo : hi;
                }
            }
}
__device__ __forceinline__ void merge16(int (&a)[16], const int (&b)[16]) {
#pragma unroll
    for (int i = 0; i < 16; ++i) a[i] = max(a[i], b[15 - i]);
#pragma unroll
    for (int j = 8; j > 0; j >>= 1)
#pragma unroll
        for (int i = 0; i < 16; ++i) { const int l = i ^ j; if (l > i) { const int hi = max(a[i], a[l]), lo = min(a[i], a[l]); a[i] = hi; a[l] = lo; } }
}
__device__ __forceinline__ void merge_partner(int (&a)[16]) {
    int b[16];
#pragma unroll
    for (int i = 0; i < 16; ++i) b[i] = __shfl_xor(a[i], 32);
    merge16(a, b);
}
__device__ __forceinline__ int f2skey(float s) { const int b = (int)__float_as_uint(s); return b ^ ((b >> 31) & 0x7fffffff); }
__device__ __forceinline__ float skey2f(int k) { return __uint_as_float((unsigned)(k ^ ((k >> 31) & 0x7fffffff))); }

__device__ __forceinline__ float sel_f(bool c, float a, float b) { asm volatile("" : "+v"(a), "+v"(b)); return c ? a : b; }
__device__ __forceinline__ int sel_i(bool c, int a, int b) { asm volatile("" : "+v"(a), "+v"(b)); return c ? a : b; }
struct CandTab { int ci[64], cj[64]; };
__host__ __device__ constexpr CandTab make_cand() { CandTab t{}; int n = 0; for (int i = 0; i < 16; ++i) for (int j = 0; j < 16; ++j) if ((i + 1) * (j + 1) <= 16) { t.ci[n] = i; t.cj[n] = j; ++n; } return t; }

__device__ __forceinline__ void peersel_item(int tg, int l, const bf16_t* __restrict__ QP, const bf16_t* __restrict__ SK, unsigned* __restrict__ PIDX, float* __restrict__ PG, lds_t lds) {
    const int tid = otid(), lane = tid & 63, head = tid >> 6, l31 = lane & 31, hh = lane >> 5;
    const size_t tok = (size_t)tg * 32 + l31;
    int L[2][16];
#pragma unroll
    for (int p = 0; p < 2; ++p) {
        f32x16 acc[4];
#pragma unroll
        for (int nt = 0; nt < 4; ++nt)
#pragma unroll
            for (int r = 0; r < 16; ++r) acc[nt][r] = 0.f;
        const bf16_t* qp = QP + tok * 2048 + (head * 2 + p) * 128 + 8 * hh;
        const bf16_t* sk = SK + ((size_t)((l * 8 + head) * 2 + p) * 128 + l31) * 128 + 8 * hh;
        { int oz = 0; asm volatile("" : "+v"(oz)); sk += oz; }
#pragma unroll 2
        for (int ks = 0; ks < 8; ++ks) {
            const bf16x8 qv = *(const bf16x8*)(qp + ks * 16);
#pragma unroll
            for (int nt = 0; nt < 4; ++nt) { const bf16x8 sv = *(const bf16x8*)(sk + (size_t)nt * 32 * 128 + ks * 16); acc[nt] = MFMA32(sv, qv, acc[nt]); }
        }
#pragma unroll
        for (int nt = 0; nt < 4; ++nt) {
            int g[16];
#pragma unroll
            for (int r = 0; r < 16; ++r) { const int n0 = nt * 32 + (r & 3) + 8 * (r >> 2); g[r] = (f2skey(acc[nt][r]) & ~127) | ((127 - n0) - 4 * hh); }
            bitonic_desc<16>(g);
            if (nt == 0) {
#pragma unroll
                for (int r = 0; r < 16; ++r) L[p][r] = g[r];
            } else merge16(L[p], g);
            __builtin_amdgcn_sched_barrier(0);
        }
        merge_partner(L[p]);
        __builtin_amdgcn_sched_barrier(0);
    }
    LAS unsigned char* nl = (LAS unsigned char*)lds + (size_t)tid * 32;
#pragma unroll
    for (int i = 0; i < 16; ++i) { nl[i] = (unsigned char)(127 - (L[0][i] & 127)); nl[16 + i] = (unsigned char)(127 - (L[1][i] & 127)); }
    float va[16], vb[16];
#pragma unroll
    for (int i = 0; i < 16; ++i) { va[i] = skey2f(L[0][i] & ~127); vb[i] = skey2f(L[1][i] & ~127); }
    constexpr CandTab ct = make_cand();
    int cA[16], cB[16];
#pragma unroll
    for (int m = 0; m < 16; ++m) {
        const float s = sel_f(hh, va[ct.ci[2 * m + 1]], va[ct.ci[2 * m]]) + sel_f(hh, vb[ct.cj[2 * m + 1]], vb[ct.cj[2 * m]]);
        const int code = hh ? (ct.ci[2 * m + 1] * 16 + ct.cj[2 * m + 1]) : (ct.ci[2 * m] * 16 + ct.cj[2 * m]);
        cA[m] = (f2skey(s) & ~255) | (255 - code);
    }
#pragma unroll
    for (int m = 16; m < 32; ++m) {
        if (m < 25) {
            const float s = sel_f(hh, va[ct.ci[2 * m + 1]], va[ct.ci[2 * m]]) + sel_f(hh, vb[ct.cj[2 * m + 1]], vb[ct.cj[2 * m]]);
            const int code = hh ? (ct.ci[2 * m + 1] * 16 + ct.cj[2 * m + 1]) : (ct.ci[2 * m] * 16 + ct.cj[2 * m]);
            cB[m - 16] = (f2skey(s) & ~255) | (255 - code);
        } else cB[m - 16] = (int)0x80000000;
    }
    __builtin_amdgcn_sched_barrier(0);
    bitonic_desc<16>(cA); bitonic_desc<16>(cB);
    merge16(cA, cB);
    merge_partner(cA);
    lds_fence();
    float val[16], ex[16], sum = 0.f;
#pragma unroll
    for (int r = 0; r < 16; ++r) val[r] = skey2f(cA[r] & ~255);
#pragma unroll
    for (int r = 0; r < 16; ++r) { ex[r] = __expf(val[r] - val[0]); sum += ex[r]; }
    const float inv = 1.0f / sum;
#pragma unroll
    for (int r = 0; r < 8; ++r) {
        const int kk = sel_i(hh, cA[8 + r], cA[r]);
        const float gk = sel_f(hh, ex[8 + r], ex[r]) * inv;
        const int code = 255 - (kk & 255);
        const unsigned ia = nl[code >> 4], ib = nl[16 + (code & 15)];
        PIDX[tok * 128 + head * 16 + 8 * hh + r] = ia * 128u + ib;
        PG[tok * 128 + head * 16 + 8 * hh + r] = gk;
    }
}

__device__ __forceinline__ void fp8x16_to_f32(const u32x4 w, float (&f)[16]) {
#pragma unroll
    for (int i = 0; i < 4; ++i) {
        const f32x2 lo = __builtin_amdgcn_cvt_pk_f32_fp8((int)w[i], false), hi = __builtin_amdgcn_cvt_pk_f32_fp8((int)w[i], true);
        f[4 * i] = lo[0]; f[4 * i + 1] = lo[1]; f[4 * i + 2] = hi[0]; f[4 * i + 3] = hi[1];
    }
}
__device__ __forceinline__ void peer_gather(int l, const bf16_t* __restrict__ H, const unsigned* __restrict__ PIDX, const float* __restrict__ PG, const unsigned char* __restrict__ EU, const unsigned char* __restrict__ EV,
                                            const float* __restrict__ ES, const float* __restrict__ gate  , float* x, float* xout,
                                            const float* __restrict__ nrmw  , const float* __restrict__ nsh, const float* __restrict__ nsc  , bf16_t* hnext, float* fout) {
    const int tid = otid(), lane = tid & 63, wid = tid >> 6, g = lane >> 4, j = lane & 15;
    const int nw = gridDim.x * 8;
    const unsigned char* eu = EU + (size_t)l * NEXP * D;
    const unsigned char* ev = EV + (size_t)l * NEXP * D;
    const f32x2* es = (const f32x2*)ES + (size_t)l * NEXP;
    for (int gw = blockIdx.x * 8 + wid; gw * 32 < T; gw += nw) {
        const int b = (gw * 32) / S;
        for (int tr = 0; tr < 32; ++tr) {
            const size_t t = (size_t)gw * 32 + tr;
            unsigned hp[4][8];
#pragma unroll
            for (int i = 0; i < 4; ++i) {
                const u32x4 a = *(const u32x4*)(H + t * D + (j + 16 * i) * 16), c = *(const u32x4*)(H + t * D + (j + 16 * i) * 16 + 8);
#pragma unroll
                for (int q = 0; q < 4; ++q) { hp[i][q] = a[q]; hp[i][4 + q] = c[q]; }
            }
            const unsigned e0 = PIDX[t * 128 + lane], e1 = PIDX[t * 128 + 64 + lane];
            const float g0 = PG[t * 128 + lane], g1 = PG[t * 128 + 64 + lane];
            float acc[16];
#pragma unroll
            for (int i = 0; i < 16; ++i) acc[i] = 0.f;
            unsigned eid_n[2]; float gt_n[2]; u32x4 un[2][4]; f32x2 sc_n[2];
#pragma unroll
            for (int h2 = 0; h2 < 2; ++h2) {
                eid_n[h2] = (unsigned)__shfl((int)e0, 4 * h2 + g); gt_n[h2] = __shfl(g0, 4 * h2 + g);
                const unsigned char* ur = eu + (size_t)eid_n[h2] * D + j * 16;
#pragma unroll
                for (int i = 0; i < 4; ++i) un[h2][i] = *(const u32x4*)(ur + i * 256);
                sc_n[h2] = es[eid_n[h2]];
            }
            for (int it = 0; it < 16; ++it) {
                unsigned eid[2]; float gt[2]; f32x2 sc[2]; u32x4 uc[2][4], vv[2][4];
#pragma unroll
                for (int h2 = 0; h2 < 2; ++h2) {
                    eid[h2] = eid_n[h2]; gt[h2] = gt_n[h2]; sc[h2] = sc_n[h2];
#pragma unroll
                    for (int i = 0; i < 4; ++i) uc[h2][i] = un[h2][i];
#pragma unroll
                    for (int gg = 0; gg < 4; ++gg) { const unsigned ve = (unsigned)__builtin_amdgcn_readlane((int)eid[h2], gg * 16); vv[h2][gg] = *(const u32x4*)(ev + (size_t)ve * D + lane * 16); }
                }
                if (it + 1 < 16) {
#pragma unroll
                    for (int h2 = 0; h2 < 2; ++h2) {
                        const int ent = (it + 1) * 8 + 4 * h2 + g;
                        eid_n[h2] = (unsigned)__shfl((int)(it + 1 < 8 ? e0 : e1), ent & 63); gt_n[h2] = __shfl(it + 1 < 8 ? g0 : g1, ent & 63);
                        const unsigned char* ur = eu + (size_t)eid_n[h2] * D + j * 16;
#pragma unroll
                        for (int i = 0; i < 4; ++i) un[h2][i] = *(const u32x4*)(ur + i * 256);
                        sc_n[h2] = es[eid_n[h2]];
                    }
                }
#pragma unroll
                for (int h2 = 0; h2 < 2; ++h2) {
                    float part = 0.f;
#pragma unroll
                    for (int i = 0; i < 4; ++i) {
                        float uf[16]; fp8x16_to_f32(uc[h2][i], uf);
#pragma unroll
                        for (int q = 0; q < 8; ++q) part = dot2bf(pk_bf16(uf[2 * q], uf[2 * q + 1]), hp[i][q], part);
                    }
                    part += __shfl_xor(part, 1); part += __shfl_xor(part, 2); part += __shfl_xor(part, 4); part += __shfl_xor(part, 8);
                    const float a = part * sc[h2][0];
                    const float act = gt[h2] * 0.5f * a * (1.0f + erff(a * 0.70710678118654752f)) * sc[h2][1];
#pragma unroll
                    for (int gg = 0; gg < 4; ++gg) {
                        const float av = __uint_as_float((unsigned)__builtin_amdgcn_readlane((int)__float_as_uint(act), gg * 16));
                        float vf[16]; fp8x16_to_f32(vv[h2][gg], vf);
#pragma unroll
                        for (int q = 0; q < 16; ++q) acc[q] = fmaf(av, vf[q], acc[q]);
                    }
                }
            }
            float* xr = x + t * D + lane * 16; float* xw = xout + t * D + lane * 16;
            const float* gr = gate + (size_t)b * 6144 + lane * 16;
            f32x4 xn[4]; float ss = 0.f;
#pragma unroll
            for (int q = 0; q < 4; ++q) {
                const f32x4 xo = *(const f32x4*)(xr + 4 * q), gg4 = *(const f32x4*)(gr + 4 * q);
                f32x4 a4; a4[0] = acc[4 * q]; a4[1] = acc[4 * q + 1]; a4[2] = acc[4 * q + 2]; a4[3] = acc[4 * q + 3];
                xn[q] = xo + gg4 * a4;
                ss += xn[q][0] * xn[q][0] + xn[q][1] * xn[q][1] + xn[q][2] * xn[q][2] + xn[q][3] * xn[q][3];
            }
            ss = wave_sum(ss);
            const float rstd = rsqrtf(ss * (1.0f / D) + 1e-6f);
            int ozn = 0; asm volatile("" : "+v"(ozn));
#pragma unroll
            for (int q = 0; q < 4; ++q) {
                const f32x4 w4 = *(const f32x4*)(nrmw + lane * 16 + 4 * q + ozn);
                f32x4 y = xn[q] * rstd * w4;
                if (nsc) {
                    *(f32x4*)(xw + 4 * q) = xn[q];
                    const f32x4 c4 = *(const f32x4*)(nsc + (size_t)b * 6144 + lane * 16 + 4 * q + ozn) + 1.0f, s4 = *(const f32x4*)(nsh + (size_t)b * 6144 + lane * 16 + 4 * q + ozn);
                    y = y * c4 + s4;
                    u32x2 w; w.x = pk_bf16(y[0], y[1]); w.y = pk_bf16(y[2], y[3]);
                    *(u32x2*)(hnext + t * D + lane * 16 + 4 * q) = w;
                } else {
                    *(f32x4*)(fout + t * D + lane * 16 + 4 * q) = y;
                }
            }
        }
    }
}

__global__ void __launch_bounds__(NTHREADS, 2) mega(const float* x, const float* c, const int* pos, const float* w_ada, const float* b_ada, const float* norm_mix, const float* w_in, const float* w_pool,
                                                     const float* pool_scale, const float* w_out, const float* norm_ffn, const float* w_query, const float* sub_keys, const float* expert_u, const float* expert_v,
                                                     const float* final_norm, float* out, unsigned char* wsp, int ph_lo, int ph_hi) {
    Params p; p.x = x; p.c = c; p.pos = pos; p.w_ada = w_ada; p.b_ada = b_ada; p.norm_mix = norm_mix; p.w_in = w_in; p.w_pool = w_pool; p.pool_scale = pool_scale; p.w_out = w_out; p.norm_ffn = norm_ffn;
    p.w_query = w_query; p.sub_keys = sub_keys; p.expert_u = expert_u; p.expert_v = expert_v; p.final_norm = final_norm; p.out = out; p.ws = wsp; p.ph_lo = ph_lo; p.ph_hi = ph_hi;
    __shared__ __attribute__((aligned(16))) unsigned char smem_raw[LDS_BYTES];
    lds_t lds = (lds_t)smem_raw;
    unsigned char* ws = p.ws;
    volatile LAS unsigned* st = (volatile LAS unsigned*)(lds + 147456);
    if (threadIdx.x == 0) { st[0] = 0u; st[1] = 0u; st[2] = 0u; st[3] = 0u; }
    __syncthreads();
    XcdBarrier bar = xcd_barrier_post((unsigned*)(ws + WS_CTL), st);
    const int lo = p.ph_lo, hi = p.ph_hi, G = gridDim.x, bid = blockIdx.x;
#define RUN(n) ((n) >= lo && (n) < hi)
#define SEAM(n) do { if ((n) >= lo && (n) + 1 < hi) xcd_barrier(bar); } while (0)

    float* modp = (float*)(ws + WS_MOD);
    bf16_t* Hb = (bf16_t*)(ws + WS_H);

    if (RUN(0)) phase_prologue(p, lds);
    SEAM(0);
    for (int l = 0; l < DEPTH; ++l) {
        const int pb = 1 + 9 * l;
        unsigned char* const ws0 = p.ws;
        const float* xin = (l == 0) ? p.x : p.out;
        const float* modl = modp + (size_t)l * NB * 6144;
        if (RUN(pb + 0) && l == 0) { size_t oz = 0; asm volatile("" : "+s"(oz)); unsigned char* ws = ws0 + oz;     bf16_t* Hb = (bf16_t*)(ws + WS_H); float* modp = (float*)(ws + WS_MOD); const float* modl = modp + (size_t)l * NB * 6144; phase_norm<0>(xin, p.norm_mix + (size_t)l * D, modl + 0, modl + 1024, Hb, nullptr); }
        if (l == 0) SEAM(pb + 0);
        if (RUN(pb + 1)) { size_t oz = 0; asm volatile("" : "+s"(oz)); unsigned char* ws = ws0 + oz;     bf16_t* Hb = (bf16_t*)(ws + WS_H); float* modp = (float*)(ws + WS_MOD); const float* modl = modp + (size_t)l * NB * 6144; { }
            EpiIn ep; ep.xp = (bf16_t*)(ws + WS_XP); ep.q = (bf16_t*)(ws + WS_Q); ep.k = (bf16_t*)(ws + WS_K); ep.vt = (bf16_t*)(ws + WS_VT); ep.qi = (bf16_t*)(ws + WS_QI); ep.ki = (bf16_t*)(ws + WS_KI);
            ep.wi = (float*)(ws + WS_WI); ep.rope = (const float*)(ws + WS_ROPE);
            gemm_phase(Hb, (const bf16_t*)(ws + WS_WIN) + (size_t)l * NIN * D, NIN, ep, lds);
#if MK_DUP & 1
            { __syncthreads(); EpiNull en; en.sink = (float*)(ws + 746 * MBy); gemm_phase<MK_DUPVAR>(Hb, (const bf16_t*)(ws + WS_WIN) + (size_t)l * NIN * D, NIN, en, lds); }
#endif
        }
        SEAM(pb + 1);
        if (RUN(pb + 2)) { size_t oz = 0; asm volatile("" : "+s"(oz)); unsigned char* ws = ws0 + oz;     bf16_t* Hb = (bf16_t*)(ws + WS_H); float* modp = (float*)(ws + WS_MOD); const float* modl = modp + (size_t)l * NB * 6144; { }
            for (int e = bid; e < 2048; e += G) topk_item<0>(e, (const bf16_t*)(ws + WS_QI), (const bf16_t*)(ws + WS_KI), (const float*)(ws + WS_WI), (unsigned*)(ws + WS_MASK), lds);
#if MK_DUP & 2
            for (int e = bid; e < 2048; e += G) topk_item<MK_DUPVAR>(e, (const bf16_t*)(ws + WS_QI), (const bf16_t*)(ws + WS_KI), (const float*)(ws + WS_WI), (unsigned*)(ws + 746 * MBy), lds);
#endif
            for (int e = bid; e < 2048; e += G) pool_item(e, (const bf16_t*)(ws + WS_XP), (const bf16_t*)(ws + WS_WPOOL) + (size_t)l * 4 * 128 * 128, p.pool_scale + (size_t)l * 512, Hb, lds);
        }
        SEAM(pb + 2);
        if (RUN(pb + 3)) { size_t oz = 0; asm volatile("" : "+s"(oz)); unsigned char* ws = ws0 + oz;     bf16_t* Hb = (bf16_t*)(ws + WS_H); float* modp = (float*)(ws + WS_MOD); const float* modl = modp + (size_t)l * NB * 6144; { }
            for (int e = bid; e < 2048; e += G) attn_item(e, (const bf16_t*)(ws + WS_Q), (const bf16_t*)(ws + WS_K), (const bf16_t*)(ws + WS_VT), (const unsigned*)(ws + WS_MASK), Hb, lds);
#if MK_DUP & 8
            __syncthreads(); for (int e = bid; e < 2048; e += G) attn_item(e, (const bf16_t*)(ws + WS_Q), (const bf16_t*)(ws + WS_K), (const bf16_t*)(ws + WS_VT), (const unsigned*)(ws + WS_MASK), Hb, lds);
#endif
        }
        SEAM(pb + 3);
        if (RUN(pb + 4)) { size_t oz = 0; asm volatile("" : "+s"(oz)); unsigned char* ws = ws0 + oz;     bf16_t* Hb = (bf16_t*)(ws + WS_H); float* modp = (float*)(ws + WS_MOD); const float* modl = modp + (size_t)l * NB * 6144; { }
            EpiOut ep; ep.xin = xin; ep.xout = p.out; ep.gate = modl + 2 * 1024;
            gemm_phase(Hb, (const bf16_t*)(ws + WS_WOUT) + (size_t)l * D * D, D, ep, lds);
        }
        SEAM(pb + 4);
        if (RUN(pb + 5)) { size_t oz = 0; asm volatile("" : "+s"(oz)); unsigned char* ws = ws0 + oz;     bf16_t* Hb = (bf16_t*)(ws + WS_H); float* modp = (float*)(ws + WS_MOD); const float* modl = modp + (size_t)l * NB * 6144; phase_norm<0>(p.out, p.norm_ffn + (size_t)l * D, modl + 3 * 1024, modl + 4 * 1024, Hb, nullptr); }
        SEAM(pb + 5);
        if (RUN(pb + 6)) { size_t oz = 0; asm volatile("" : "+s"(oz)); unsigned char* ws = ws0 + oz;     bf16_t* Hb = (bf16_t*)(ws + WS_H); float* modp = (float*)(ws + WS_MOD); const float* modl = modp + (size_t)l * NB * 6144; { }
            EpiBf ep; ep.C = (bf16_t*)(ws + WS_QP); ep.ldc = 2048;
            gemm_phase(Hb, (const bf16_t*)(ws + WS_WQ) + (size_t)l * 2048 * D, 2048, ep, lds);
#if MK_DUP & 32
            __syncthreads(); gemm_phase(Hb, (const bf16_t*)(ws + WS_WQ) + (size_t)l * 2048 * D, 2048, ep, lds);
#endif
        }
        SEAM(pb + 6);
        if (RUN(pb + 7)) { size_t oz = 0; asm volatile("" : "+s"(oz)); unsigned char* ws = ws0 + oz;     bf16_t* Hb = (bf16_t*)(ws + WS_H); float* modp = (float*)(ws + WS_MOD); const float* modl = modp + (size_t)l * NB * 6144; { }
            for (int e = bid; e < 2048; e += G) peersel_item(e, l, (const bf16_t*)(ws + WS_QP), (const bf16_t*)(ws + WS_SK), (unsigned*)(ws + WS_PIDX), (float*)(ws + WS_PG), lds);
#if MK_DUP & 64
            for (int e = bid; e < 2048; e += G) peersel_item(e, l, (const bf16_t*)(ws + WS_QP), (const bf16_t*)(ws + WS_SK), (unsigned*)(ws + WS_PIDX), (float*)(ws + WS_PG), lds);
#endif
        }
        SEAM(pb + 7);
        if (RUN(pb + 8)) { size_t oz = 0; asm volatile("" : "+s"(oz)); unsigned char* ws = ws0 + oz;     bf16_t* Hb = (bf16_t*)(ws + WS_H); float* modp = (float*)(ws + WS_MOD); const float* modl = modp + (size_t)l * NB * 6144;
#if MK_DUP & 128
            peer_gather(l, Hb, (const unsigned*)(ws + WS_PIDX), (const float*)(ws + WS_PG), (const unsigned char*)(ws + WS_EU), (const unsigned char*)(ws + WS_EV), (const float*)(ws + WS_ES), modl + 5 * 1024, p.out, (float*)(ws + 746 * MBy), p.final_norm, nullptr, nullptr, nullptr, (float*)(ws + 746 * MBy));
#endif
            peer_gather(l, Hb, (const unsigned*)(ws + WS_PIDX), (const float*)(ws + WS_PG), (const unsigned char*)(ws + WS_EU), (const unsigned char*)(ws + WS_EV), (const float*)(ws + WS_ES), modl + 5 * 1024, p.out, p.out,
                        l + 1 < DEPTH ? p.norm_mix + (size_t)(l + 1) * D : p.final_norm, l + 1 < DEPTH ? modp + (size_t)(l + 1) * NB * 6144 : nullptr, l + 1 < DEPTH ? modp + (size_t)(l + 1) * NB * 6144 + 1024 : nullptr, Hb, p.out); }
        if (l + 1 < DEPTH) SEAM(pb + 8);
    }
#undef RUN
#undef SEAM
}


#ifndef MK_CHECK
#define MK_CHECK 0
#endif
#ifndef MK_CHECK_LAYER
#define MK_CHECK_LAYER 0
#endif
#ifndef MK_CHECK_SLOT0
#define MK_CHECK_SLOT0 0
#endif
#if MK_CHECK
__device__ __forceinline__ unsigned hash32(unsigned x) { x ^= x >> 16; x *= 0x7feb352dU; x ^= x >> 15; x *= 0x846ca68bU; x ^= x >> 16; return x; }
__device__ __forceinline__ float bfv(const bf16_t* p, size_t i) { return __uint_as_float((unsigned)p[i] << 16); }
__device__ __forceinline__ bool badrel(float got, float ref, float rtol, float atol) { return !(fabsf(got - ref) <= atol + rtol * fabsf(ref)); }
#define DIAG(p) ((unsigned*)((p).ws + WS_CTL + 32768))
constexpr size_t WS_XCOPY = 746 * MBy;

__global__ void chk_mod(Params p) {
    const unsigned id = blockIdx.x * blockDim.x + threadIdx.x;
    const unsigned h = hash32(id * 3u + 1u);
    const int l = h & 1, b = (h >> 1) & 7, j = (h >> 4) % 6144;
    float s = 0.f;
    for (int k = 0; k < D; ++k) { const float c = p.c[b * D + k]; s += (c / (1.f + expf(-c))) * p.w_ada[((size_t)l * D + k) * 6144 + j]; }
    s += p.b_ada[l * 6144 + j];
    const float got = ((const float*)(p.ws + WS_MOD))[((size_t)l * NB + b) * 6144 + j];
    if (badrel(got, s, 1e-3f, 1e-4f)) atomicAdd(DIAG(p) + 0, 1u);
}
__global__ void chk_norm(Params p, int l, int which, const float* xin, int slot) {
    const unsigned id = blockIdx.x * blockDim.x + threadIdx.x;
    const unsigned h = hash32(id * 7u + 3u);
    const int t = h % T, b = t / S;
    const float* xr = xin + (size_t)t * D;
    float ss = 0.f; for (int k = 0; k < D; ++k) ss += xr[k] * xr[k];
    const float rstd = 1.0f / sqrtf(ss / D + 1e-6f);
    const float* modl = (const float*)(p.ws + WS_MOD) + ((size_t)l * NB + b) * 6144;
    const float* gw = (which ? p.norm_ffn : p.norm_mix) + (size_t)l * D;
    const float* sh = modl + (which ? 3 : 0) * 1024; const float* sc = modl + (which ? 4 : 1) * 1024;
    const bf16_t* hb = (const bf16_t*)(p.ws + WS_H);
    for (int q = 0; q < 4; ++q) {
        const int n = hash32(h + q) % D;
        const float ref = xr[n] * rstd * gw[n] * (1.f + sc[n]) + sh[n];
        if (badrel(bfv(hb, (size_t)t * D + n), ref, 1e-2f, 1e-2f)) atomicAdd(DIAG(p) + slot, 1u);
    }
}
__device__ float dot_h_w(const bf16_t* hrow, const float* w, int ldw, int n) { float s = 0.f; for (int k = 0; k < D; ++k) s += bfv(hrow, k) * w[(size_t)k * ldw + n]; return s; }
__global__ void chk_in(Params p, int l) {
    const unsigned id = blockIdx.x * blockDim.x + threadIdx.x;
    const unsigned h = hash32(id * 11u + 5u);
    const int t = h % T; const int n = hash32(h) % DIN;
    const bf16_t* hrow = (const bf16_t*)(p.ws + WS_H) + (size_t)t * D;
    const float* w = p.w_in + (size_t)l * D * DIN;
    const float* rope = (const float*)(p.ws + WS_ROPE) + (size_t)t * 16;
    const int b = t / S, s = t % S;
    float ref, got; int slot = 2;
    auto roped = [&](int base, int d) -> float {
        if (d >= 16) return dot_h_w(hrow, w, DIN, base + d);
        const int f = d & 7; const float x1 = dot_h_w(hrow, w, DIN, base + f), x2 = dot_h_w(hrow, w, DIN, base + 8 + f);
        return d < 8 ? x1 * rope[f] - x2 * rope[8 + f] : x1 * rope[8 + f] + x2 * rope[f];
    };
    if (n < 512) { ref = dot_h_w(hrow, w, DIN, n); got = bfv((const bf16_t*)(p.ws + WS_XP), (size_t)t * 512 + n); }
    else if (n < 1024) { const int c = n - 512; ref = roped(512 + (c & ~63), c & 63) * 0.125f; got = bfv((const bf16_t*)(p.ws + WS_Q), (size_t)t * 512 + c); }
    else if (n < 1536) { const int c = n - 1024; ref = roped(1024 + (c & ~63), c & 63); got = bfv((const bf16_t*)(p.ws + WS_K), (size_t)t * 512 + c); }
    else if (n < 2048) { const int c = n - 1536; ref = dot_h_w(hrow, w, DIN, n); got = bfv((const bf16_t*)(p.ws + WS_VT), ((size_t)(b * 8 + (c >> 6)) * 64 + (c & 63)) * S + s); }
    else if (n < 2560) { const int c = n - 2048; ref = roped(2048 + (c & ~63), c & 63) * 0.125f; got = bfv((const bf16_t*)(p.ws + WS_QI), (size_t)t * 512 + c); }
    else if (n < 2624) { const int c = n - 2560; ref = roped(2560, c); got = bfv((const bf16_t*)(p.ws + WS_KI), (size_t)t * 64 + c); }
    else { const int c = n - 2624; ref = dot_h_w(hrow, w, DIN, n) * 0.35355339f; got = ((const float*)(p.ws + WS_WI))[(size_t)t * 8 + c]; }
    if (badrel(got, ref, 2e-2f, 3e-2f)) atomicAdd(DIAG(p) + slot, 1u);
}
__global__ void chk_pool(Params p, int l) {
    const unsigned id = blockIdx.x * blockDim.x + threadIdx.x;
    const unsigned h = hash32(id * 13u + 7u);
    const int t = h % T, s = t % S; const int n = hash32(h) % 512, g = n >> 7, d = n & 127, w = 2 << g;
    const bf16_t* xp = (const bf16_t*)(p.ws + WS_XP);
    float ref = 0.f;
    for (int c = 0; c < 128; ++c) {
        float sum = 0.f; int cnt = 0;
        for (int jj = 0; jj < w; ++jj) if (s - jj >= 0) { sum += bfv(xp, (size_t)(t - jj) * 512 + g * 128 + c); ++cnt; }
        const float pooled = sum / (float)cnt - bfv(xp, (size_t)t * 512 + g * 128 + c);
        ref += pooled * p.w_pool[(((size_t)l * 4 + g) * 128 + c) * 128 + d];
    }
    ref *= p.pool_scale[l * 512 + n];
    if (badrel(bfv((const bf16_t*)(p.ws + WS_H), (size_t)t * D + n), ref, 3e-2f, 3e-2f)) atomicAdd(DIAG(p) + 3, 1u);
}
__global__ void __launch_bounds__(512) chk_topk(Params p) {
    __shared__ float sc[S];
    __shared__ int nbad;
    const unsigned h = hash32(blockIdx.x * 17u + 9u);
    const int b = h & 7; int tq = (h >> 3) % S; if (blockIdx.x < 8) tq = blockIdx.x * 40;
    const size_t tokb = (size_t)b * S;
    const bf16_t* QI = (const bf16_t*)(p.ws + WS_QI); const bf16_t* KI = (const bf16_t*)(p.ws + WS_KI); const float* WI = (const float*)(p.ws + WS_WI);
    if (threadIdx.x == 0) nbad = 0;
    for (int s = threadIdx.x; s <= tq; s += 512) {
        float tot = 0.f;
        for (int hd = 0; hd < 8; ++hd) { float dsum = 0.f; for (int d = 0; d < 64; ++d) dsum += bfv(QI, (tokb + tq) * 512 + hd * 64 + d) * bfv(KI, (tokb + s) * 64 + d); tot += WI[(tokb + tq) * 8 + hd] * fmaxf(dsum, 0.f); }
        sc[s] = tot;
    }
    __syncthreads();
    int bad = 0;
    for (int s = threadIdx.x; s < S; s += 512) {
        bool sel = false;
        if (s <= tq) { const float v = sc[s]; int rank = 0; for (int s2 = 0; s2 <= tq; ++s2) { const float v2 = sc[s2]; rank += (v2 > v || (v2 == v && s2 < s)) ? 1 : 0; } sel = rank < 256; }
        const unsigned wmask = ((const unsigned*)(p.ws + WS_MASK))[(tokb + tq) * 256 + (s >> 5)];
        if (((wmask >> (s & 31)) & 1u) != (sel ? 1u : 0u)) ++bad;
    }
    atomicAdd(&nbad, bad);
    __syncthreads();
    if (threadIdx.x == 0 && nbad > 6) atomicAdd(DIAG(p) + 4, 1u);
}
__global__ void chk_attn(Params p) {
    const unsigned id = blockIdx.x * blockDim.x + threadIdx.x;
    const unsigned h = hash32(id * 19u + 11u);
    const int t = h % T, b = t / S, tq = t % S, head = (h >> 20) & 7, d = (h >> 24) & 63;
    const size_t tokb = (size_t)b * S;
    const bf16_t* Q = (const bf16_t*)(p.ws + WS_Q); const bf16_t* K = (const bf16_t*)(p.ws + WS_K); const bf16_t* VT = (const bf16_t*)(p.ws + WS_VT);
    const unsigned* M = (const unsigned*)(p.ws + WS_MASK) + (size_t)t * 256;
    float mx = -1e30f;
    for (int s = 0; s <= tq; ++s) if ((M[s >> 5] >> (s & 31)) & 1u) { float lg = 0.f; for (int e = 0; e < 64; ++e) lg += bfv(Q, (size_t)t * 512 + head * 64 + e) * bfv(K, (tokb + s) * 512 + head * 64 + e); mx = fmaxf(mx, lg); }
    float den = 0.f, num = 0.f;
    for (int s = 0; s <= tq; ++s) if ((M[s >> 5] >> (s & 31)) & 1u) { float lg = 0.f; for (int e = 0; e < 64; ++e) lg += bfv(Q, (size_t)t * 512 + head * 64 + e) * bfv(K, (tokb + s) * 512 + head * 64 + e); const float pe = expf(lg - mx); den += pe; num += pe * bfv(VT, ((size_t)(b * 8 + head) * 64 + d) * S + s); }
    const float ref = num / den;
    if (badrel(bfv((const bf16_t*)(p.ws + WS_H), (size_t)t * D + 512 + head * 64 + d), ref, 3e-2f, 1e-2f)) atomicAdd(DIAG(p) + 5, 1u);
}
__global__ void chk_out(Params p, int l, const float* xin) {
    const unsigned id = blockIdx.x * blockDim.x + threadIdx.x;
    const unsigned h = hash32(id * 23u + 13u);
    const int t = h % T, b = t / S, n = hash32(h) % D;
    const bf16_t* mrow = (const bf16_t*)(p.ws + WS_H) + (size_t)t * D;
    float s = 0.f; for (int k = 0; k < D; ++k) s += bfv(mrow, k) * p.w_out[((size_t)l * D + k) * D + n];
    const float g1 = ((const float*)(p.ws + WS_MOD))[((size_t)l * NB + b) * 6144 + 2048 + n];
    const float ref = xin[(size_t)t * D + n] + g1 * s;
    if (badrel(p.out[(size_t)t * D + n], ref, 1e-2f, 1e-2f)) atomicAdd(DIAG(p) + 6, 1u);
}
__global__ void chk_q(Params p, int l) {
    const unsigned id = blockIdx.x * blockDim.x + threadIdx.x;
    const unsigned h = hash32(id * 29u + 17u);
    const int t = h % T, n = hash32(h) % 2048;
    const bf16_t* hrow = (const bf16_t*)(p.ws + WS_H) + (size_t)t * D;
    const float ref = dot_h_w(hrow, p.w_query + (size_t)l * D * 2048, 2048, n);
    if (badrel(bfv((const bf16_t*)(p.ws + WS_QP), (size_t)t * 2048 + n), ref, 2e-2f, 3e-2f)) atomicAdd(DIAG(p) + 8, 1u);
}
__global__ void __launch_bounds__(64) chk_sel(Params p, int l) {
    __shared__ float tv[2][16][64]; __shared__ int ti[2][16][64]; __shared__ float cv[16][64]; __shared__ int cid[16][64];
    const int x = threadIdx.x;
    const unsigned id = blockIdx.x * blockDim.x + threadIdx.x;
    const unsigned h = hash32(id * 31u + 19u);
    const int t = h % T, head = (h >> 20) & 7;
    const bf16_t* QP = (const bf16_t*)(p.ws + WS_QP);
    for (int pp = 0; pp < 2; ++pp) {
        for (int i = 0; i < 16; ++i) { tv[pp][i][x] = -1e30f; ti[pp][i][x] = -1; }
        for (int n = 0; n < 128; ++n) {
            float s = 0.f; for (int d = 0; d < 128; ++d) s += bfv(QP, (size_t)t * 2048 + (head * 2 + pp) * 128 + d) * p.sub_keys[((((size_t)l * 8 + head) * 2 + pp) * 128 + n) * 128 + d];
            int pos = 16; for (int i = 15; i >= 0; --i) if (s > tv[pp][i][x]) pos = i;
            for (int i = 15; i > pos; --i) { tv[pp][i][x] = tv[pp][i - 1][x]; ti[pp][i][x] = ti[pp][i - 1][x]; }
            if (pos < 16) { tv[pp][pos][x] = s; ti[pp][pos][x] = n; }
        }
    }
    for (int i = 0; i < 16; ++i) { cv[i][x] = -1e30f; cid[i][x] = -1; }
    for (int i = 0; i < 16; ++i) for (int j = 0; j < 16; ++j) {
        const float s = tv[0][i][x] + tv[1][j][x];
        int pos = 16; for (int q = 15; q >= 0; --q) if (s > cv[q][x]) pos = q;
        for (int q = 15; q > pos; --q) { cv[q][x] = cv[q - 1][x]; cid[q][x] = cid[q - 1][x]; }
        if (pos < 16) { cv[pos][x] = s; cid[pos][x] = ti[0][i][x] * 128 + ti[1][j][x]; }
    }
    float den = 0.f; for (int i = 0; i < 16; ++i) den += expf(cv[i][x] - cv[0][x]);
    const unsigned* PI = (const unsigned*)(p.ws + WS_PIDX) + (size_t)t * 128 + head * 16; const float* PGp = (const float*)(p.ws + WS_PG) + (size_t)t * 128 + head * 16;
    int miss = 0;
    for (int i = 0; i < 16; ++i) {
        const float g = expf(cv[i][x] - cv[0][x]) / den; bool found = false;
        for (int q = 0; q < 16; ++q) if ((int)PI[q] == cid[i][x]) { found = true; if (badrel(PGp[q], g, 5e-2f, 2e-3f)) ++miss; }
        if (!found) ++miss;
    }
    if (miss > 2) atomicAdd(DIAG(p) + 9, 1u);
}
__global__ void chk_gather(Params p, int l) {
    const unsigned id = blockIdx.x * blockDim.x + threadIdx.x;
    const unsigned h = hash32(id * 37u + 23u);
    const int t = h % T, b = t / S, n = hash32(h) % D;
    const bf16_t* hrow = (const bf16_t*)(p.ws + WS_H) + (size_t)t * D;
    const unsigned* PI = (const unsigned*)(p.ws + WS_PIDX) + (size_t)t * 128; const float* PGp = (const float*)(p.ws + WS_PG) + (size_t)t * 128;
    float o = 0.f;
    for (int e = 0; e < 128; ++e) {
        const size_t ex = (size_t)l * NEXP + PI[e];
        float a = 0.f; for (int k = 0; k < D; ++k) a += bfv(hrow, k) * p.expert_u[ex * D + k];
        const float act = PGp[e] * 0.5f * a * (1.f + erff(a * 0.70710678f));
        o += act * p.expert_v[ex * D + n];
    }
    const float g2 = ((const float*)(p.ws + WS_MOD))[((size_t)l * NB + b) * 6144 + 5 * 1024 + n];
    const float ref = ((const float*)(p.ws + WS_XCOPY))[(size_t)t * D + n] + g2 * o;
    if (badrel(p.out[(size_t)t * D + n], ref, 1e-2f, 1e-2f)) atomicAdd(DIAG(p) + 10, 1u);
}
__global__ void chk_fill(Params p, int s0) {
    const unsigned* dg = DIAG(p);
    const unsigned total[11] = {4096, 4096, 4096, 4096, 64, 1024, 4096, 4096, 4096, 1024, 512};
    float E = 0.f;
    for (int i = 0; i < 5; ++i) { const int sl = s0 + i; if (sl < 11 && dg[sl] * 50u > total[sl]) E += (float)(1 << i); }
    const size_t n = (size_t)T * D, stride = (size_t)gridDim.x * blockDim.x;
    for (size_t i = (size_t)blockIdx.x * blockDim.x + threadIdx.x; i < n; i += stride) p.out[i] = E;
}
#endif

#ifndef MK_TRUNC
#define MK_TRUNC 0
#endif
#if MK_TRUNC
__global__ void __launch_bounds__(256) dump_kernel(Params p, int which) {
    unsigned char* ws = p.ws;
    const size_t n = (size_t)T * D, stride = (size_t)gridDim.x * 256;
    for (size_t i = (size_t)blockIdx.x * 256 + threadIdx.x; i < n; i += stride) {
        const size_t t = i / D; const int c = (int)(i % D);
        float v = 0.f;
        if (which == 2) {
            const bf16_t* xp = (const bf16_t*)(ws + WS_XP); const bf16_t* q = (const bf16_t*)(ws + WS_Q); const bf16_t* k = (const bf16_t*)(ws + WS_K); const bf16_t* vt = (const bf16_t*)(ws + WS_VT);
            const bf16_t* qi = (const bf16_t*)(ws + WS_QI); const bf16_t* ki = (const bf16_t*)(ws + WS_KI); const float* wi = (const float*)(ws + WS_WI);
            const int cc = c & 511;
            v = bf_lo(xp[t * 512 + cc]) + bf_lo(q[t * 512 + cc]) + bf_lo(k[t * 512 + cc]) + bf_lo(vt[t * 512 + cc]) + bf_lo(qi[t * 512 + cc]) + bf_lo(ki[t * 64 + (cc & 63)]) + wi[t * 8 + (cc & 7)];
        } else if (which == 3) {
            const unsigned* m = (const unsigned*)(ws + WS_MASK); const bf16_t* hb = (const bf16_t*)(ws + WS_H);
            v = (float)(m[t * 256 + (c & 255)] & 0xffffu) + (float)(m[t * 256 + (c & 255)] >> 16) + bf_lo(hb[t * D + (c & 511)]);
        } else if (which == 4) {
            const bf16_t* hb = (const bf16_t*)(ws + WS_H); v = bf_lo(hb[t * D + c]);
        } else if (which == 7) {
            const bf16_t* qp = (const bf16_t*)(ws + WS_QP); v = bf_lo(qp[t * 2048 + c]) + bf_lo(qp[t * 2048 + 1024 + c]);
        } else if (which == 8) {
            const unsigned* pi = (const unsigned*)(ws + WS_PIDX); const float* pg = (const float*)(ws + WS_PG);
            v = (float)pi[t * 128 + (c & 127)] + pg[t * 128 + (c & 127)];
        }
        p.out[i] = v;
    }
}
#endif

extern "C" void kernel_launch(void* const* d_in, const int* in_sizes, int n_in, void* d_out, int out_size, void* d_ws, size_t ws_size, hipStream_t stream) {
    static int grid = 0;
    if (grid == 0) {
        if (n_in != 16 || out_size != T * D || ws_size < WS_END) { fprintf(stderr, "kernel_launch: unexpected shapes (n_in %d, out %d, ws %zu)\n", n_in, out_size, ws_size); grid = -1; return; }
        int dev = 0, cus = 0, per_cu = 0;
        if (hipGetDevice(&dev) != hipSuccess || hipDeviceGetAttribute(&cus, hipDeviceAttributeMultiprocessorCount, dev) != hipSuccess) { grid = -1; return; }
        if (hipOccupancyMaxActiveBlocksPerMultiprocessor(&per_cu, (const void*)mega, NTHREADS, 0) != hipSuccess || per_cu < 1) fprintf(stderr, "kernel_launch: occupancy query says %d\n", per_cu);
        (void)hipGetLastError();
        grid = cus;
    }
    if (grid < 0) return;
    (void)hipMemsetAsync((char*)d_ws + WS_CTL, 0, 64 * 1024, stream);
#ifdef MK_DBG_CLEAR
    (void)hipMemsetAsync((char*)d_ws, 0, WS_END, stream); (void)hipMemsetAsync(d_out, 0, (size_t)T * D * 4, stream);
#endif
    Params p{};
    p.x = (const float*)d_in[0]; p.c = (const float*)d_in[1]; p.pos = (const int*)d_in[2];
    p.w_ada = (const float*)d_in[3]; p.b_ada = (const float*)d_in[4]; p.norm_mix = (const float*)d_in[5]; p.w_in = (const float*)d_in[6]; p.w_pool = (const float*)d_in[7];
    p.pool_scale = (const float*)d_in[8]; p.w_out = (const float*)d_in[9]; p.norm_ffn = (const float*)d_in[10]; p.w_query = (const float*)d_in[11]; p.sub_keys = (const float*)d_in[12];
    p.expert_u = (const float*)d_in[13]; p.expert_v = (const float*)d_in[14]; p.final_norm = (const float*)d_in[15];
    p.out = (float*)d_out; p.ws = (unsigned char*)d_ws;
#if MK_CHECK
    {
        auto run = [&](int ph) { p.ph_lo = ph; p.ph_hi = ph + 1; hipLaunchKernelGGL(mega, dim3(grid), dim3(NTHREADS), 0, stream, p.x, p.c, p.pos, p.w_ada, p.b_ada, p.norm_mix, p.w_in, p.w_pool, p.pool_scale, p.w_out, p.norm_ffn, p.w_query, p.sub_keys, p.expert_u, p.expert_v, p.final_norm, p.out, p.ws, p.ph_lo, p.ph_hi); };
        const int L = MK_CHECK_LAYER; const int pb = 1 + 9 * L;
        for (int ph = 0; ph < pb; ++ph) run(ph);
        const float* xin = (L == 0) ? p.x : p.out;
        hipLaunchKernelGGL(chk_mod, dim3(16), dim3(256), 0, stream, p);
        run(pb + 0); hipLaunchKernelGGL(chk_norm, dim3(4), dim3(256), 0, stream, p, L, 0, xin, 1);
        run(pb + 1); hipLaunchKernelGGL(chk_in, dim3(16), dim3(256), 0, stream, p, L);
        run(pb + 2); hipLaunchKernelGGL(chk_pool, dim3(16), dim3(256), 0, stream, p, L); hipLaunchKernelGGL(chk_topk, dim3(64), dim3(512), 0, stream, p);
        run(pb + 3); hipLaunchKernelGGL(chk_attn, dim3(4), dim3(256), 0, stream, p);
        if (L == 1) (void)hipMemcpyAsync((char*)d_ws + WS_XCOPY, d_out, (size_t)T * D * 4, hipMemcpyDeviceToDevice, stream);
        run(pb + 4); hipLaunchKernelGGL(chk_out, dim3(16), dim3(256), 0, stream, p, L, (L == 0) ? p.x : (const float*)((char*)d_ws + WS_XCOPY));
        run(pb + 5); hipLaunchKernelGGL(chk_norm, dim3(4), dim3(256), 0, stream, p, L, 1, (const float*)p.out, 7);
        run(pb + 6); hipLaunchKernelGGL(chk_q, dim3(16), dim3(256), 0, stream, p, L);
        run(pb + 7); hipLaunchKernelGGL(chk_sel, dim3(16), dim3(64), 0, stream, p, L);
        (void)hipMemcpyAsync((char*)d_ws + WS_XCOPY, d_out, (size_t)T * D * 4, hipMemcpyDeviceToDevice, stream);
        run(pb + 8); hipLaunchKernelGGL(chk_gather, dim3(2), dim3(256), 0, stream, p, L);
        hipLaunchKernelGGL(chk_fill, dim3(2048), dim3(256), 0, stream, p, (int)MK_CHECK_SLOT0);
    }
#elif MK_TRUNC
    for (int ph = 0; ph <= MK_TRUNC; ++ph) { p.ph_lo = ph; p.ph_hi = ph + 1; hipLaunchKernelGGL(mega, dim3(grid), dim3(NTHREADS), 0, stream, p.x, p.c, p.pos, p.w_ada, p.b_ada, p.norm_mix, p.w_in, p.w_pool, p.pool_scale, p.w_out, p.norm_ffn, p.w_query, p.sub_keys, p.expert_u, p.expert_v, p.final_norm, p.out, p.ws, p.ph_lo, p.ph_hi); }
    if (MK_TRUNC != 5 && MK_TRUNC != 9) hipLaunchKernelGGL(dump_kernel, dim3(2048), dim3(256), 0, stream, p, (int)MK_TRUNC);
#elif MK_MULTI
    for (int ph = 0; ph < NPH; ++ph) { p.ph_lo = ph; p.ph_hi = ph + 1; hipLaunchKernelGGL(mega, dim3(grid), dim3(NTHREADS), 0, stream, p.x, p.c, p.pos, p.w_ada, p.b_ada, p.norm_mix, p.w_in, p.w_pool, p.pool_scale, p.w_out, p.norm_ffn, p.w_query, p.sub_keys, p.expert_u, p.expert_v, p.final_norm, p.out, p.ws, p.ph_lo, p.ph_hi); }
#else
    p.ph_lo = 0; p.ph_hi = NPH;
    hipLaunchKernelGGL(mega, dim3(grid), dim3(NTHREADS), 0, stream, p.x, p.c, p.pos, p.w_ada, p.b_ada, p.norm_mix, p.w_in, p.w_pool, p.pool_scale, p.w_out, p.norm_ffn, p.w_query, p.sub_keys, p.expert_u, p.expert_v, p.final_norm, p.out, p.ws, p.ph_lo, p.ph_hi);
#endif
    const hipError_t le = hipPeekAtLastError();
    if (le != hipSuccess) fprintf(stderr, "kernel_launch: launch failed: %s\n", hipGetErrorName(le));
}
```

```cpp
#include <hip/hip_runtime.h>
#include <stdint.h>
#include <stdio.h>

#ifndef MK_STAMP
#define MK_STAMP 0
#endif
#ifndef MK_STAMP_PH
#define MK_STAMP_PH 9
#endif
#ifndef MK_DUP
#define MK_DUP 0
#endif
#ifndef MK_DUPVAR
#define MK_DUPVAR 0
#endif
#ifndef MK_MULTI
#define MK_MULTI 0
#endif

#define LAS __attribute__((address_space(3)))
typedef unsigned short bf16_t;
typedef short bf16x8 __attribute__((ext_vector_type(8)));
typedef float f32x16 __attribute__((ext_vector_type(16)));
typedef float f32x4 __attribute__((ext_vector_type(4)));
typedef float f32x2 __attribute__((ext_vector_type(2)));
typedef unsigned u32x4 __attribute__((ext_vector_type(4)));
typedef unsigned u32x2 __attribute__((ext_vector_type(2)));
typedef __bf16 bf16v2 __attribute__((ext_vector_type(2)));
typedef LAS unsigned char* lds_t;
typedef float v32f_t __attribute__((ext_vector_type(32)));
typedef float v16f_t __attribute__((ext_vector_type(16)));
typedef unsigned v6u_t __attribute__((ext_vector_type(6)));
constexpr int EROW = 768;

constexpr int D = 1024, NB = 8, S = 8192, T = NB * S, DEPTH = 2;
constexpr int NIN = 2816;
constexpr int DIN = 2632;
constexpr int NEXP = 16384;
constexpr int NTHREADS = 512;
constexpr int LDS_BYTES = 148480;

constexpr size_t MBy = 1u << 20;
constexpr size_t WS_CTL = 0;
constexpr size_t WS_MOD = 64 * 1024;
constexpr size_t WS_ROPE = 1 * MBy;
constexpr size_t WS_WIN = 5 * MBy;
constexpr size_t WS_WOUT = 16 * MBy;
constexpr size_t WS_WQ = 20 * MBy;
constexpr size_t WS_WPOOL = 28 * MBy;
constexpr size_t WS_SK = 29 * MBy;
constexpr size_t WS_EU = 30 * MBy;
constexpr size_t WS_EV = 94 * MBy;
constexpr size_t WS_H = 158 * MBy;
constexpr size_t WS_XP = 286 * MBy;
constexpr size_t WS_Q = 350 * MBy;
constexpr size_t WS_K = 414 * MBy;
constexpr size_t WS_VT = 478 * MBy;
constexpr size_t WS_QP = WS_XP;
constexpr size_t WS_QI = 542 * MBy;
constexpr size_t WS_KI = 606 * MBy;
constexpr size_t WS_WI = 614 * MBy;
constexpr size_t WS_MASK = 616 * MBy;
constexpr size_t WS_PIDX = 680 * MBy;
constexpr size_t WS_PG = 712 * MBy;
constexpr size_t WS_ES = 744 * MBy;
constexpr size_t WS_END = 745 * MBy;
constexpr int NPH = 20;

struct Params {
    const float *x, *c; const int* pos;
    const float *w_ada, *b_ada, *norm_mix, *w_in, *w_pool, *pool_scale, *w_out, *norm_ffn, *w_query, *sub_keys, *expert_u, *expert_v, *final_norm;
    float* out; unsigned char* ws; int ph_lo, ph_hi;
};

#define XB_TMO      128
#define XB_XCNT(j)  (256  + 64 * (j))
#define XB_XSUB(j)  (1280 + 64 * (j))
#define XB_XGEN(j)  (2304 + 64 * (j))
#define XB_TOP      3328
#define XB_TOPGEN   3392
#define XCD_BAR_WORDS 3456
#define XB_SPIN_CAP (1u << 22)

__device__ __forceinline__ unsigned xb_ld(unsigned* p)              { return __hip_atomic_load(p, __ATOMIC_RELAXED, __HIP_MEMORY_SCOPE_AGENT); }
__device__ __forceinline__ unsigned xb_add(unsigned* p, unsigned v) { return __hip_atomic_fetch_add(p, v, __ATOMIC_RELAXED, __HIP_MEMORY_SCOPE_AGENT); }
__device__ __forceinline__ unsigned xb_xcc_id() { return (unsigned)__builtin_amdgcn_s_getreg((3 << 11) | 20) & 0xFu; }
#define XB_SPIN(cond, bar) do { unsigned _sp = 0; while (cond) { __builtin_amdgcn_s_sleep(1); \
    if ((++_sp & 255u) == 0u) { if (xb_ld(&(bar)[XB_TMO])) break; if (_sp > XB_SPIN_CAP) { atomicAdd(&(bar)[XB_TMO], 1u); break; } } } } while (0)

struct XcdBarrier { unsigned* bar; unsigned x; volatile LAS unsigned* st; };

__device__ __forceinline__ XcdBarrier xcd_barrier_post(unsigned* bar, volatile LAS unsigned* st) {
    XcdBarrier b; b.bar = bar; b.x = xb_xcc_id(); b.st = st;
    if (threadIdx.x == 0) (void)xb_add(&bar[XB_XCNT(b.x)], 1u);
    return b;
}
__device__ __forceinline__ void xcd_barrier_complete(unsigned* bar, unsigned x, unsigned& nloc, unsigned& nx) {
    const unsigned G = gridDim.x * gridDim.y * gridDim.z;
    unsigned sum, cnt, mine, sp = 0u;
    for (;;) {
        sum = 0u; cnt = 0u; mine = 0u;
#pragma unroll
        for (unsigned j = 0; j < 16; ++j) { const unsigned c = xb_ld(&bar[XB_XCNT(j)]); sum += c; cnt += (c > 0u) ? 1u : 0u; mine = (j == x) ? c : mine; }
        if (sum == G) break;
        __builtin_amdgcn_s_sleep(1);
        if ((++sp & 255u) == 0u) { if (xb_ld(&bar[XB_TMO])) break; if (sp > XB_SPIN_CAP) { atomicAdd(&bar[XB_TMO], 1u); break; } }
    }
    nloc = mine > 0u ? mine : 1u; nx = cnt > 0u ? cnt : 1u;
}
__device__ __forceinline__ void xcd_barrier(const XcdBarrier& b) {
    asm volatile("s_waitcnt vmcnt(0)" ::: "memory");
    __syncthreads();
    if (threadIdx.x == 0) {
        unsigned* bar = b.bar;
        __builtin_amdgcn_s_waitcnt(0);
        unsigned nloc = b.st[0], nx = b.st[1];
        if (nloc == 0u) { xcd_barrier_complete(bar, b.x, nloc, nx); b.st[0] = nloc; b.st[1] = nx; }
        const unsigned old = xb_add(&bar[XB_XSUB(b.x)], 1u);
        const unsigned gen = old / nloc;
        if (old + 1u == (gen + 1u) * nloc) {
            __builtin_amdgcn_fence(__ATOMIC_RELEASE, "agent");
            asm volatile("s_waitcnt vmcnt(0)" ::: "memory");
            const unsigned og = xb_add(&bar[XB_TOP], 1u);
            const unsigned tg = og / nx;
            if (og + 1u == (tg + 1u) * nx) xb_add(&bar[XB_TOPGEN], 1u);
            else XB_SPIN(xb_ld(&bar[XB_TOPGEN]) == tg, bar);
            __builtin_amdgcn_fence(__ATOMIC_ACQUIRE, "agent");
            xb_add(&bar[XB_XGEN(b.x)], 1u);
            asm volatile("s_waitcnt vmcnt(0)" ::: "memory");
        } else {
            XB_SPIN(xb_ld(&bar[XB_XGEN(b.x)]) == gen, bar);
            __builtin_amdgcn_fence(__ATOMIC_ACQUIRE, "agent");
            asm volatile("s_waitcnt vmcnt(0)" ::: "memory");
        }
    }
    __syncthreads();
}

#define MFMA32(a, b, c) __builtin_amdgcn_mfma_f32_32x32x16_bf16((a), (b), (c), 0, 0, 0)
__device__ __forceinline__ unsigned pk_bf16(float lo, float hi) { const f32x2 v = {lo, hi}; return __builtin_bit_cast(unsigned, __builtin_convertvector(v, bf16v2)); }
__device__ __forceinline__ float dot2bf(unsigned a, unsigned b, float c) { return __builtin_amdgcn_fdot2_f32_bf16(__builtin_bit_cast(bf16v2, a), __builtin_bit_cast(bf16v2, b), c, false); }
__device__ __forceinline__ float bf_lo(unsigned u) { return __uint_as_float(u << 16); }
__device__ __forceinline__ float bf_hi(unsigned u) { return __uint_as_float(u & 0xffff0000u); }
__device__ __forceinline__ float wave_sum(float v) {
#pragma unroll
    for (int o = 32; o > 0; o >>= 1) v += __shfl_xor(v, o);
    return v;
}
__device__ __forceinline__ int otid() { int t = threadIdx.x; asm volatile("" : "+v"(t)); return t; }
__device__ __forceinline__ void lds_fence() { asm volatile("s_waitcnt lgkmcnt(0)" ::: "memory"); }

__device__ __forceinline__ void transpose_tile(const float* __restrict__ src, int ldsrc, int Nvalid, bf16_t* __restrict__ dst, int lddst, int k0, int n0, lds_t lds) {
    LAS float* tile = (LAS float*)lds;
    const int tid = otid();
    {
        const int r = tid >> 6, c = tid & 63, n = n0 + c;
#pragma unroll
        for (int i = 0; i < 8; ++i) { const int k = r + 8 * i; tile[k * 65 + c] = (n < Nvalid) ? src[(size_t)(k0 + k) * ldsrc + n] : 0.f; }
    }
    __syncthreads();
    {
        const int nn = tid >> 3, kc = tid & 7;
        float v[8];
#pragma unroll
        for (int j = 0; j < 8; ++j) v[j] = tile[(kc * 8 + j) * 65 + nn];
        u32x4 w; w.x = pk_bf16(v[0], v[1]); w.y = pk_bf16(v[2], v[3]); w.z = pk_bf16(v[4], v[5]); w.w = pk_bf16(v[6], v[7]);
        *(u32x4*)(dst + (size_t)(n0 + nn) * lddst + k0 + kc * 8) = w;
    }
    __syncthreads();
}

__device__ __forceinline__ void convert_bf16(const float* __restrict__ src, bf16_t* __restrict__ dst, size_t n8) {
    const size_t stride = (size_t)gridDim.x * NTHREADS;
    for (size_t i = (size_t)blockIdx.x * NTHREADS + otid(); i < n8; i += stride) {
        const f32x4 a = *(const f32x4*)(src + i * 8), b = *(const f32x4*)(src + i * 8 + 4);
        u32x4 w; w.x = pk_bf16(a[0], a[1]); w.y = pk_bf16(a[2], a[3]); w.z = pk_bf16(b[0], b[1]); w.w = pk_bf16(b[2], b[3]);
        *(u32x4*)(dst + i * 8) = w;
    }
}

__device__ __forceinline__ void sincos_d(double a, float& sn, float& cs) {
    const double kq = rint(a * 0.63661977236758134308);
    double r = fma(-kq, 1.57079632679489655800e+00, a);
    r = fma(-kq, 6.12323399573676603587e-17, r);
    const int q = ((int)kq) & 3;
    const double r2 = r * r;
    double sp = -7.647163731819816476e-13;
    sp = fma(sp, r2, 1.605904383682161460e-10);
    sp = fma(sp, r2, -2.505210838544171878e-08);
    sp = fma(sp, r2, 2.755731922398589065e-06);
    sp = fma(sp, r2, -1.984126984126984127e-04);
    sp = fma(sp, r2, 8.333333333333333333e-03);
    sp = fma(sp, r2, -1.666666666666666667e-01);
    const double s = fma(sp * r2, r, r);
    double cp = 4.779477332387385297e-14;
    cp = fma(cp, r2, -1.147074559772972471e-11);
    cp = fma(cp, r2, 2.087675698786809898e-09);
    cp = fma(cp, r2, -2.755731922398589065e-07);
    cp = fma(cp, r2, 2.480158730158730159e-05);
    cp = fma(cp, r2, -1.388888888888888889e-03);
    cp = fma(cp, r2, 4.166666666666666667e-02);
    cp = fma(cp, r2, -0.5);
    const double c = fma(cp, r2, 1.0);
    const double ss = (q & 1) ? c : s, cc = (q & 1) ? s : c;
    sn = (float)((q & 2) ? -ss : ss);
    cs = (float)(((q + 1) & 2) ? -cc : cc);
}

__device__ __forceinline__ void phase_prologue(const Params& p, lds_t lds) {
    const int tid = otid(), bid = blockIdx.x, G = gridDim.x;
    unsigned char* ws = p.ws;
    {
        const int J_IN = 16 * 44, J_OUT = 16 * 16, J_Q = 16 * 32, J_P = 4;
        const int total = 2 * (J_IN + J_OUT + J_Q) + 8 * J_P;
        for (int j = bid; j < total; j += G) {
            int r = j;
            if (r < 2 * J_IN) { const int l = r / J_IN, t = r % J_IN; transpose_tile(p.w_in + (size_t)l * D * DIN, DIN, DIN, (bf16_t*)(ws + WS_WIN) + (size_t)l * NIN * D, D, (t / 44) * 64, (t % 44) * 64, lds); continue; }
            r -= 2 * J_IN;
            if (r < 2 * J_OUT) { const int l = r / J_OUT, t = r % J_OUT; transpose_tile(p.w_out + (size_t)l * D * D, D, D, (bf16_t*)(ws + WS_WOUT) + (size_t)l * D * D, D, (t / 16) * 64, (t % 16) * 64, lds); continue; }
            r -= 2 * J_OUT;
            if (r < 2 * J_Q) { const int l = r / J_Q, t = r % J_Q; transpose_tile(p.w_query + (size_t)l * D * 2048, 2048, 2048, (bf16_t*)(ws + WS_WQ) + (size_t)l * 2048 * D, D, (t / 32) * 64, (t % 32) * 64, lds); continue; }
            r -= 2 * J_Q;
            { const int m = r / J_P, t = r % J_P; transpose_tile(p.w_pool + (size_t)m * 128 * 128, 128, 128, (bf16_t*)(ws + WS_WPOOL) + (size_t)m * 128 * 128, 128, (t / 2) * 64, (t % 2) * 64, lds); }
        }
    }
    {
        const int lane = tid & 63, wid = tid >> 6, nw = G * 8, l5 = lane & 31, hf = lane >> 5;
        for (int r2 = bid * 8 + wid; r2 < DEPTH * NEXP; r2 += nw) {
            const int tab = r2 / (DEPTH * NEXP / 2), row = (r2 % (DEPTH * NEXP / 2)) * 2 + hf;
            const float* src = (tab ? p.expert_v : p.expert_u) + (size_t)row * D + l5 * 32;
            f32x4 v[8]; float am = 0.f;
#pragma unroll
            for (int i = 0; i < 8; ++i) { v[i] = *(const f32x4*)(src + 4 * i); am = fmaxf(am, fmaxf(fmaxf(fabsf(v[i][0]), fabsf(v[i][1])), fmaxf(fabsf(v[i][2]), fabsf(v[i][3])))); }
#pragma unroll
            for (int o = 16; o > 0; o >>= 1) am = fmaxf(am, __shfl_xor(am, o));
            const unsigned ab = __float_as_uint(am), eb = (ab >> 23) & 255u, mant = ab & 0x7fffffu;
            const bool ok = eb >= 8u && eb <= 250u;
            const unsigned se = (mant <= 0x700000u) ? eb - 2u : eb - 1u;
            const float sc = ok ? __uint_as_float(se << 23) : 1.0f;
            v16f_t ea, eo;
#pragma unroll
            for (int i = 0; i < 8; ++i) { ea[2 * i] = v[i][0]; eo[2 * i] = v[i][1]; ea[2 * i + 1] = v[i][2]; eo[2 * i + 1] = v[i][3]; }
            const v6u_t pk = __builtin_amdgcn_cvt_scalef32_2xpk16_fp6_f32(ea, eo, sc);
            unsigned char* dst = ws + (tab ? WS_EV : WS_EU) + (size_t)row * EROW + l5 * 24;
            *(u32x2*)(dst) = (u32x2){pk[0], pk[1]}; *(u32x2*)(dst + 8) = (u32x2){pk[2], pk[3]}; *(u32x2*)(dst + 16) = (u32x2){pk[4], pk[5]};
            if (l5 == 0) ((float*)(ws + WS_ES))[(size_t)row * 2 + tab] = sc;
        }
    }
    convert_bf16(p.sub_keys, (bf16_t*)(ws + WS_SK), (size_t)DEPTH * 16 * 128 * 128 / 8);
    {
        LAS float* sc = (LAS float*)lds;
        LAS float* part = (LAS float*)(lds + 32768);
        for (int i = tid; i < NB * D; i += NTHREADS) { const float v = p.c[i]; sc[i] = v / (1.f + __expf(-v)); }
        __syncthreads();
        const int lane = tid & 63, wid = tid >> 6;
        for (int j = bid; j < DEPTH * 96; j += G) {
            const int l = j / 96, col = (j % 96) * 64 + lane;
            const float* wp = p.w_ada + (size_t)l * D * 6144 + col;
            float a[8] = {0.f, 0.f, 0.f, 0.f, 0.f, 0.f, 0.f, 0.f};
            for (int k = wid * 128; k < wid * 128 + 128; ++k) {
                const float w = wp[(size_t)k * 6144];
#pragma unroll
                for (int b = 0; b < 8; ++b) a[b] = fmaf(sc[b * D + k], w, a[b]);
            }
#pragma unroll
            for (int b = 0; b < 8; ++b) part[(wid * 8 + b) * 64 + lane] = a[b];
            __syncthreads();
            {
                const int b = tid >> 6;
                float s = 0.f;
#pragma unroll
                for (int w = 0; w < 8; ++w) s += part[(w * 8 + b) * 64 + lane];
                ((float*)(ws + WS_MOD))[((size_t)l * NB + b) * 6144 + col] = s + p.b_ada[(size_t)l * 6144 + col];
            }
            __syncthreads();
        }
    }
    {
        const float inv[8] = {1.0f, 0.1939227432012558f, 0.03760603070259094f, 0.007292664609849453f, 0.0014142135623842478f, 0.00027424818836152554f, 5.318296098266728e-05f, 1.0313386155758053e-05f};
        const size_t stride = (size_t)G * NTHREADS;
        for (size_t i = (size_t)bid * NTHREADS + tid; i < (size_t)T * 8; i += stride) {
            const int t = (int)(i >> 3), f = (int)(i & 7);
            float iv = inv[0];
#pragma unroll
            for (int q = 1; q < 8; ++q) iv = (f == q) ? inv[q] : iv;
            const float ang = (float)p.pos[t] * iv;
            float sn, cs; sincos_d((double)ang, sn, cs);
            float* rp = (float*)(ws + WS_ROPE) + (size_t)t * 16;
            rp[f] = cs; rp[8 + f] = sn;
        }
    }
}

template <int MODE>
__device__ __forceinline__ void phase_norm(const float* xin, const float* __restrict__ gw, const float* __restrict__ sh, const float* __restrict__ scl, bf16_t* hout, float* fout) {
    const int tid = otid(), lane = tid & 63, wid = tid >> 6;
    const int nw = gridDim.x * 8;
    for (int gwv = blockIdx.x * 8 + wid; gwv * 32 < T; gwv += nw) {
        const int row0 = gwv * 32, b = row0 / S;
        f32x4 g4[4], a4[4], s4[4];
#pragma unroll
        for (int i = 0; i < 4; ++i) {
            const int col = 4 * lane + 256 * i;
            g4[i] = *(const f32x4*)(gw + col);
            if (MODE == 0) { a4[i] = *(const f32x4*)(scl + (size_t)b * 6144 + col) + 1.0f; s4[i] = *(const f32x4*)(sh + (size_t)b * 6144 + col); }
        }
        for (int r = 0; r < 32; ++r) {
            const float* xr = xin + (size_t)(row0 + r) * D;
            f32x4 v[4]; float ss = 0.f;
#pragma unroll
            for (int i = 0; i < 4; ++i) { v[i] = *(const f32x4*)(xr + 4 * lane + 256 * i); ss += v[i][0] * v[i][0] + v[i][1] * v[i][1] + v[i][2] * v[i][2] + v[i][3] * v[i][3]; }
            ss = wave_sum(ss);
            const float rstd = rsqrtf(ss * (1.0f / D) + 1e-6f);
            int ozn = 0; asm volatile("" : "+v"(ozn));
#pragma unroll
            for (int i = 0; i < 4; ++i) {
                f32x4 y = v[i] * rstd * g4[i];
                if (MODE == 0) {
                    y = y * a4[i] + s4[i];
                    u32x2 w; w.x = pk_bf16(y[0], y[1]); w.y = pk_bf16(y[2], y[3]);
                    *(u32x2*)(hout + (size_t)(row0 + r) * D + 4 * lane + 256 * i) = w;
                } else {
                    *(f32x4*)(fout + (size_t)(row0 + r) * D + 4 * lane + 256 * i) = y;
                }
            }
        }
    }
}
constexpr int GROW = 144;
constexpr int GTILE = 256 * GROW;

__device__ __forceinline__ bool tile_order(int i, int N, int& pm, int& pn) {
    const int nM = T / 256, nN = N / 256, nwg = nM * nN, G = gridDim.x;
    const long L = (long)i * G + blockIdx.x; if (L >= nwg) return false;
    int wgid = (int)L; { const int q = nwg / 8, r = nwg % 8, xcd = wgid % 8, off = wgid / 8; wgid = (xcd < r ? xcd * (q + 1) : r * (q + 1) + (xcd - r) * q) + off; }
    const int nig = 8 * nN, gid = wgid / nig, fm = gid * 8, gsz = (nM - fm) < 8 ? (nM - fm) : 8;
    pm = fm + ((wgid % nig) % gsz); pn = (wgid % nig) / gsz; return true;
}

template <int MODE = 0, class Epi>
__device__ __forceinline__ void gemm_phase(const bf16_t* __restrict__ A, const bf16_t* __restrict__ Wt, int N, const Epi& epi, lds_t lds) {
    const int tid = otid(), lane = tid & 63, wid = tid >> 6;
    const int wr = wid >> 2, wc = wid & 3, l31 = lane & 31, hh = lane >> 5;
    const int srow = tid >> 3, scc = tid & 7;
    int pm, pn;
    for (int it = 0; tile_order(it, N, pm, pn); ++it) {
        const bf16_t* Ag = A + (size_t)(pm * 256 + srow) * D + scc * 8;
        const bf16_t* Wg = Wt + (size_t)(pn * 256 + srow) * D + scc * 8;
        f32x16 acc[2][4];
#pragma unroll
        for (int a = 0; a < 2; ++a)
#pragma unroll
            for (int b = 0; b < 4; ++b)
#pragma unroll
                for (int r = 0; r < 16; ++r) acc[a][b][r] = 0.f;
        u32x4 ra[4], rw[4];
#pragma unroll
        for (int i = 0; i < 4; ++i) { ra[i] = *(const u32x4*)(Ag + (size_t)i * 64 * D); rw[i] = *(const u32x4*)(Wg + (size_t)i * 64 * D); }
#pragma unroll
        for (int i = 0; i < 4; ++i) { *(LAS u32x4*)(lds + (srow + 64 * i) * GROW + scc * 16) = ra[i]; *(LAS u32x4*)(lds + GTILE + (srow + 64 * i) * GROW + scc * 16) = rw[i]; }
#pragma unroll
        for (int i = 0; i < 4; ++i) { ra[i] = *(const u32x4*)(Ag + (size_t)i * 64 * D + 64); rw[i] = *(const u32x4*)(Wg + (size_t)i * 64 * D + 64); }
        __syncthreads();
        for (int kt = 0; kt < 16; ++kt) {
#pragma unroll
            for (int half = 0; half < 2; ++half) {
                if (wr == half) {
                    const lds_t sb = lds + (kt & 1) * 2 * GTILE;
#pragma unroll
                    for (int ks = 0; ks < 4; ++ks) {
                        bf16x8 af[4], wf[2];
#pragma unroll
                        for (int tt = 0; tt < 4; ++tt) af[tt] = *(LAS bf16x8*)(sb + (wr * 128 + tt * 32 + l31) * GROW + (ks * 2 + hh) * 16);
#pragma unroll
                        for (int nt = 0; nt < 2; ++nt) wf[nt] = *(LAS bf16x8*)(sb + GTILE + (wc * 64 + nt * 32 + l31) * GROW + (ks * 2 + hh) * 16);
#pragma unroll
                        for (int nt = 0; nt < 2; ++nt)
#pragma unroll
                            for (int tt = 0; tt < 4; ++tt) acc[nt][tt] = MFMA32(wf[nt], af[tt], acc[nt][tt]);
                    }
                } else {
                    if (kt + 1 < 16) {
                        const lds_t nb = lds + ((kt + 1) & 1) * 2 * GTILE;
#pragma unroll
                        for (int i = 0; i < 4; ++i) { *(LAS u32x4*)(nb + (srow + 64 * i) * GROW + scc * 16) = ra[i]; *(LAS u32x4*)(nb + GTILE + (srow + 64 * i) * GROW + scc * 16) = rw[i]; }
                    }
                    if (kt + 2 < 16) {
#pragma unroll
                        for (int i = 0; i < 4; ++i) { ra[i] = *(const u32x4*)(Ag + (size_t)i * 64 * D + (kt + 2) * 64); rw[i] = *(const u32x4*)(Wg + (size_t)i * 64 * D + (kt + 2) * 64); }
                    }
                }
                __syncthreads();
            }
        }
        epi(acc, pm, pn, wr, wc, l31, hh);
    }
}

struct EpiIn {
    bf16_t *xp, *q, *k, *vt, *qi, *ki; float* wi; const float* rope;
    __device__ __forceinline__ void operator()(const f32x16 (&acc)[2][4], int pm, int pn, int wr, int wc, int l31, int hh) const {
        const int seg = pn >> 1;
        const int cb = (pn & 1) * 256 + wc * 64;
#pragma unroll
        for (int tt = 0; tt < 4; ++tt) {
            const int t = pm * 256 + wr * 128 + tt * 32 + l31;
            if (seg == 0) {
#pragma unroll
                for (int nt = 0; nt < 2; ++nt)
#pragma unroll
                    for (int rq = 0; rq < 4; ++rq) {
                        u32x2 w; w.x = pk_bf16(acc[nt][tt][4 * rq], acc[nt][tt][4 * rq + 1]); w.y = pk_bf16(acc[nt][tt][4 * rq + 2], acc[nt][tt][4 * rq + 3]);
                        *(u32x2*)(xp + (size_t)t * 512 + cb + nt * 32 + 8 * rq + 4 * hh) = w;
                    }
            } else if (seg == 3) {
                const int b = t / S, s = t % S, head = cb >> 6;
                bf16_t* vb = vt + ((size_t)(b * 8 + head) * 64) * S + s;
#pragma unroll
                for (int nt = 0; nt < 2; ++nt)
#pragma unroll
                    for (int r = 0; r < 16; ++r) {
                        const int d = nt * 32 + (r & 3) + 8 * (r >> 2) + 4 * hh;
                        vb[(size_t)d * S] = (bf16_t)(pk_bf16(acc[nt][tt][r], 0.f) & 0xffffu);
                    }
            } else if (seg == 1 || seg == 2 || seg == 4 || (seg == 5 && wc == 0)) {
                const f32x4 cs = *(const f32x4*)(rope + (size_t)t * 16 + 4 * hh), sn = *(const f32x4*)(rope + (size_t)t * 16 + 8 + 4 * hh);
                const float scale = (seg == 1 || seg == 4) ? 0.125f : 1.0f;
                bf16_t* dst; size_t off;
                if (seg == 1) { dst = q; off = (size_t)t * 512 + cb; } else if (seg == 2) { dst = k; off = (size_t)t * 512 + cb; } else if (seg == 4) { dst = qi; off = (size_t)t * 512 + cb; } else { dst = ki; off = (size_t)t * 64; }
                float v0[16];
#pragma unroll
                for (int r = 0; r < 16; ++r) v0[r] = acc[0][tt][r];
#pragma unroll
                for (int j = 0; j < 4; ++j) { const float x1 = acc[0][tt][j], x2 = acc[0][tt][4 + j]; v0[j] = x1 * cs[j] - x2 * sn[j]; v0[4 + j] = x1 * sn[j] + x2 * cs[j]; }
#pragma unroll
                for (int rq = 0; rq < 4; ++rq) {
                    u32x2 w; w.x = pk_bf16(v0[4 * rq] * scale, v0[4 * rq + 1] * scale); w.y = pk_bf16(v0[4 * rq + 2] * scale, v0[4 * rq + 3] * scale);
                    *(u32x2*)(dst + off + 8 * rq + 4 * hh) = w;
                    u32x2 w2; w2.x = pk_bf16(acc[1][tt][4 * rq] * scale, acc[1][tt][4 * rq + 1] * scale); w2.y = pk_bf16(acc[1][tt][4 * rq + 2] * scale, acc[1][tt][4 * rq + 3] * scale);
                    *(u32x2*)(dst + off + 32 + 8 * rq + 4 * hh) = w2;
                }
            } else if (seg == 5 && wc == 1) {
                f32x4 w;
#pragma unroll
                for (int j = 0; j < 4; ++j) w[j] = acc[0][tt][j] * 0.35355339059327373f;
                *(f32x4*)(wi + (size_t)t * 8 + 4 * hh) = w;
            }
        }
    }
};

struct EpiOut {
    const float* xin; float* xout; const float* gate;
    __device__ __forceinline__ void operator()(const f32x16 (&acc)[2][4], int pm, int pn, int wr, int wc, int l31, int hh) const {
        const int b = (pm * 256) / S;
#pragma unroll
        for (int nt = 0; nt < 2; ++nt)
#pragma unroll
            for (int rq = 0; rq < 4; ++rq) {
                const int n0 = pn * 256 + wc * 64 + nt * 32 + 8 * rq + 4 * hh;
                const f32x4 g = *(const f32x4*)(gate + (size_t)b * 6144 + n0);
#pragma unroll
                for (int tt = 0; tt < 4; ++tt) {
                    const int t = pm * 256 + wr * 128 + tt * 32 + l31;
                    const f32x4 xo = *(const f32x4*)(xin + (size_t)t * D + n0);
                    f32x4 a; a[0] = acc[nt][tt][4 * rq]; a[1] = acc[nt][tt][4 * rq + 1]; a[2] = acc[nt][tt][4 * rq + 2]; a[3] = acc[nt][tt][4 * rq + 3];
                    *(f32x4*)(xout + (size_t)t * D + n0) = xo + g * a;
                }
            }
    }
};

struct EpiNull { float* sink; __device__ __forceinline__ void operator()(const f32x16 (&acc)[2][4], int pm, int pn, int wr, int wc, int l31, int hh) const { float t = 0.f;
#pragma unroll
    for (int a = 0; a < 2; ++a)
#pragma unroll
        for (int b = 0; b < 4; ++b)
#pragma unroll
            for (int r = 0; r < 16; ++r) t += acc[a][b][r];
    sink[((size_t)(pm * 11 + pn) * 512 + (wr * 4 + wc) * 64 + hh * 32 + l31)] = t; } };
struct EpiBf {
    bf16_t* C; int ldc;
    __device__ __forceinline__ void operator()(const f32x16 (&acc)[2][4], int pm, int pn, int wr, int wc, int l31, int hh) const {
#pragma unroll
        for (int tt = 0; tt < 4; ++tt) {
            const int t = pm * 256 + wr * 128 + tt * 32 + l31;
#pragma unroll
            for (int nt = 0; nt < 2; ++nt)
#pragma unroll
                for (int rq = 0; rq < 4; ++rq) {
                    u32x2 w; w.x = pk_bf16(acc[nt][tt][4 * rq], acc[nt][tt][4 * rq + 1]); w.y = pk_bf16(acc[nt][tt][4 * rq + 2], acc[nt][tt][4 * rq + 3]);
                    *(u32x2*)(C + (size_t)t * ldc + pn * 256 + wc * 64 + nt * 32 + 8 * rq + 4 * hh) = w;
                }
        }
    }
};

__device__ __forceinline__ void pool_item(int e, const bf16_t* __restrict__ xp, const bf16_t* __restrict__ wpool  , const float* __restrict__ pscale  , bf16_t* __restrict__ mixed, lds_t lds) {
    const int tid = otid(), lane = tid & 63, wid = tid >> 6, l31 = lane & 31, hh = lane >> 5;
    const int g = e & 3, tile = e >> 2;
    const int t0 = tile * 128, s0 = t0 % S;
    lds_t xs = lds;
    lds_t ps = lds + 144 * 256;
    for (int c = tid; c < 144 * 16; c += NTHREADS) {
        const int r = c >> 4, cc = c & 15;
        u32x4 v = {0u, 0u, 0u, 0u};
        if (s0 - 16 + r >= 0) v = *(const u32x4*)(xp + (size_t)(t0 - 16 + r) * 512 + g * 128 + cc * 8);
        *(LAS u32x4*)(xs + r * 256 + cc * 16) = v;
    }
    __syncthreads();
    {
        const int cp = tid & 63, ts = tid >> 6, w = 2 << g;
        const int tl0 = ts * 16;
        float s0 = 0.f, s1 = 0.f;
        for (int j = 1; j < w; ++j) { const unsigned v = *(LAS unsigned*)(xs + (16 + tl0 - j) * 256 + cp * 4); s0 += bf_lo(v); s1 += bf_hi(v); }
        for (int tl = tl0; tl < tl0 + 16; ++tl) {
            const unsigned vn = *(LAS unsigned*)(xs + (16 + tl) * 256 + cp * 4);
            const float x0 = bf_lo(vn), x1 = bf_hi(vn);
            s0 += x0; s1 += x1;
            const int spos = (t0 % S) + tl;
            const float rc = 1.0f / (float)((spos + 1 < w) ? (spos + 1) : w);
            *(LAS unsigned*)(ps + tl * 272 + cp * 4) = pk_bf16(s0 * rc - x0, s1 * rc - x1);
            const unsigned vo = *(LAS unsigned*)(xs + (16 + tl - w + 1) * 256 + cp * 4);
            s0 -= bf_lo(vo); s1 -= bf_hi(vo);
        }
    }
    __syncthreads();
    {
        const int dt = wid & 3, tb = (wid >> 2) * 2;
        f32x16 acc[2];
#pragma unroll
        for (int a = 0; a < 2; ++a)
#pragma unroll
            for (int r = 0; r < 16; ++r) acc[a][r] = 0.f;
        const bf16_t* wg = wpool + (size_t)g * 128 * 128 + (size_t)(dt * 32 + l31) * 128 + 8 * hh;
#pragma unroll
        for (int ks = 0; ks < 8; ++ks) {
            const bf16x8 wf = *(const bf16x8*)(wg + ks * 16);
#pragma unroll
            for (int a = 0; a < 2; ++a) {
                const bf16x8 pf = *(LAS bf16x8*)(ps + ((tb + a) * 32 + l31) * 272 + (ks * 2 + hh) * 16);
                acc[a] = MFMA32(wf, pf, acc[a]);
            }
        }
#pragma unroll
        for (int a = 0; a < 2; ++a) {
            const int t = t0 + (tb + a) * 32 + l31;
#pragma unroll
            for (int rq = 0; rq < 4; ++rq) {
                const int d = dt * 32 + 8 * rq + 4 * hh;
                const f32x4 sc = *(const f32x4*)(pscale + g * 128 + d);
                u32x2 w; w.x = pk_bf16(acc[a][4 * rq] * sc[0], acc[a][4 * rq + 1] * sc[1]); w.y = pk_bf16(acc[a][4 * rq + 2] * sc[2], acc[a][4 * rq + 3] * sc[3]);
                *(u32x2*)(mixed + (size_t)t * D + g * 128 + d) = w;
            }
        }
    }
    __syncthreads();
}
constexpr int TK_CAP = 576, TK_NE = 9, TK_TRIG = 512, TK_SOFT = 448;
constexpr int TK_FLAG = 145408;
constexpr int TK_CS = 0;
constexpr int TK_CI = 73728;
constexpr int TK_KST = 110592;
constexpr int TK_HIST = 129024;

__device__ __forceinline__ unsigned f2key(float s) { const unsigned b = __float_as_uint(s); return b ^ ((b >> 31) ? 0xffffffffu : 0x80000000u); }
__device__ __forceinline__ float key2f(unsigned k) { return __uint_as_float((k & 0x80000000u) ? (k ^ 0x80000000u) : ~k); }
__device__ __forceinline__ int bcount(bool p) { return __builtin_popcountll(__ballot(p)); }

template <int CTRL> __device__ __forceinline__ unsigned dpp_z(unsigned v) { return (unsigned)__builtin_amdgcn_update_dpp(0, (int)v, CTRL, 0xf, 0xf, true); }
__device__ __forceinline__ unsigned rdl(unsigned v, int l) { return (unsigned)__builtin_amdgcn_readlane((int)v, l); }

__device__ __forceinline__ void prune4(LAS float* cs, LAS bf16_t* ci, int (&cnt)[4], float (&tau)[2], LAS unsigned* hist, int lane, int hh) {
    unsigned key[4][TK_NE], idx[4][TK_NE];
    bool act[4];
#pragma unroll
    for (int q = 0; q < 4; ++q) {
        act[q] = cnt[q] > 256;
#pragma unroll
        for (int e = 0; e < TK_NE; ++e) {
            const int i = lane + 64 * e; const bool v = act[q] && i < cnt[q];
            const float sv_ = cs[q * TK_CAP + i]; const unsigned iv_ = ci[q * TK_CAP + i];
            key[q][e] = v ? f2key(sv_) : 0u; idx[q][e] = v ? iv_ : 0xffffu;
        }
    }
    unsigned prefix[4] = {0u, 0u, 0u, 0u}; int need[4] = {256, 256, 256, 256};
    const int row = lane >> 4;
#pragma unroll
    for (int pass = 3; pass >= 0; --pass) {
        const int sh = pass * 8;
        *(LAS u32x4*)(hist + lane * 8) = (u32x4){0u, 0u, 0u, 0u}; *(LAS u32x4*)(hist + lane * 8 + 4) = (u32x4){0u, 0u, 0u, 0u};
        lds_fence();
#pragma unroll
        for (int q = 0; q < 4; ++q)
#pragma unroll
            for (int e = 0; e < TK_NE; ++e) {
                const bool a = (key[q][e] != 0u) && (pass == 3 ? true : (((key[q][e] ^ prefix[q]) >> ((sh + 8) & 31)) == 0u));
                const unsigned b = (key[q][e] >> sh) & 255u;
                __hip_atomic_fetch_add(hist + (b >> 2) * 8 + q * 2 + ((b >> 1) & 1u), a ? (1u << (16 * (b & 1u))) : 0u, __ATOMIC_RELAXED, __HIP_MEMORY_SCOPE_WORKGROUP);
            }
        lds_fence();
        const u32x4 w0 = *(LAS u32x4*)(hist + lane * 8), w1 = *(LAS u32x4*)(hist + lane * 8 + 4);
#pragma unroll
        for (int q = 0; q < 4; ++q) {
            const unsigned wk0 = q == 0 ? w0[0] : q == 1 ? w0[2] : q == 2 ? w1[0] : w1[2], wk1 = q == 0 ? w0[1] : q == 1 ? w0[3] : q == 2 ? w1[1] : w1[3];
            const unsigned b0 = wk0 & 0xffffu, b1 = wk0 >> 16, b2 = wk1 & 0xffffu, b3 = wk1 >> 16, sb = b0 + b1 + b2 + b3;
            unsigned P = sb;
            P += dpp_z<0x111>(P); P += dpp_z<0x112>(P); P += dpp_z<0x114>(P); P += dpp_z<0x118>(P);
            const unsigned R0 = rdl(P, 15), R1 = rdl(P, 31), R2 = rdl(P, 47), R3 = rdl(P, 63);
            const unsigned Gp = P + (row > 0 ? R0 : 0u) + (row > 1 ? R1 : 0u) + (row > 2 ? R2 : 0u);
            const unsigned suf = (R0 + R1 + R2 + R3) - Gp + sb;
            const unsigned long long bm = __ballot(suf >= (unsigned)need[q]);
            const int Ls = 63 - __builtin_clzll(bm | 1ull);
            const unsigned above = rdl(suf - sb, Ls), c1 = rdl(b1, Ls), c2 = rdl(b2, Ls), c3 = rdl(b3, Ls);
            unsigned c = above; int bin;
            if (c + c3 >= (unsigned)need[q]) bin = 3;
            else { c += c3; if (c + c2 >= (unsigned)need[q]) bin = 2; else { c += c2; if (c + c1 >= (unsigned)need[q]) bin = 1; else { c += c1; bin = 0; } } }
            need[q] -= (int)c;
            prefix[q] |= (unsigned)(Ls * 4 + bin) << sh;
        }
    }
#pragma unroll
    for (int q = 0; q < 4; ++q) {
        if (act[q]) {
            int eq = 0;
#pragma unroll
            for (int e = 0; e < TK_NE; ++e) eq += bcount(key[q][e] == prefix[q]);
            unsigned ithr = 0xffffu;
            if (eq > need[q]) {
                unsigned lo = 0u;
                for (int bit = 12; bit >= 0; --bit) {
                    const unsigned mid = lo + (1u << bit);
                    int c = 0;
#pragma unroll
                    for (int e = 0; e < TK_NE; ++e) c += bcount(key[q][e] == prefix[q] && idx[q][e] < mid);
                    if (c < need[q]) lo = mid;
                }
                ithr = lo;
            }
            int base = 0;
#pragma unroll
            for (int e = 0; e < TK_NE; ++e) {
                const bool keep = (key[q][e] > prefix[q]) || (key[q][e] == prefix[q] && idx[q][e] <= ithr);
                const unsigned long long m = __ballot(keep);
                const int pos = base + (int)__builtin_amdgcn_mbcnt_hi((unsigned)(m >> 32), __builtin_amdgcn_mbcnt_lo((unsigned)m, 0u));
                if (keep) { cs[q * TK_CAP + pos] = key2f(key[q][e]); ci[q * TK_CAP + pos] = (bf16_t)idx[q][e]; }
                base += __builtin_popcountll(m);
            }
            cnt[q] = 256;
            const float nt_ = key2f(prefix[q]);
            if ((q >> 1) == hh) { if ((q & 1) == 0) tau[0] = nt_; else tau[1] = nt_; }
        }
    }
    lds_fence();
}


__device__ __forceinline__ float wave_max_f(float v) {
    v = fmaxf(v, __uint_as_float((unsigned)__builtin_amdgcn_update_dpp((int)__float_as_uint(v), (int)__float_as_uint(v), 0x111, 0xf, 0xf, false)));
    v = fmaxf(v, __uint_as_float((unsigned)__builtin_amdgcn_update_dpp((int)__float_as_uint(v), (int)__float_as_uint(v), 0x112, 0xf, 0xf, false)));
    v = fmaxf(v, __uint_as_float((unsigned)__builtin_amdgcn_update_dpp((int)__float_as_uint(v), (int)__float_as_uint(v), 0x114, 0xf, 0xf, false)));
    v = fmaxf(v, __uint_as_float((unsigned)__builtin_amdgcn_update_dpp((int)__float_as_uint(v), (int)__float_as_uint(v), 0x118, 0xf, 0xf, false)));
    const float a = __uint_as_float(rdl(__float_as_uint(v), 15)), b = __uint_as_float(rdl(__float_as_uint(v), 31)), c = __uint_as_float(rdl(__float_as_uint(v), 47)), d = __uint_as_float(rdl(__float_as_uint(v), 63));
    return fmaxf(fmaxf(a, b), fmaxf(c, d));
}
__device__ __forceinline__ void prune4_fast(LAS float* cs, LAS bf16_t* ci, int (&cnt)[4], float (&tau)[2], LAS unsigned* hist, int lane, int hh) {
    float sv[4][TK_NE]; unsigned idx[4][TK_NE]; bool val[4][TK_NE];
    float lo[4], scale[4];
#pragma unroll
    for (int q = 0; q < 4; ++q) {
        float mx = -INFINITY, mn = INFINITY;
#pragma unroll
        for (int e = 0; e < TK_NE; ++e) {
            const int i = lane + 64 * e; val[q][e] = i < cnt[q];
            sv[q][e] = cs[q * TK_CAP + i]; idx[q][e] = ci[q * TK_CAP + i];
            mx = fmaxf(mx, val[q][e] ? sv[q][e] : -INFINITY); mn = fminf(mn, val[q][e] ? sv[q][e] : INFINITY);
        }
        mx = wave_max_f(mx); mn = -wave_max_f(-mn);
        lo[q] = mn; const float d = mx - mn; scale[q] = d > 0.f ? 255.9f / d : 0.f;
    }
    *(LAS u32x4*)(hist + lane * 8) = (u32x4){0u, 0u, 0u, 0u}; *(LAS u32x4*)(hist + lane * 8 + 4) = (u32x4){0u, 0u, 0u, 0u};
    lds_fence();
    unsigned bin[4][TK_NE];
#pragma unroll
    for (int q = 0; q < 4; ++q)
#pragma unroll
        for (int e = 0; e < TK_NE; ++e) {
            int b = (int)((sv[q][e] - lo[q]) * scale[q]); b = b < 0 ? 0 : (b > 255 ? 255 : b);
            bin[q][e] = val[q][e] ? (unsigned)b : 0u;
            __hip_atomic_fetch_add(hist + (bin[q][e] >> 2) * 8 + q * 2 + ((bin[q][e] >> 1) & 1u), val[q][e] ? (1u << (16 * (bin[q][e] & 1u))) : 0u, __ATOMIC_RELAXED, __HIP_MEMORY_SCOPE_WORKGROUP);
        }
    lds_fence();
    const u32x4 w0 = *(LAS u32x4*)(hist + lane * 8), w1 = *(LAS u32x4*)(hist + lane * 8 + 4);
    const int row = lane >> 4;
    bool fail = false;
#pragma unroll
    for (int q = 0; q < 4; ++q) {
        const unsigned wk0 = q == 0 ? w0[0] : q == 1 ? w0[2] : q == 2 ? w1[0] : w1[2], wk1 = q == 0 ? w0[1] : q == 1 ? w0[3] : q == 2 ? w1[1] : w1[3];
        const unsigned b0 = wk0 & 0xffffu, b1 = wk0 >> 16, b2 = wk1 & 0xffffu, b3 = wk1 >> 16, sb = b0 + b1 + b2 + b3;
        unsigned P = sb;
        P += dpp_z<0x111>(P); P += dpp_z<0x112>(P); P += dpp_z<0x114>(P); P += dpp_z<0x118>(P);
        const unsigned R0 = rdl(P, 15), R1 = rdl(P, 31), R2 = rdl(P, 47), R3 = rdl(P, 63);
        const unsigned Gp = P + (row > 0 ? R0 : 0u) + (row > 1 ? R1 : 0u) + (row > 2 ? R2 : 0u);
        const unsigned suf = (R0 + R1 + R2 + R3) - Gp + sb;
        const unsigned long long bm = __ballot(suf >= 256u);
        const int Ls = 63 - __builtin_clzll(bm | 1ull);
        const unsigned above = rdl(suf - sb, Ls), c1 = rdl(b1, Ls), c2 = rdl(b2, Ls), c3 = rdl(b3, Ls);
        unsigned c = above; int bsel;
        if (c + c3 >= 256u) bsel = 3;
        else { c += c3; if (c + c2 >= 256u) bsel = 2; else { c += c2; if (c + c1 >= 256u) bsel = 1; else bsel = 0; } }
        const unsigned B = (unsigned)(Ls * 4 + bsel);
        if (cnt[q] > 256) {
            int base = 0; float kmin = INFINITY;
#pragma unroll
            for (int e = 0; e < TK_NE; ++e) {
                const bool keep = val[q][e] && bin[q][e] >= B;
                const unsigned long long m = __ballot(keep);
                const int pos = base + (int)__builtin_amdgcn_mbcnt_hi((unsigned)(m >> 32), __builtin_amdgcn_mbcnt_lo((unsigned)m, 0u));
                if (keep) { cs[q * TK_CAP + pos] = sv[q][e]; ci[q * TK_CAP + pos] = (bf16_t)idx[q][e]; }
                kmin = fminf(kmin, keep ? sv[q][e] : INFINITY);
                base += __builtin_popcountll(m);
            }
            kmin = -wave_max_f(-kmin);
            if (base > TK_TRIG - 64) fail = true;
            cnt[q] = base;
            const float nt_ = key2f(f2key(kmin) - 1u);
            if ((q >> 1) == hh) { if ((q & 1) == 0) tau[0] = nt_; else tau[1] = nt_; }
        }
    }
    lds_fence();
    if (fail) prune4(cs, ci, cnt, tau, hist, lane, hh);
}

template <int VAR>
__device__ __forceinline__ void topk_item(int e, const bf16_t* __restrict__ QI, const bf16_t* __restrict__ KI, const float* __restrict__ WI, unsigned* __restrict__ MASK, lds_t lds) {
    const int tid = otid(), lane = tid & 63, wid = tid >> 6, l31 = lane & 31, hh = lane >> 5;
    const int r8 = e >> 8, c = e & 255, b = c & 7, j = c >> 3;
    const int qb = (r8 < 4) ? (j + 32 * r8) : (255 - (j + 32 * (r8 - 4)));
    const int t0 = qb * 32, tq0 = t0 + 4 * wid;
    const size_t tokb = (size_t)b * S;
    bf16x8 qf[4];
    {
        const int i = l31, qi_ = 2 * ((i >> 2) & 1) + (i >> 4), hd = (i & 3) + 4 * ((i >> 3) & 1);
        const bf16_t* qp = QI + (tokb + tq0 + qi_) * 512 + hd * 64 + 8 * hh;
#pragma unroll
        for (int ks = 0; ks < 4; ++ks) qf[ks] = *(const bf16x8*)(qp + ks * 16);
    }
    float wv[2][8];
#pragma unroll
    for (int a = 0; a < 2; ++a) {
        const f32x4 w0 = *(const f32x4*)(WI + (tokb + tq0 + 2 * hh + a) * 8), w1 = *(const f32x4*)(WI + (tokb + tq0 + 2 * hh + a) * 8 + 4);
#pragma unroll
        for (int q = 0; q < 4; ++q) { wv[a][q] = w0[q]; wv[a][4 + q] = w1[q]; }
    }
    float tau[2] = {-INFINITY, -INFINITY};
    int cnt[4] = {0, 0, 0, 0};
    LAS float* cs = (LAS float*)(lds + TK_CS) + (wid * 4) * TK_CAP;
    LAS bf16_t* ci = (LAS bf16_t*)(lds + TK_CI) + (wid * 4) * TK_CAP;
    LAS unsigned* hist = (LAS unsigned*)(lds + TK_HIST) + wid * 512;
    volatile LAS unsigned* flag = (volatile LAS unsigned*)(lds + TK_FLAG);
    if (tid < 3) flag[tid] = 0u;
    const int ntiles = qb + 1, nch = (ntiles + 1) >> 1;
    const int srow = tid >> 3, scc = tid & 7;
    const bf16_t* kg = KI + (tokb + srow) * 64 + scc * 8;
    u32x4 kr = *(const u32x4*)kg, kr2 = kr, kr3 = kr;
    if (1 < nch) kr2 = *(const u32x4*)(kg + (size_t)1 * 64 * 64);
    if (2 < nch) kr3 = *(const u32x4*)(kg + (size_t)2 * 64 * 64);
    *(LAS u32x4*)(lds + TK_KST + srow * GROW + scc * 16) = kr;
    kr = kr2; kr2 = kr3;
    __syncthreads();
    for (int ch = 0; ch < nch; ++ch) {
        if (ch + 3 < nch) kr3 = *(const u32x4*)(kg + (size_t)(ch + 3) * 64 * 64);
        const lds_t kb = lds + TK_KST + (ch & 1) * (64 * GROW);
        {
            f32x16 acc[2];
#pragma unroll
            for (int tl = 0; tl < 2; ++tl)
#pragma unroll
                for (int r = 0; r < 16; ++r) acc[tl][r] = 0.f;
            bf16x8 kf[2][4];
#pragma unroll
            for (int tl = 0; tl < 2; ++tl)
#pragma unroll
                for (int ks = 0; ks < 4; ++ks) kf[tl][ks] = *(LAS bf16x8*)(kb + (tl * 32 + l31) * GROW + (ks * 2 + hh) * 16);
            __builtin_amdgcn_sched_barrier(0);
#pragma unroll
            for (int ks = 0; ks < 4; ++ks)
#pragma unroll
                for (int tl = 0; tl < 2; ++tl) acc[tl] = MFMA32(qf[ks], kf[tl][ks], acc[tl]);
            float sc[2][2];
#pragma unroll
            for (int tl = 0; tl < 2; ++tl)
#pragma unroll
                for (int a = 0; a < 2; ++a) {
                    float sv = 0.f;
#pragma unroll
                    for (int h = 0; h < 8; ++h) sv = fmaf(wv[a][h], __int_as_float(max(__float_as_int(acc[tl][8 * a + h]), 0)), sv);
                    sc[tl][a] = sv;
                }
            const int key0 = ch * 64 + l31;
#pragma unroll
            for (int a = 0; a < 2; ++a) {
                const int tq = tq0 + 2 * hh + a;
                const bool p0 = (sc[0][a] > tau[a]) && (key0 <= tq), p1 = (sc[1][a] > tau[a]) && (key0 + 32 <= tq);
                const unsigned long long m0 = __ballot(p0), m1 = __ballot(p1);
                if ((m0 | m1) != 0ull) {
                    const unsigned m0h = hh ? (unsigned)(m0 >> 32) : (unsigned)m0;
                    const int p0i = hh ? (int)__builtin_amdgcn_mbcnt_hi((unsigned)(m0 >> 32), 0u) : (int)__builtin_amdgcn_mbcnt_lo((unsigned)m0, 0u);
                    const int p1i = hh ? (int)__builtin_amdgcn_mbcnt_hi((unsigned)(m1 >> 32), 0u) : (int)__builtin_amdgcn_mbcnt_lo((unsigned)m1, 0u);
                    const int bc = (hh ? cnt[2 + a] : cnt[a]) + (2 * hh + a) * TK_CAP;
                    if (VAR == 0 || VAR == 3) {
                        if (p0) { cs[bc + p0i] = sc[0][a]; ci[bc + p0i] = (bf16_t)key0; }
                        if (p1) { const int pos = bc + __builtin_popcount(m0h) + p1i; cs[pos] = sc[1][a]; ci[pos] = (bf16_t)(key0 + 32); }
                    } else if (VAR == 2 || VAR == 4) {
                        const int qo = (2 * hh + a) * TK_CAP, rel = (hh ? cnt[2 + a] : cnt[a]);
                        if (p0) { const int pp = qo + ((rel + p0i) % TK_CAP); cs[pp] = sc[0][a]; ci[pp] = (bf16_t)key0; }
                        if (p1) { const int pp = qo + ((rel + __builtin_popcount(m0h) + p1i) % TK_CAP); cs[pp] = sc[1][a]; ci[pp] = (bf16_t)(key0 + 32); }
                    }
                    cnt[a] += __builtin_popcount((unsigned)m0) + __builtin_popcount((unsigned)m1);
                    cnt[2 + a] += __builtin_popcount((unsigned)(m0 >> 32)) + __builtin_popcount((unsigned)(m1 >> 32));
                }
            }
            if (VAR == 0 || VAR == 3) { if (cnt[0] > TK_SOFT || cnt[1] > TK_SOFT || cnt[2] > TK_SOFT || cnt[3] > TK_SOFT) { if (lane == 0) flag[ch % 3] = 1u; } }
        }
        if (ch + 1 < nch) *(LAS u32x4*)(lds + TK_KST + ((ch + 1) & 1) * (64 * GROW) + srow * GROW + scc * 16) = kr;
        kr = kr2; kr2 = kr3;
        if (tid == 0) flag[(ch + 1) % 3] = 0u;
        __syncthreads();
        if (VAR == 0 || VAR == 3) { if (flag[ch % 3] != 0u) { prune4_fast(cs, ci, cnt, tau, hist, lane, hh); } }
    }
    if (VAR == 1 || VAR == 2 || VAR == 3) { if (lane == 0) MASK[(tokb + tq0) * 256] = (unsigned)(cnt[0] + cnt[1] + cnt[2] + cnt[3]); __syncthreads(); return; }
    if (VAR == 4) {
#pragma unroll
        for (int q = 0; q < 4; ++q) cnt[q] = cnt[q] > TK_CAP ? TK_CAP : cnt[q];
    }
    lds_fence();
    prune4(cs, ci, cnt, tau, hist, lane, hh);
    LAS unsigned* mrow = hist;
#pragma unroll
    for (int q = 0; q < 4; ++q) {
        *(LAS u32x4*)(mrow + lane * 4) = (u32x4){0u, 0u, 0u, 0u};
        lds_fence();
#pragma unroll
        for (int e8 = 0; e8 < 8; ++e8) {
            const int i = lane + 64 * e8;
            if (i < cnt[q]) { const unsigned ix = ci[q * TK_CAP + i]; __hip_atomic_fetch_or(mrow + (ix >> 5), 1u << (ix & 31u), __ATOMIC_RELAXED, __HIP_MEMORY_SCOPE_WORKGROUP); }
        }
        lds_fence();
        const u32x4 mv = *(LAS u32x4*)(mrow + lane * 4);
        *(u32x4*)(MASK + (tokb + tq0 + q) * 256 + lane * 4) = mv;
        lds_fence();
    }
    __syncthreads();
}

constexpr int AT_STAGE = 2 * 64 * GROW;

__device__ __forceinline__ void attn_qk(f32x16 (&sacc)[2], const bf16x8 (&qf)[4], lds_t sb, int kap, int hh) {
#pragma unroll
    for (int kt = 0; kt < 2; ++kt)
#pragma unroll
        for (int r = 0; r < 16; ++r) sacc[kt][r] = 0.f;
#pragma unroll
    for (int ks = 0; ks < 4; ++ks)
#pragma unroll
        for (int kt = 0; kt < 2; ++kt) {
            const bf16x8 kf = *(LAS bf16x8*)(sb + (kt * 32 + kap) * GROW + (ks * 2 + hh) * 16);
            sacc[kt] = MFMA32(kf, qf[ks], sacc[kt]);
        }
}
template <int VAR>
__device__ __forceinline__ void attn_item(int e, const bf16_t* __restrict__ Q, const bf16_t* __restrict__ K, const bf16_t* __restrict__ VT, const unsigned* __restrict__ MASK, bf16_t* __restrict__ mixed, lds_t lds) {
    const int tid = otid(), lane = tid & 63, wid = tid >> 6, l31 = lane & 31, hh = lane >> 5;
    const int r8 = e >> 8, c = e & 255, pr = (c & 7) * 8 + (c >> 5), b = pr >> 3, head = pr & 7, jj = (c >> 3) & 3;
    const int qb = (r8 < 4) ? (jj + 4 * r8) : (31 - (jj + 4 * (r8 - 4)));
    const size_t tokb = (size_t)b * S;
    const int tq = qb * 256 + 32 * wid + l31;
    const size_t tok = tokb + tq;
    bf16x8 qf[4];
#pragma unroll
    for (int ks = 0; ks < 4; ++ks) qf[ks] = *(const bf16x8*)(Q + tok * 512 + head * 64 + ks * 16 + 8 * hh);
    const int nchb = (qb + 1) * 4, nchw = qb * 4 + (wid >> 1) + 1;
    f32x16 O[2];
#pragma unroll
    for (int a = 0; a < 2; ++a)
#pragma unroll
        for (int r = 0; r < 16; ++r) O[a][r] = 0.f;
    float mrun = -1e30f, lrun = 0.f;
    const float L2E = 1.4426950408889634f;
    const int srow = tid >> 3, scc = tid & 7;
    const bf16_t* kg = K + (tokb + srow) * 512 + head * 64 + scc * 8;
    const bf16_t* vg = VT + ((size_t)(b * 8 + head) * 64 + srow) * S + scc * 8;
    const unsigned* mg = MASK + tok * 256;
    const int kap = (l31 & 0x13) | ((l31 & 4) << 1) | ((l31 & 8) >> 1);
    u32x4 kr = *(const u32x4*)kg, vr = *(const u32x4*)vg, kr2, vr2;
    kr2 = *(const u32x4*)(kg + (size_t)1 * 64 * 512); vr2 = *(const u32x4*)(vg + 1 * 64);
    *(LAS u32x4*)(lds + srow * GROW + scc * 16) = kr;
    *(LAS u32x4*)(lds + 64 * GROW + srow * GROW + scc * 16) = vr;
    *(LAS u32x4*)(lds + AT_STAGE + srow * GROW + scc * 16) = kr2;
    *(LAS u32x4*)(lds + AT_STAGE + 64 * GROW + srow * GROW + scc * 16) = vr2;
    kr = *(const u32x4*)(kg + (size_t)2 * 64 * 512); vr = *(const u32x4*)(vg + 2 * 64);
    u32x2 mwn = *(const u32x2*)mg;
    __syncthreads();
    f32x16 scur[2];
    if (VAR != 2 && VAR < 3) attn_qk(scur, qf, lds, kap, hh);
    else {
#pragma unroll
        for (int kt = 0; kt < 2; ++kt)
#pragma unroll
            for (int r = 0; r < 16; ++r) scur[kt][r] = (float)(r + l31) * 0.01f;
    }
    for (int ch = 0; ch < nchb; ++ch) {
        if (ch + 3 < nchb && VAR != 4) { kr2 = *(const u32x4*)(kg + (size_t)(ch + 3) * 64 * 512); vr2 = *(const u32x4*)(vg + (ch + 3) * 64); }
        const lds_t sb = lds + (ch % 3) * AT_STAGE;
        if (ch < nchw) {
            const u32x2 mw = mwn;
            if (ch + 1 < nchw) mwn = *(const u32x2*)(mg + (ch + 1) * 2);
            f32x16 snext[2];
            if (ch + 1 < nchw) { if (VAR != 2 && VAR < 3) attn_qk(snext, qf, lds + ((ch + 1) % 3) * AT_STAGE, kap, hh); else {
#pragma unroll
                for (int kt = 0; kt < 2; ++kt)
#pragma unroll
                    for (int r = 0; r < 16; ++r) snext[kt][r] = scur[kt][r] * 0.999f + 0.001f * (float)ch;
            } }
            float mt = -INFINITY;
            if (VAR != 1 && VAR < 3)
#pragma unroll
            for (int kt = 0; kt < 2; ++kt) {
                const unsigned wsh = (kt == 0 ? mw.x : mw.y) >> (8 * hh);
#pragma unroll
                for (int r = 0; r < 16; ++r) {
                    const int bit = (r & 7) + 16 * (r >> 3);
                    const unsigned msk = (unsigned)__builtin_amdgcn_sbfe((int)wsh, bit, 1);
                    const float v = __uint_as_float((__float_as_uint(scur[kt][r]) & msk) | (~msk & 0xff800000u));
                    scur[kt][r] = v; mt = fmaxf(mt, v);
                }
            }
            if (VAR != 1 && VAR < 3) mt = fmaxf(mt, __shfl_xor(mt, 32));
            const float mnew = fmaxf(mrun, mt);
            if (VAR != 1 && VAR < 3 && __ballot(mnew != mrun) != 0ull) {
                const float alpha = __builtin_amdgcn_exp2f((mrun - mnew) * L2E);
                lrun *= alpha;
#pragma unroll
                for (int a = 0; a < 2; ++a)
#pragma unroll
                    for (int r = 0; r < 16; ++r) O[a][r] *= alpha;
                mrun = mnew;
            }
            const float mb = mrun * L2E;
            bf16x8 pf[2][2];
#pragma unroll
            for (int kt = 0; kt < 2; ++kt) {
                float pv[16];
#pragma unroll
                for (int r = 0; r < 16; ++r) { if (VAR == 1 || VAR >= 3) { pv[r] = scur[kt][r] + __uint_as_float(mw.x); } else { pv[r] = __builtin_amdgcn_exp2f(fmaf(scur[kt][r], L2E, -mb)); lrun += pv[r]; } }
#pragma unroll
                for (int s2 = 0; s2 < 2; ++s2) {
                    u32x4 w; w.x = pk_bf16(pv[8 * s2], pv[8 * s2 + 1]); w.y = pk_bf16(pv[8 * s2 + 2], pv[8 * s2 + 3]); w.z = pk_bf16(pv[8 * s2 + 4], pv[8 * s2 + 5]); w.w = pk_bf16(pv[8 * s2 + 6], pv[8 * s2 + 7]);
                    pf[kt][s2] = __builtin_bit_cast(bf16x8, w);
                }
            }
#pragma unroll
            for (int dt = 0; dt < 2; ++dt)
#pragma unroll
                for (int kt = 0; kt < 2; ++kt)
#pragma unroll
                    for (int s2 = 0; s2 < 2; ++s2) {
                        if (VAR != 2 && VAR < 3) {
                            const bf16x8 vf = *(LAS bf16x8*)(sb + 64 * GROW + (dt * 32 + l31) * GROW + (kt * 32 + 16 * s2 + 8 * hh) * 2);
                            O[dt] = MFMA32(vf, pf[kt][s2], O[dt]);
                        } else { O[dt][(kt * 2 + s2) * 4] += __uint_as_float((unsigned)pf[kt][s2][0] << 16); }
                    }
            if (ch + 1 < nchw) {
#pragma unroll
                for (int kt = 0; kt < 2; ++kt) scur[kt] = snext[kt];
            }
        }
        if (ch + 2 < nchb && VAR != 4) {
            const lds_t nb = lds + ((ch + 2) % 3) * AT_STAGE;
            *(LAS u32x4*)(nb + srow * GROW + scc * 16) = kr;
            *(LAS u32x4*)(nb + 64 * GROW + srow * GROW + scc * 16) = vr;
        }
        kr = kr2; vr = vr2;
        __syncthreads();
    }
    const float ltot = lrun + __shfl_xor(lrun, 32);
    const float inv = 1.0f / ltot;
#pragma unroll
    for (int dt = 0; dt < 2; ++dt)
#pragma unroll
        for (int rq = 0; rq < 4; ++rq) {
            u32x2 w; w.x = pk_bf16(O[dt][4 * rq] * inv, O[dt][4 * rq + 1] * inv); w.y = pk_bf16(O[dt][4 * rq + 2] * inv, O[dt][4 * rq + 3] * inv);
            *(u32x2*)(mixed + tok * D + 512 + head * 64 + dt * 32 + 8 * rq + 4 * hh) = w;
        }
}

template <int N> __device__ __forceinline__ void bitonic_desc(int (&a)[N]) {
#pragma unroll
    for (int k = 2; k <= N; k <<= 1)
#pragma unroll
        for (int j = k >> 1; j > 0; j >>= 1)
#pragma unroll
            for (int i = 0; i < N; ++i) {
                const int l = i ^ j;
                if (l > i) {
                    const int hi = max(a[i], a[l]), lo = min(a[i], a[l]);
                    const bool desc = ((i & k) == 0);
                    a[i] = desc ? hi : lo; a[l] = desc ? lo : hi;
                }
            }
}
__device__ __forceinline__ void merge16(int (&a)[16], const int (&b)[16]) {
#pragma unroll
    for (int i = 0; i < 16; ++i) a[i] = max(a[i], b[15 - i]);
#pragma unroll
    for (int j = 8; j > 0; j >>= 1)
#pragma unroll
        for (int i = 0; i < 16; ++i) { const int l = i ^ j; if (l > i) { const int hi = max(a[i], a[l]), lo = min(a[i], a[l]); a[i] = hi; a[l] = lo; } }
}
__device__ __forceinline__ void merge_partner(int (&a)[16]) {
    int b[16];
#pragma unroll
    for (int i = 0; i < 16; ++i) b[i] = __shfl_xor(a[i], 32);
    merge16(a, b);
}
__device__ __forceinline__ int f2skey(float s) { const int b = (int)__float_as_uint(s); return b ^ ((b >> 31) & 0x7fffffff); }
__device__ __forceinline__ float skey2f(int k) { return __uint_as_float((unsigned)(k ^ ((k >> 31) & 0x7fffffff))); }

__device__ __forceinline__ float sel_f(bool c, float a, float b) { asm volatile("" : "+v"(a), "+v"(b)); return c ? a : b; }
__device__ __forceinline__ int sel_i(bool c, int a, int b) { asm volatile("" : "+v"(a), "+v"(b)); return c ? a : b; }
struct CandTab { int ci[64], cj[64]; };
__host__ __device__ constexpr CandTab make_cand() { CandTab t{}; int n = 0; for (int i = 0; i < 16; ++i) for (int j = 0; j < 16; ++j) if ((i + 1) * (j + 1) <= 16) { t.ci[n] = i; t.cj[n] = j; ++n; } return t; }

__device__ __forceinline__ void peersel_item(int tg, int l, const bf16_t* __restrict__ QP, const bf16_t* __restrict__ SK, unsigned* __restrict__ PIDX, float* __restrict__ PG, lds_t lds) {
    const int tid = otid(), lane = tid & 63, head = tid >> 6, l31 = lane & 31, hh = lane >> 5;
    const size_t tok = (size_t)tg * 32 + l31;
    int L[2][16];
#pragma unroll
    for (int p = 0; p < 2; ++p) {
        f32x16 acc[4];
#pragma unroll
        for (int nt = 0; nt < 4; ++nt)
#pragma unroll
            for (int r = 0; r < 16; ++r) acc[nt][r] = 0.f;
        const bf16_t* qp = QP + tok * 2048 + (head * 2 + p) * 128 + 8 * hh;
        const bf16_t* sk = SK + ((size_t)((l * 8 + head) * 2 + p) * 128 + l31) * 128 + 8 * hh;
        { int oz = 0; asm volatile("" : "+v"(oz)); sk += oz; }
#pragma unroll 2
        for (int ks = 0; ks < 8; ++ks) {
            const bf16x8 qv = *(const bf16x8*)(qp + ks * 16);
#pragma unroll
            for (int nt = 0; nt < 4; ++nt) { const bf16x8 sv = *(const bf16x8*)(sk + (size_t)nt * 32 * 128 + ks * 16); acc[nt] = MFMA32(sv, qv, acc[nt]); }
        }
#pragma unroll
        for (int nt = 0; nt < 4; ++nt) {
            int g[16];
#pragma unroll
            for (int r = 0; r < 16; ++r) { const int n0 = nt * 32 + (r & 3) + 8 * (r >> 2); g[r] = (f2skey(acc[nt][r]) & ~127) | ((127 - n0) - 4 * hh); }
            bitonic_desc<16>(g);
            if (nt == 0) {
#pragma unroll
                for (int r = 0; r < 16; ++r) L[p][r] = g[r];
            } else merge16(L[p], g);
            __builtin_amdgcn_sched_barrier(0);
        }
        merge_partner(L[p]);
        __builtin_amdgcn_sched_barrier(0);
    }
    LAS unsigned char* nl = (LAS unsigned char*)lds + (size_t)tid * 32;
#pragma unroll
    for (int i = 0; i < 16; ++i) { nl[i] = (unsigned char)(127 - (L[0][i] & 127)); nl[16 + i] = (unsigned char)(127 - (L[1][i] & 127)); }
    float va[16], vb[16];
#pragma unroll
    for (int i = 0; i < 16; ++i) { va[i] = skey2f(L[0][i] & ~127); vb[i] = skey2f(L[1][i] & ~127); }
    constexpr CandTab ct = make_cand();
    int cA[16], cB[16];
#pragma unroll
    for (int m = 0; m < 16; ++m) {
        const float s = sel_f(hh, va[ct.ci[2 * m + 1]], va[ct.ci[2 * m]]) + sel_f(hh, vb[ct.cj[2 * m + 1]], vb[ct.cj[2 * m]]);
        const int code = hh ? (ct.ci[2 * m + 1] * 16 + ct.cj[2 * m + 1]) : (ct.ci[2 * m] * 16 + ct.cj[2 * m]);
        cA[m] = (f2skey(s) & ~255) | (255 - code);
    }
#pragma unroll
    for (int m = 16; m < 32; ++m) {
        if (m < 25) {
            const float s = sel_f(hh, va[ct.ci[2 * m + 1]], va[ct.ci[2 * m]]) + sel_f(hh, vb[ct.cj[2 * m + 1]], vb[ct.cj[2 * m]]);
            const int code = hh ? (ct.ci[2 * m + 1] * 16 + ct.cj[2 * m + 1]) : (ct.ci[2 * m] * 16 + ct.cj[2 * m]);
            cB[m - 16] = (f2skey(s) & ~255) | (255 - code);
        } else cB[m - 16] = (int)0x80000000;
    }
    __builtin_amdgcn_sched_barrier(0);
    bitonic_desc<16>(cA); bitonic_desc<16>(cB);
    merge16(cA, cB);
    merge_partner(cA);
    lds_fence();
    float val[16], ex[16], sum = 0.f;
#pragma unroll
    for (int r = 0; r < 16; ++r) val[r] = skey2f(cA[r] & ~255);
#pragma unroll
    for (int r = 0; r < 16; ++r) { ex[r] = __expf(val[r] - val[0]); sum += ex[r]; }
    const float inv = 1.0f / sum;
#pragma unroll
    for (int r = 0; r < 8; ++r) {
        const int kk = sel_i(hh, cA[8 + r], cA[r]);
        const float gk = sel_f(hh, ex[8 + r], ex[r]) * inv;
        const int code = 255 - (kk & 255);
        const unsigned ia = nl[code >> 4], ib = nl[16 + (code & 15)];
        PIDX[tok * 128 + head * 16 + 8 * hh + r] = ia * 128u + ib;
        PG[tok * 128 + head * 16 + 8 * hh + r] = gk;
    }
}

__device__ __forceinline__ v6u_t ld_pack(const unsigned char* p) { const u32x2 a = *(const u32x2*)p, b = *(const u32x2*)(p + 8), c = *(const u32x2*)(p + 16); return (v6u_t){a[0], a[1], b[0], b[1], c[0], c[1]}; }
__device__ __forceinline__ void peer_gather(int l, const bf16_t* __restrict__ H, const unsigned* __restrict__ PIDX, const float* __restrict__ PG, const unsigned char* __restrict__ EU, const unsigned char* __restrict__ EV,
                                            const float* __restrict__ ES, const float* __restrict__ gate  , float* x, float* xout,
                                            const float* __restrict__ nrmw  , const float* __restrict__ nsh, const float* __restrict__ nsc  , bf16_t* hnext, float* fout) {
    const int tid = otid(), lane = tid & 63, wid = tid >> 6, g = lane >> 4, j = lane & 15, l5 = lane & 31, hf = lane >> 5;
    const int nw = gridDim.x * 8;
    const unsigned char* eu = EU + (size_t)l * NEXP * EROW;
    const unsigned char* ev = EV + (size_t)l * NEXP * EROW;
    const f32x2* es = (const f32x2*)ES + (size_t)l * NEXP;
    for (int gw = blockIdx.x * 8 + wid; gw * 32 < T; gw += nw) {
        const int b = (gw * 32) / S;
        for (int tr = 0; tr < 32; ++tr) {
            const size_t t = (size_t)gw * 32 + tr;
            unsigned hp[32];
#pragma unroll
            for (int i = 0; i < 8; ++i) {
                const u32x4 a = *(const u32x4*)(H + t * D + j * 64 + i * 8);
#pragma unroll
                for (int q = 0; q < 4; ++q) hp[4 * i + q] = a[q];
            }
            const unsigned e0 = PIDX[t * 128 + lane], e1 = PIDX[t * 128 + 64 + lane];
            const float g0 = PG[t * 128 + lane], g1 = PG[t * 128 + 64 + lane];
            float acc[32];
#pragma unroll
            for (int i = 0; i < 32; ++i) acc[i] = 0.f;
            unsigned eid_n[2]; float gt_n[2]; v6u_t un[2][2]; f32x2 sc_n[2];
#pragma unroll
            for (int h2 = 0; h2 < 2; ++h2) {
                eid_n[h2] = (unsigned)__shfl((int)e0, 4 * h2 + g); gt_n[h2] = __shfl(g0, 4 * h2 + g);
                const unsigned char* ur = eu + (size_t)eid_n[h2] * EROW + j * 48;
                un[h2][0] = ld_pack(ur); un[h2][1] = ld_pack(ur + 24);
                sc_n[h2] = es[eid_n[h2]];
            }
            for (int it = 0; it < 16; ++it) {
                unsigned eid[2]; float gt[2]; f32x2 sc[2]; v6u_t uc[2][2], vv[2][2];
#pragma unroll
                for (int h2 = 0; h2 < 2; ++h2) {
                    eid[h2] = eid_n[h2]; gt[h2] = gt_n[h2]; sc[h2] = sc_n[h2]; uc[h2][0] = un[h2][0]; uc[h2][1] = un[h2][1];
#pragma unroll
                    for (int pr = 0; pr < 2; ++pr) {
                        const unsigned va = (unsigned)__builtin_amdgcn_readlane((int)eid[h2], (2 * pr) * 16), vb = (unsigned)__builtin_amdgcn_readlane((int)eid[h2], (2 * pr + 1) * 16);
                        vv[h2][pr] = ld_pack(ev + (size_t)(hf ? vb : va) * EROW + l5 * 24);
                    }
                }
                if (it + 1 < 16) {
#pragma unroll
                    for (int h2 = 0; h2 < 2; ++h2) {
                        const int ent = (it + 1) * 8 + 4 * h2 + g;
                        eid_n[h2] = (unsigned)__shfl((int)(it + 1 < 8 ? e0 : e1), ent & 63); gt_n[h2] = __shfl(it + 1 < 8 ? g0 : g1, ent & 63);
                        const unsigned char* ur = eu + (size_t)eid_n[h2] * EROW + j * 48;
                        un[h2][0] = ld_pack(ur); un[h2][1] = ld_pack(ur + 24);
                        sc_n[h2] = es[eid_n[h2]];
                    }
                }
#pragma unroll
                for (int h2 = 0; h2 < 2; ++h2) {
                    float part = 0.f;
#pragma unroll
                    for (int pk = 0; pk < 2; ++pk) {
                        const v32f_t uf = __builtin_amdgcn_cvt_scalef32_pk32_f32_fp6(uc[h2][pk], 1.0f);
#pragma unroll
                        for (int q = 0; q < 16; ++q) part = dot2bf(pk_bf16(uf[2 * q], uf[2 * q + 1]), hp[16 * pk + q], part);
                    }
                    part += __shfl_xor(part, 1); part += __shfl_xor(part, 2); part += __shfl_xor(part, 4); part += __shfl_xor(part, 8);
                    const float a = part * sc[h2][0];
                    const float act = gt[h2] * 0.5f * a * (1.0f + erff(a * 0.70710678118654752f)) * sc[h2][1];
#pragma unroll
                    for (int pr = 0; pr < 2; ++pr) {
                        const float aa = __uint_as_float((unsigned)__builtin_amdgcn_readlane((int)__float_as_uint(act), (2 * pr) * 16));
                        const float ab = __uint_as_float((unsigned)__builtin_amdgcn_readlane((int)__float_as_uint(act), (2 * pr + 1) * 16));
                        const v32f_t vf = __builtin_amdgcn_cvt_scalef32_pk32_f32_fp6(vv[h2][pr], 1.0f);
                        const float av = hf ? ab : aa;
#pragma unroll
                        for (int q = 0; q < 32; ++q) acc[q] = fmaf(av, vf[q], acc[q]);
                    }
                }
            }
            float a16[16];
#pragma unroll
            for (int q = 0; q < 16; ++q) {
                const float lo_ = acc[q] + __shfl_xor(acc[q], 32), hi_ = acc[16 + q] + __shfl_xor(acc[16 + q], 32);
                a16[q] = sel_f(hf, hi_, lo_);
            }
            const int cb = 32 * l5 + 16 * hf;
            float* xr = x + t * D + cb; float* xw = xout + t * D + cb;
            const float* gr = gate + (size_t)b * 6144 + cb;
            f32x4 xn[4]; float ss = 0.f;
#pragma unroll
            for (int q = 0; q < 4; ++q) {
                const f32x4 xo = *(const f32x4*)(xr + 4 * q), gg4 = *(const f32x4*)(gr + 4 * q);
                f32x4 a4; a4[0] = a16[4 * q]; a4[1] = a16[4 * q + 1]; a4[2] = a16[4 * q + 2]; a4[3] = a16[4 * q + 3];
                xn[q] = xo + gg4 * a4;
                ss += xn[q][0] * xn[q][0] + xn[q][1] * xn[q][1] + xn[q][2] * xn[q][2] + xn[q][3] * xn[q][3];
            }
            ss = wave_sum(ss);
            const float rstd = rsqrtf(ss * (1.0f / D) + 1e-6f);
            int ozn = 0; asm volatile("" : "+v"(ozn));
#pragma unroll
            for (int q = 0; q < 4; ++q) {
                const f32x4 w4 = *(const f32x4*)(nrmw + cb + 4 * q + ozn);
                f32x4 y = xn[q] * rstd * w4;
                if (nsc) {
                    *(f32x4*)(xw + 4 * q) = xn[q];
                    const f32x4 c4 = *(const f32x4*)(nsc + (size_t)b * 6144 + cb + 4 * q + ozn) + 1.0f, s4 = *(const f32x4*)(nsh + (size_t)b * 6144 + cb + 4 * q + ozn);
                    y = y * c4 + s4;
                    u32x2 w; w.x = pk_bf16(y[0], y[1]); w.y = pk_bf16(y[2], y[3]);
                    *(u32x2*)(hnext + t * D + cb + 4 * q) = w;
                } else {
                    *(f32x4*)(fout + t * D + cb + 4 * q) = y;
                }
            }
        }
    }
}

__global__ void __launch_bounds__(NTHREADS, 2) mega(const float* x, const float* c, const int* pos, const float* w_ada, const float* b_ada, const float* norm_mix, const float* w_in, const float* w_pool,
                                                     const float* pool_scale, const float* w_out, const float* norm_ffn, const float* w_query, const float* sub_keys, const float* expert_u, const float* expert_v,
                                                     const float* final_norm, float* out, unsigned char* wsp, int ph_lo, int ph_hi) {
    Params p; p.x = x; p.c = c; p.pos = pos; p.w_ada = w_ada; p.b_ada = b_ada; p.norm_mix = norm_mix; p.w_in = w_in; p.w_pool = w_pool; p.pool_scale = pool_scale; p.w_out = w_out; p.norm_ffn = norm_ffn;
    p.w_query = w_query; p.sub_keys = sub_keys; p.expert_u = expert_u; p.expert_v = expert_v; p.final_norm = final_norm; p.out = out; p.ws = wsp; p.ph_lo = ph_lo; p.ph_hi = ph_hi;
    __shared__ __attribute__((aligned(16))) unsigned char smem_raw[LDS_BYTES];
    lds_t lds = (lds_t)smem_raw;
    unsigned char* ws = p.ws;
    volatile LAS unsigned* st = (volatile LAS unsigned*)(lds + 147456);
    if (threadIdx.x == 0) { st[0] = 0u; st[1] = 0u; st[2] = 0u; st[3] = 0u; }
    __syncthreads();
    XcdBarrier bar = xcd_barrier_post((unsigned*)(ws + WS_CTL), st);
    const int lo = p.ph_lo, hi = p.ph_hi, G = gridDim.x, bid = blockIdx.x;
#if MK_STAMP
    unsigned long long* stamps = (unsigned long long*)(ws + 1010 * MBy) + (size_t)blockIdx.x * 64;
    if (threadIdx.x == 0) stamps[63] = wall_clock64();
#define RUN(n) ((n) >= lo && (n) < hi)
#define SEAM(n) do { if (threadIdx.x == 0) stamps[2 * (n)] = wall_clock64(); if ((n) >= lo && (n) + 1 < hi) xcd_barrier(bar); if (threadIdx.x == 0) stamps[2 * (n) + 1] = wall_clock64(); } while (0)
#else
#define RUN(n) ((n) >= lo && (n) < hi)
#define SEAM(n) do { if ((n) >= lo && (n) + 1 < hi) xcd_barrier(bar); } while (0)
#endif

    float* modp = (float*)(ws + WS_MOD);
    bf16_t* Hb = (bf16_t*)(ws + WS_H);

    if (RUN(0)) phase_prologue(p, lds);
#if MK_DUP & 512
    if (RUN(0)) { __syncthreads(); phase_prologue(p, lds); }
#endif
    SEAM(0);
    for (int l = 0; l < DEPTH; ++l) {
        const int pb = 1 + 9 * l;
        unsigned char* const ws0 = p.ws;
        const float* xin = (l == 0) ? p.x : p.out;
        const float* modl = modp + (size_t)l * NB * 6144;
        if (RUN(pb + 0) && l == 0) { size_t oz = 0; asm volatile("" : "+s"(oz)); unsigned char* ws = ws0 + oz;     bf16_t* Hb = (bf16_t*)(ws + WS_H); float* modp = (float*)(ws + WS_MOD); const float* modl = modp + (size_t)l * NB * 6144; phase_norm<0>(xin, p.norm_mix + (size_t)l * D, modl + 0, modl + 1024, Hb, nullptr); }
        if (l == 0 || MK_STAMP) SEAM(pb + 0);
        if (RUN(pb + 1)) { size_t oz = 0; asm volatile("" : "+s"(oz)); unsigned char* ws = ws0 + oz;     bf16_t* Hb = (bf16_t*)(ws + WS_H); float* modp = (float*)(ws + WS_MOD); const float* modl = modp + (size_t)l * NB * 6144; { }
            EpiIn ep; ep.xp = (bf16_t*)(ws + WS_XP); ep.q = (bf16_t*)(ws + WS_Q); ep.k = (bf16_t*)(ws + WS_K); ep.vt = (bf16_t*)(ws + WS_VT); ep.qi = (bf16_t*)(ws + WS_QI); ep.ki = (bf16_t*)(ws + WS_KI);
            ep.wi = (float*)(ws + WS_WI); ep.rope = (const float*)(ws + WS_ROPE);
            gemm_phase(Hb, (const bf16_t*)(ws + WS_WIN) + (size_t)l * NIN * D, NIN, ep, lds);
#if MK_DUP & 1
            { __syncthreads(); EpiNull en; en.sink = (float*)(ws + 746 * MBy); gemm_phase<MK_DUPVAR>(Hb, (const bf16_t*)(ws + WS_WIN) + (size_t)l * NIN * D, NIN, en, lds); }
#endif
        }
        SEAM(pb + 1);
        if (RUN(pb + 2)) { size_t oz = 0; asm volatile("" : "+s"(oz)); unsigned char* ws = ws0 + oz;     bf16_t* Hb = (bf16_t*)(ws + WS_H); float* modp = (float*)(ws + WS_MOD); const float* modl = modp + (size_t)l * NB * 6144; { }
            for (int e = bid; e < 2048; e += G) topk_item<0>(e, (const bf16_t*)(ws + WS_QI), (const bf16_t*)(ws + WS_KI), (const float*)(ws + WS_WI), (unsigned*)(ws + WS_MASK), lds);
#if MK_DUP & 2
            for (int e = bid; e < 2048; e += G) topk_item<MK_DUPVAR>(e, (const bf16_t*)(ws + WS_QI), (const bf16_t*)(ws + WS_KI), (const float*)(ws + WS_WI), (unsigned*)(ws + 746 * MBy), lds);
#endif
            for (int e = bid; e < 2048; e += G) pool_item(e, (const bf16_t*)(ws + WS_XP), (const bf16_t*)(ws + WS_WPOOL) + (size_t)l * 4 * 128 * 128, p.pool_scale + (size_t)l * 512, Hb, lds);
#if MK_DUP & 4
            for (int e = bid; e < 2048; e += G) pool_item(e, (const bf16_t*)(ws + WS_XP), (const bf16_t*)(ws + WS_WPOOL) + (size_t)l * 4 * 128 * 128, p.pool_scale + (size_t)l * 512, Hb, lds);
#endif
        }
        SEAM(pb + 2);
        if (RUN(pb + 3)) { size_t oz = 0; asm volatile("" : "+s"(oz)); unsigned char* ws = ws0 + oz;     bf16_t* Hb = (bf16_t*)(ws + WS_H); float* modp = (float*)(ws + WS_MOD); const float* modl = modp + (size_t)l * NB * 6144; { }
            for (int e = bid; e < 2048; e += G) attn_item<0>(e, (const bf16_t*)(ws + WS_Q), (const bf16_t*)(ws + WS_K), (const bf16_t*)(ws + WS_VT), (const unsigned*)(ws + WS_MASK), Hb, lds);
#if MK_DUP & 8
            __syncthreads(); for (int e = bid; e < 2048; e += G) attn_item<MK_DUPVAR>(e, (const bf16_t*)(ws + WS_Q), (const bf16_t*)(ws + WS_K), (const bf16_t*)(ws + WS_VT), (const unsigned*)(ws + WS_MASK), (bf16_t*)(ws + 746 * MBy), lds);
#endif
        }
        SEAM(pb + 3);
        if (RUN(pb + 4)) { size_t oz = 0; asm volatile("" : "+s"(oz)); unsigned char* ws = ws0 + oz;     bf16_t* Hb = (bf16_t*)(ws + WS_H); float* modp = (float*)(ws + WS_MOD); const float* modl = modp + (size_t)l * NB * 6144; { }
            EpiOut ep; ep.xin = xin; ep.xout = p.out; ep.gate = modl + 2 * 1024;
            gemm_phase(Hb, (const bf16_t*)(ws + WS_WOUT) + (size_t)l * D * D, D, ep, lds);
        }
        SEAM(pb + 4);
        if (RUN(pb + 5)) { size_t oz = 0; asm volatile("" : "+s"(oz)); unsigned char* ws = ws0 + oz;     bf16_t* Hb = (bf16_t*)(ws + WS_H); float* modp = (float*)(ws + WS_MOD); const float* modl = modp + (size_t)l * NB * 6144; phase_norm<0>(p.out, p.norm_ffn + (size_t)l * D, modl + 3 * 1024, modl + 4 * 1024, Hb, nullptr);
#if MK_DUP & 256
            phase_norm<0>(p.out, p.norm_ffn + (size_t)l * D, modl + 3 * 1024, modl + 4 * 1024, Hb, nullptr);
#endif
        }
        SEAM(pb + 5);
        if (RUN(pb + 6)) { size_t oz = 0; asm volatile("" : "+s"(oz)); unsigned char* ws = ws0 + oz;     bf16_t* Hb = (bf16_t*)(ws + WS_H); float* modp = (float*)(ws + WS_MOD); const float* modl = modp + (size_t)l * NB * 6144; { }
            EpiBf ep; ep.C = (bf16_t*)(ws + WS_QP); ep.ldc = 2048;
            gemm_phase(Hb, (const bf16_t*)(ws + WS_WQ) + (size_t)l * 2048 * D, 2048, ep, lds);
#if MK_DUP & 32
            __syncthreads(); gemm_phase(Hb, (const bf16_t*)(ws + WS_WQ) + (size_t)l * 2048 * D, 2048, ep, lds);
#endif
        }
        SEAM(pb + 6);
        if (RUN(pb + 7)) { size_t oz = 0; asm volatile("" : "+s"(oz)); unsigned char* ws = ws0 + oz;     bf16_t* Hb = (bf16_t*)(ws + WS_H); float* modp = (float*)(ws + WS_MOD); const float* modl = modp + (size_t)l * NB * 6144; { }
            for (int e = bid; e < 2048; e += G) peersel_item(e, l, (const bf16_t*)(ws + WS_QP), (const bf16_t*)(ws + WS_SK), (unsigned*)(ws + WS_PIDX), (float*)(ws + WS_PG), lds);
#if MK_DUP & 64
            for (int e = bid; e < 2048; e += G) peersel_item(e, l, (const bf16_t*)(ws + WS_QP), (const bf16_t*)(ws + WS_SK), (unsigned*)(ws + WS_PIDX), (float*)(ws + WS_PG), lds);
#endif
        }
        SEAM(pb + 7);
        if (RUN(pb + 8)) { size_t oz = 0; asm volatile("" : "+s"(oz)); unsigned char* ws = ws0 + oz;     bf16_t* Hb = (bf16_t*)(ws + WS_H); float* modp = (float*)(ws + WS_MOD); const float* modl = modp + (size_t)l * NB * 6144;
#if MK_DUP & 128
            peer_gather(l, Hb, (const unsigned*)(ws + WS_PIDX), (const float*)(ws + WS_PG), (const unsigned char*)(ws + WS_EU), (const unsigned char*)(ws + WS_EV), (const float*)(ws + WS_ES), modl + 5 * 1024, p.out, (float*)(ws + 746 * MBy), p.final_norm, nullptr, nullptr, nullptr, (float*)(ws + 746 * MBy));
#endif
            peer_gather(l, Hb, (const unsigned*)(ws + WS_PIDX), (const float*)(ws + WS_PG), (const unsigned char*)(ws + WS_EU), (const unsigned char*)(ws + WS_EV), (const float*)(ws + WS_ES), modl + 5 * 1024, p.out, p.out,
                        l + 1 < DEPTH ? p.norm_mix + (size_t)(l + 1) * D : p.final_norm, l + 1 < DEPTH ? modp + (size_t)(l + 1) * NB * 6144 : nullptr, l + 1 < DEPTH ? modp + (size_t)(l + 1) * NB * 6144 + 1024 : nullptr, Hb, p.out); }
        if (l + 1 < DEPTH) SEAM(pb + 8);
    }
#if MK_STAMP
    {
        if (threadIdx.x == 0) stamps[2 * 18] = wall_clock64();
        xcd_barrier(bar);
        LAS unsigned long long* red = (LAS unsigned long long*)lds;
        const int P = MK_STAMP_PH;
        if (threadIdx.x < 256 && (int)threadIdx.x < (int)gridDim.x) {
            const unsigned long long* sb = (const unsigned long long*)(ws + 1010 * MBy) + (size_t)threadIdx.x * 64;
            red[threadIdx.x] = (P == 0) ? sb[63] : sb[2 * (P - 1) + 1];
            red[256 + threadIdx.x] = sb[2 * P];
        }
        __syncthreads();
        unsigned long long mn = ~0ull, mx = 0ull;
        const int nb = (int)gridDim.x < 256 ? (int)gridDim.x : 256;
        for (int i = 0; i < nb; ++i) { mn = red[i] < mn ? red[i] : mn; mx = red[256 + i] > mx ? red[256 + i] : mx; }
        const float E = (float)(mx - mn) * 1e-3f;
        const size_t n = (size_t)T * D, stride = (size_t)gridDim.x * NTHREADS;
        for (size_t i = (size_t)blockIdx.x * NTHREADS + threadIdx.x; i < n; i += stride) p.out[i] = E;
    }
#endif
#undef RUN
#undef SEAM
}


#ifndef MK_CHECK
#define MK_CHECK 0
#endif
#ifndef MK_CHECK_LAYER
#define MK_CHECK_LAYER 0
#endif
#ifndef MK_CHECK_SLOT0
#define MK_CHECK_SLOT0 0
#endif
#if MK_CHECK
__device__ __forceinline__ unsigned hash32(unsigned x) { x ^= x >> 16; x *= 0x7feb352dU; x ^= x >> 15; x *= 0x846ca68bU; x ^= x >> 16; return x; }
__device__ __forceinline__ float bfv(const bf16_t* p, size_t i) { return __uint_as_float((unsigned)p[i] << 16); }
__device__ __forceinline__ bool badrel(float got, float ref, float rtol, float atol) { return !(fabsf(got - ref) <= atol + rtol * fabsf(ref)); }
#define DIAG(p) ((unsigned*)((p).ws + WS_CTL + 32768))
constexpr size_t WS_XCOPY = 746 * MBy;

__global__ void chk_mod(Params p) {
    const unsigned id = blockIdx.x * blockDim.x + threadIdx.x;
    const unsigned h = hash32(id * 3u + 1u);
    const int l = h & 1, b = (h >> 1) & 7, j = (h >> 4) % 6144;
    float s = 0.f;
    for (int k = 0; k < D; ++k) { const float c = p.c[b * D + k]; s += (c / (1.f + expf(-c))) * p.w_ada[((size_t)l * D + k) * 6144 + j]; }
    s += p.b_ada[l * 6144 + j];
    const float got = ((const float*)(p.ws + WS_MOD))[((size_t)l * NB + b) * 6144 + j];
    if (badrel(got, s, 1e-3f, 1e-4f)) atomicAdd(DIAG(p) + 0, 1u);
}
__global__ void chk_norm(Params p, int l, int which, const float* xin, int slot) {
    const unsigned id = blockIdx.x * blockDim.x + threadIdx.x;
    const unsigned h = hash32(id * 7u + 3u);
    const int t = h % T, b = t / S;
    const float* xr = xin + (size_t)t * D;
    float ss = 0.f; for (int k = 0; k < D; ++k) ss += xr[k] * xr[k];
    const float rstd = 1.0f / sqrtf(ss / D + 1e-6f);
    const float* modl = (const float*)(p.ws + WS_MOD) + ((size_t)l * NB + b) * 6144;
    const float* gw = (which ? p.norm_ffn : p.norm_mix) + (size_t)l * D;
    const float* sh = modl + (which ? 3 : 0) * 1024; const float* sc = modl + (which ? 4 : 1) * 1024;
    const bf16_t* hb = (const bf16_t*)(p.ws + WS_H);
    for (int q = 0; q < 4; ++q) {
        const int n = hash32(h + q) % D;
        const float ref = xr[n] * rstd * gw[n] * (1.f + sc[n]) + sh[n];
        if (badrel(bfv(hb, (size_t)t * D + n), ref, 1e-2f, 1e-2f)) atomicAdd(DIAG(p) + slot, 1u);
    }
}
__device__ float dot_h_w(const bf16_t* hrow, const float* w, int ldw, int n) { float s = 0.f; for (int k = 0; k < D; ++k) s += bfv(hrow, k) * w[(size_t)k * ldw + n]; return s; }
__global__ void chk_in(Params p, int l) {
    const unsigned id = blockIdx.x * blockDim.x + threadIdx.x;
    const unsigned h = hash32(id * 11u + 5u);
    const int t = h % T; const int n = hash32(h) % DIN;
    const bf16_t* hrow = (const bf16_t*)(p.ws + WS_H) + (size_t)t * D;
    const float* w = p.w_in + (size_t)l * D * DIN;
    const float* rope = (const float*)(p.ws + WS_ROPE) + (size_t)t * 16;
    const int b = t / S, s = t % S;
    float ref, got; int slot = 2;
    auto roped = [&](int base, int d) -> float {
        if (d >= 16) return dot_h_w(hrow, w, DIN, base + d);
        const int f = d & 7; const float x1 = dot_h_w(hrow, w, DIN, base + f), x2 = dot_h_w(hrow, w, DIN, base + 8 + f);
        return d < 8 ? x1 * rope[f] - x2 * rope[8 + f] : x1 * rope[8 + f] + x2 * rope[f];
    };
    if (n < 512) { ref = dot_h_w(hrow, w, DIN, n); got = bfv((const bf16_t*)(p.ws + WS_XP), (size_t)t * 512 + n); }
    else if (n < 1024) { const int c = n - 512; ref = roped(512 + (c & ~63), c & 63) * 0.125f; got = bfv((const bf16_t*)(p.ws + WS_Q), (size_t)t * 512 + c); }
    else if (n < 1536) { const int c = n - 1024; ref = roped(1024 + (c & ~63), c & 63); got = bfv((const bf16_t*)(p.ws + WS_K), (size_t)t * 512 + c); }
    else if (n < 2048) { const int c = n - 1536; ref = dot_h_w(hrow, w, DIN, n); got = bfv((const bf16_t*)(p.ws + WS_VT), ((size_t)(b * 8 + (c >> 6)) * 64 + (c & 63)) * S + s); }
    else if (n < 2560) { const int c = n - 2048; ref = roped(2048 + (c & ~63), c & 63) * 0.125f; got = bfv((const bf16_t*)(p.ws + WS_QI), (size_t)t * 512 + c); }
    else if (n < 2624) { const int c = n - 2560; ref = roped(2560, c); got = bfv((const bf16_t*)(p.ws + WS_KI), (size_t)t * 64 + c); }
    else { const int c = n - 2624; ref = dot_h_w(hrow, w, DIN, n) * 0.35355339f; got = ((const float*)(p.ws + WS_WI))[(size_t)t * 8 + c]; }
    if (badrel(got, ref, 2e-2f, 3e-2f)) atomicAdd(DIAG(p) + slot, 1u);
}
__global__ void chk_pool(Params p, int l) {
    const unsigned id = blockIdx.x * blockDim.x + threadIdx.x;
    const unsigned h = hash32(id * 13u + 7u);
    const int t = h % T, s = t % S; const int n = hash32(h) % 512, g = n >> 7, d = n & 127, w = 2 << g;
    const bf16_t* xp = (const bf16_t*)(p.ws + WS_XP);
    float ref = 0.f;
    for (int c = 0; c < 128; ++c) {
        float sum = 0.f; int cnt = 0;
        for (int jj = 0; jj < w; ++jj) if (s - jj >= 0) { sum += bfv(xp, (size_t)(t - jj) * 512 + g * 128 + c); ++cnt; }
        const float pooled = sum / (float)cnt - bfv(xp, (size_t)t * 512 + g * 128 + c);
        ref += pooled * p.w_pool[(((size_t)l * 4 + g) * 128 + c) * 128 + d];
    }
    ref *= p.pool_scale[l * 512 + n];
    if (badrel(bfv((const bf16_t*)(p.ws + WS_H), (size_t)t * D + n), ref, 3e-2f, 3e-2f)) atomicAdd(DIAG(p) + 3, 1u);
}
__global__ void __launch_bounds__(512) chk_topk(Params p) {
    __shared__ float sc[S];
    __shared__ int nbad;
    const unsigned h = hash32(blockIdx.x * 17u + 9u);
    const int b = h & 7; int tq = (h >> 3) % S; if (blockIdx.x < 8) tq = blockIdx.x * 40;
    const size_t tokb = (size_t)b * S;
    const bf16_t* QI = (const bf16_t*)(p.ws + WS_QI); const bf16_t* KI = (const bf16_t*)(p.ws + WS_KI); const float* WI = (const float*)(p.ws + WS_WI);
    if (threadIdx.x == 0) nbad = 0;
    for (int s = threadIdx.x; s <= tq; s += 512) {
        float tot = 0.f;
        for (int hd = 0; hd < 8; ++hd) { float dsum = 0.f; for (int d = 0; d < 64; ++d) dsum += bfv(QI, (tokb + tq) * 512 + hd * 64 + d) * bfv(KI, (tokb + s) * 64 + d); tot += WI[(tokb + tq) * 8 + hd] * fmaxf(dsum, 0.f); }
        sc[s] = tot;
    }
    __syncthreads();
    int bad = 0;
    for (int s = threadIdx.x; s < S; s += 512) {
        bool sel = false;
        if (s <= tq) { const float v = sc[s]; int rank = 0; for (int s2 = 0; s2 <= tq; ++s2) { const float v2 = sc[s2]; rank += (v2 > v || (v2 == v && s2 < s)) ? 1 : 0; } sel = rank < 256; }
        const unsigned wmask = ((const unsigned*)(p.ws + WS_MASK))[(tokb + tq) * 256 + (s >> 5)];
        if (((wmask >> (s & 31)) & 1u) != (sel ? 1u : 0u)) ++bad;
    }
    atomicAdd(&nbad, bad);
    __syncthreads();
    if (threadIdx.x == 0 && nbad > 6) atomicAdd(DIAG(p) + 4, 1u);
}
__global__ void chk_attn(Params p) {
    const unsigned id = blockIdx.x * blockDim.x + threadIdx.x;
    const unsigned h = hash32(id * 19u + 11u);
    const int t = h % T, b = t / S, tq = t % S, head = (h >> 20) & 7, d = (h >> 24) & 63;
    const size_t tokb = (size_t)b * S;
    const bf16_t* Q = (const bf16_t*)(p.ws + WS_Q); const bf16_t* K = (const bf16_t*)(p.ws + WS_K); const bf16_t* VT = (const bf16_t*)(p.ws + WS_VT);
    const unsigned* M = (const unsigned*)(p.ws + WS_MASK) + (size_t)t * 256;
    float mx = -1e30f;
    for (int s = 0; s <= tq; ++s) if ((M[s >> 5] >> (s & 31)) & 1u) { float lg = 0.f; for (int e = 0; e < 64; ++e) lg += bfv(Q, (size_t)t * 512 + head * 64 + e) * bfv(K, (tokb + s) * 512 + head * 64 + e); mx = fmaxf(mx, lg); }
    float den = 0.f, num = 0.f;
    for (int s = 0; s <= tq; ++s) if ((M[s >> 5] >> (s & 31)) & 1u) { float lg = 0.f; for (int e = 0; e < 64; ++e) lg += bfv(Q, (size_t)t * 512 + head * 64 + e) * bfv(K, (tokb + s) * 512 + head * 64 + e); const float pe = expf(lg - mx); den += pe; num += pe * bfv(VT, ((size_t)(b * 8 + head) * 64 + d) * S + s); }
    const float ref = num / den;
    if (badrel(bfv((const bf16_t*)(p.ws + WS_H), (size_t)t * D + 512 + head * 64 + d), ref, 3e-2f, 1e-2f)) atomicAdd(DIAG(p) + 5, 1u);
}
__global__ void chk_out(Params p, int l, const float* xin) {
    const unsigned id = blockIdx.x * blockDim.x + threadIdx.x;
    const unsigned h = hash32(id * 23u + 13u);
    const int t = h % T, b = t / S, n = hash32(h) % D;
    const bf16_t* mrow = (const bf16_t*)(p.ws + WS_H) + (size_t)t * D;
    float s = 0.f; for (int k = 0; k < D; ++k) s += bfv(mrow, k) * p.w_out[((size_t)l * D + k) * D + n];
    const float g1 = ((const float*)(p.ws + WS_MOD))[((size_t)l * NB + b) * 6144 + 2048 + n];
    const float ref = xin[(size_t)t * D + n] + g1 * s;
    if (badrel(p.out[(size_t)t * D + n], ref, 1e-2f, 1e-2f)) atomicAdd(DIAG(p) + 6, 1u);
}
__global__ void chk_q(Params p, int l) {
    const unsigned id = blockIdx.x * blockDim.x + threadIdx.x;
    const unsigned h = hash32(id * 29u + 17u);
    const int t = h % T, n = hash32(h) % 2048;
    const bf16_t* hrow = (const bf16_t*)(p.ws + WS_H) + (size_t)t * D;
    const float ref = dot_h_w(hrow, p.w_query + (size_t)l * D * 2048, 2048, n);
    if (badrel(bfv((const bf16_t*)(p.ws + WS_QP), (size_t)t * 2048 + n), ref, 2e-2f, 3e-2f)) atomicAdd(DIAG(p) + 8, 1u);
}
__global__ void __launch_bounds__(64) chk_sel(Params p, int l) {
    __shared__ float tv[2][16][64]; __shared__ int ti[2][16][64]; __shared__ float cv[16][64]; __shared__ int cid[16][64];
    const int x = threadIdx.x;
    const unsigned id = blockIdx.x * blockDim.x + threadIdx.x;
    const unsigned h = hash32(id * 31u + 19u);
    const int t = h % T, head = (h >> 20) & 7;
    const bf16_t* QP = (const bf16_t*)(p.ws + WS_QP);
    for (int pp = 0; pp < 2; ++pp) {
        for (int i = 0; i < 16; ++i) { tv[pp][i][x] = -1e30f; ti[pp][i][x] = -1; }
        for (int n = 0; n < 128; ++n) {
            float s = 0.f; for (int d = 0; d < 128; ++d) s += bfv(QP, (size_t)t * 2048 + (head * 2 + pp) * 128 + d) * p.sub_keys[((((size_t)l * 8 + head) * 2 + pp) * 128 + n) * 128 + d];
            int pos = 16; for (int i = 15; i >= 0; --i) if (s > tv[pp][i][x]) pos = i;
            for (int i = 15; i > pos; --i) { tv[pp][i][x] = tv[pp][i - 1][x]; ti[pp][i][x] = ti[pp][i - 1][x]; }
            if (pos < 16) { tv[pp][pos][x] = s; ti[pp][pos][x] = n; }
        }
    }
    for (int i = 0; i < 16; ++i) { cv[i][x] = -1e30f; cid[i][x] = -1; }
    for (int i = 0; i < 16; ++i) for (int j = 0; j < 16; ++j) {
        const float s = tv[0][i][x] + tv[1][j][x];
        int pos = 16; for (int q = 15; q >= 0; --q) if (s > cv[q][x]) pos = q;
        for (int q = 15; q > pos; --q) { cv[q][x] = cv[q - 1][x]; cid[q][x] = cid[q - 1][x]; }
        if (pos < 16) { cv[pos][x] = s; cid[pos][x] = ti[0][i][x] * 128 + ti[1][j][x]; }
    }
    float den = 0.f; for (int i = 0; i < 16; ++i) den += expf(cv[i][x] - cv[0][x]);
    const unsigned* PI = (const unsigned*)(p.ws + WS_PIDX) + (size_t)t * 128 + head * 16; const float* PGp = (const float*)(p.ws + WS_PG) + (size_t)t * 128 + head * 16;
    int miss = 0;
    for (int i = 0; i < 16; ++i) {
        const float g = expf(cv[i][x] - cv[0][x]) / den; bool found = false;
        for (int q = 0; q < 16; ++q) if ((int)PI[q] == cid[i][x]) { found = true; if (badrel(PGp[q], g, 5e-2f, 2e-3f)) ++miss; }
        if (!found) ++miss;
    }
    if (miss > 2) atomicAdd(DIAG(p) + 9, 1u);
}
__global__ void chk_gather(Params p, int l) {
    const unsigned id = blockIdx.x * blockDim.x + threadIdx.x;
    const unsigned h = hash32(id * 37u + 23u);
    const int t = h % T, b = t / S, n = hash32(h) % D;
    const bf16_t* hrow = (const bf16_t*)(p.ws + WS_H) + (size_t)t * D;
    const unsigned* PI = (const unsigned*)(p.ws + WS_PIDX) + (size_t)t * 128; const float* PGp = (const float*)(p.ws + WS_PG) + (size_t)t * 128;
    float o = 0.f;
    for (int e = 0; e < 128; ++e) {
        const size_t ex = (size_t)l * NEXP + PI[e];
        float a = 0.f; for (int k = 0; k < D; ++k) a += bfv(hrow, k) * p.expert_u[ex * D + k];
        const float act = PGp[e] * 0.5f * a * (1.f + erff(a * 0.70710678f));
        o += act * p.expert_v[ex * D + n];
    }
    const float g2 = ((const float*)(p.ws + WS_MOD))[((size_t)l * NB + b) * 6144 + 5 * 1024 + n];
    const float ref = ((const float*)(p.ws + WS_XCOPY))[(size_t)t * D + n] + g2 * o;
    if (badrel(p.out[(size_t)t * D + n], ref, 1e-2f, 1e-2f)) atomicAdd(DIAG(p) + 10, 1u);
}
__global__ void chk_fill(Params p, int s0) {
    const unsigned* dg = DIAG(p);
    const unsigned total[11] = {4096, 4096, 4096, 4096, 64, 1024, 4096, 4096, 4096, 1024, 512};
    float E = 0.f;
    for (int i = 0; i < 5; ++i) { const int sl = s0 + i; if (sl < 11 && dg[sl] * 50u > total[sl]) E += (float)(1 << i); }
    const size_t n = (size_t)T * D, stride = (size_t)gridDim.x * blockDim.x;
    for (size_t i = (size_t)blockIdx.x * blockDim.x + threadIdx.x; i < n; i += stride) p.out[i] = E;
}
#endif

#ifndef MK_FP6TEST
#define MK_FP6TEST 0
#endif
#if MK_FP6TEST
__global__ void fp6_test(float* out, unsigned* scratch) {
    const int t = threadIdx.x;
    v16f_t a, b;
#pragma unroll
    for (int i = 0; i < 16; ++i) { a[i] = (float)(i - 16) * 0.25f; b[i] = (float)i * 0.25f; }
    const v6u_t e1 = __builtin_amdgcn_cvt_scalef32_2xpk16_fp6_f32(a, b, 1.0f);
    const v32f_t d1 = __builtin_amdgcn_cvt_scalef32_pk32_f32_fp6(e1, 1.0f);
    bool ok_order = true, ok_inter = true;
#pragma unroll
    for (int i = 0; i < 16; ++i) { ok_order = ok_order && d1[i] == a[i] && d1[16 + i] == b[i]; ok_inter = ok_inter && d1[2 * i] == a[i] && d1[2 * i + 1] == b[i]; }
    const v32f_t d2 = __builtin_amdgcn_cvt_scalef32_pk32_f32_fp6(e1, 2.0f);
    bool dec_mul = true, dec_div = true;
#pragma unroll
    for (int i = 0; i < 32; ++i) { dec_mul = dec_mul && d2[i] == 2.0f * d1[i]; dec_div = dec_div && d2[i] == 0.5f * d1[i]; }
    v16f_t a2, b2;
#pragma unroll
    for (int i = 0; i < 16; ++i) { a2[i] = a[i] * 0.5f; b2[i] = b[i] * 0.5f; }
    const v6u_t e2 = __builtin_amdgcn_cvt_scalef32_2xpk16_fp6_f32(a2, b2, 0.5f);
    const v6u_t e3 = __builtin_amdgcn_cvt_scalef32_2xpk16_fp6_f32(a2, b2, 2.0f);
    bool enc_div = true, enc_mul = true;
#pragma unroll
    for (int i = 0; i < 6; ++i) { enc_div = enc_div && e2[i] == e1[i]; enc_mul = enc_mul && e3[i] == e1[i]; }
    const bool low0 = ((e1[0] & 63u) == 0x30u  );
    float E = 0.f;
    E += ok_order ? 1.f : 0.f; E += ok_inter ? 2.f : 0.f; E += dec_mul ? 4.f : 0.f; E += dec_div ? 8.f : 0.f; E += enc_div ? 16.f : 0.f; E += enc_mul ? 32.f : 0.f; E += low0 ? 64.f : 0.f;
    const size_t n = (size_t)T * D, stride = (size_t)gridDim.x * blockDim.x;
    for (size_t i = (size_t)blockIdx.x * blockDim.x + t; i < n; i += stride) out[i] = E;
    (void)scratch;
}
#endif

#ifndef MK_TRUNC
#define MK_TRUNC 0
#endif
#if MK_TRUNC
__global__ void __launch_bounds__(256) dump_kernel(Params p, int which) {
    unsigned char* ws = p.ws;
    const size_t n = (size_t)T * D, stride = (size_t)gridDim.x * 256;
    for (size_t i = (size_t)blockIdx.x * 256 + threadIdx.x; i < n; i += stride) {
        const size_t t = i / D; const int c = (int)(i % D);
        float v = 0.f;
        if (which == 2) {
            const bf16_t* xp = (const bf16_t*)(ws + WS_XP); const bf16_t* q = (const bf16_t*)(ws + WS_Q); const bf16_t* k = (const bf16_t*)(ws + WS_K); const bf16_t* vt = (const bf16_t*)(ws + WS_VT);
            const bf16_t* qi = (const bf16_t*)(ws + WS_QI); const bf16_t* ki = (const bf16_t*)(ws + WS_KI); const float* wi = (const float*)(ws + WS_WI);
            const int cc = c & 511;
            v = bf_lo(xp[t * 512 + cc]) + bf_lo(q[t * 512 + cc]) + bf_lo(k[t * 512 + cc]) + bf_lo(vt[t * 512 + cc]) + bf_lo(qi[t * 512 + cc]) + bf_lo(ki[t * 64 + (cc & 63)]) + wi[t * 8 + (cc & 7)];
        } else if (which == 3) {
            const unsigned* m = (const unsigned*)(ws + WS_MASK); const bf16_t* hb = (const bf16_t*)(ws + WS_H);
            v = (float)(m[t * 256 + (c & 255)] & 0xffffu) + (float)(m[t * 256 + (c & 255)] >> 16) + bf_lo(hb[t * D + (c & 511)]);
        } else if (which == 4) {
            const bf16_t* hb = (const bf16_t*)(ws + WS_H); v = bf_lo(hb[t * D + c]);
        } else if (which == 7) {
            const bf16_t* qp = (const bf16_t*)(ws + WS_QP); v = bf_lo(qp[t * 2048 + c]) + bf_lo(qp[t * 2048 + 1024 + c]);
        } else if (which == 8) {
            const unsigned* pi = (const unsigned*)(ws + WS_PIDX); const float* pg = (const float*)(ws + WS_PG);
            v = (float)pi[t * 128 + (c & 127)] + pg[t * 128 + (c & 127)];
        }
        p.out[i] = v;
    }
}
#endif

extern "C" void kernel_launch(void* const* d_in, const int* in_sizes, int n_in, void* d_out, int out_size, void* d_ws, size_t ws_size, hipStream_t stream) {
    static int grid = 0;
    if (grid == 0) {
        if (n_in != 16 || out_size != T * D || ws_size < WS_END) { fprintf(stderr, "kernel_launch: unexpected shapes (n_in %d, out %d, ws %zu)\n", n_in, out_size, ws_size); grid = -1; return; }
        int dev = 0, cus = 0, per_cu = 0;
        if (hipGetDevice(&dev) != hipSuccess || hipDeviceGetAttribute(&cus, hipDeviceAttributeMultiprocessorCount, dev) != hipSuccess) { grid = -1; return; }
        if (hipOccupancyMaxActiveBlocksPerMultiprocessor(&per_cu, (const void*)mega, NTHREADS, 0) != hipSuccess || per_cu < 1) fprintf(stderr, "kernel_launch: occupancy query says %d\n", per_cu);
        (void)hipGetLastError();
        grid = cus;
    }
    if (grid < 0) return;
    (void)hipMemsetAsync((char*)d_ws + WS_CTL, 0, 64 * 1024, stream);
#ifdef MK_DBG_CLEAR
    (void)hipMemsetAsync((char*)d_ws, 0, WS_END, stream); (void)hipMemsetAsync(d_out, 0, (size_t)T * D * 4, stream);
#endif
    Params p{};
    p.x = (const float*)d_in[0]; p.c = (const float*)d_in[1]; p.pos = (const int*)d_in[2];
    p.w_ada = (const float*)d_in[3]; p.b_ada = (const float*)d_in[4]; p.norm_mix = (const float*)d_in[5]; p.w_in = (const float*)d_in[6]; p.w_pool = (const float*)d_in[7];
    p.pool_scale = (const float*)d_in[8]; p.w_out = (const float*)d_in[9]; p.norm_ffn = (const float*)d_in[10]; p.w_query = (const float*)d_in[11]; p.sub_keys = (const float*)d_in[12];
    p.expert_u = (const float*)d_in[13]; p.expert_v = (const float*)d_in[14]; p.final_norm = (const float*)d_in[15];
    p.out = (float*)d_out; p.ws = (unsigned char*)d_ws;
#if MK_FP6TEST
    hipLaunchKernelGGL(fp6_test, dim3(1024), dim3(256), 0, stream, (float*)d_out, (unsigned*)d_ws);
#elif MK_CHECK
    {
        auto run = [&](int ph) { p.ph_lo = ph; p.ph_hi = ph + 1; hipLaunchKernelGGL(mega, dim3(grid), dim3(NTHREADS), 0, stream, p.x, p.c, p.pos, p.w_ada, p.b_ada, p.norm_mix, p.w_in, p.w_pool, p.pool_scale, p.w_out, p.norm_ffn, p.w_query, p.sub_keys, p.expert_u, p.expert_v, p.final_norm, p.out, p.ws, p.ph_lo, p.ph_hi); };
        const int L = MK_CHECK_LAYER; const int pb = 1 + 9 * L;
        for (int ph = 0; ph < pb; ++ph) run(ph);
        const float* xin = (L == 0) ? p.x : p.out;
        hipLaunchKernelGGL(chk_mod, dim3(16), dim3(256), 0, stream, p);
        run(pb + 0); hipLaunchKernelGGL(chk_norm, dim3(4), dim3(256), 0, stream, p, L, 0, xin, 1);
        run(pb + 1); hipLaunchKernelGGL(chk_in, dim3(16), dim3(256), 0, stream, p, L);
        run(pb + 2); hipLaunchKernelGGL(chk_pool, dim3(16), dim3(256), 0, stream, p, L); hipLaunchKernelGGL(chk_topk, dim3(64), dim3(512), 0, stream, p);
        run(pb + 3); hipLaunchKernelGGL(chk_attn, dim3(4), dim3(256), 0, stream, p);
        if (L == 1) (void)hipMemcpyAsync((char*)d_ws + WS_XCOPY, d_out, (size_t)T * D * 4, hipMemcpyDeviceToDevice, stream);
        run(pb + 4); hipLaunchKernelGGL(chk_out, dim3(16), dim3(256), 0, stream, p, L, (L == 0) ? p.x : (const float*)((char*)d_ws + WS_XCOPY));
        run(pb + 5); hipLaunchKernelGGL(chk_norm, dim3(4), dim3(256), 0, stream, p, L, 1, (const float*)p.out, 7);
        run(pb + 6); hipLaunchKernelGGL(chk_q, dim3(16), dim3(256), 0, stream, p, L);
        run(pb + 7); hipLaunchKernelGGL(chk_sel, dim3(16), dim3(64), 0, stream, p, L);
        (void)hipMemcpyAsync((char*)d_ws + WS_XCOPY, d_out, (size_t)T * D * 4, hipMemcpyDeviceToDevice, stream);
        run(pb + 8); hipLaunchKernelGGL(chk_gather, dim3(2), dim3(256), 0, stream, p, L);
        hipLaunchKernelGGL(chk_fill, dim3(2048), dim3(256), 0, stream, p, (int)MK_CHECK_SLOT0);
    }
#elif MK_TRUNC
    for (int ph = 0; ph <= MK_TRUNC; ++ph) { p.ph_lo = ph; p.ph_hi = ph + 1; hipLaunchKernelGGL(mega, dim3(grid), dim3(NTHREADS), 0, stream, p.x, p.c, p.pos, p.w_ada, p.b_ada, p.norm_mix, p.w_in, p.w_pool, p.pool_scale, p.w_out, p.norm_ffn, p.w_query, p.sub_keys, p.expert_u, p.expert_v, p.final_norm, p.out, p.ws, p.ph_lo, p.ph_hi); }
    if (MK_TRUNC != 5 && MK_TRUNC != 9) hipLaunchKernelGGL(dump_kernel, dim3(2048), dim3(256), 0, stream, p, (int)MK_TRUNC);
#elif MK_MULTI
    for (int ph = 0; ph < NPH; ++ph) { p.ph_lo = ph; p.ph_hi = ph + 1; hipLaunchKernelGGL(mega, dim3(grid), dim3(NTHREADS), 0, stream, p.x, p.c, p.pos, p.w_ada, p.b_ada, p.norm_mix, p.w_in, p.w_pool, p.pool_scale, p.w_out, p.norm_ffn, p.w_query, p.sub_keys, p.expert_u, p.expert_v, p.final_norm, p.out, p.ws, p.ph_lo, p.ph_hi); }
#else
    p.ph_lo = 0; p.ph_hi = NPH;
    hipLaunchKernelGGL(mega, dim3(grid), dim3(NTHREADS), 0, stream, p.x, p.c, p.pos, p.w_ada, p.b_ada, p.norm_mix, p.w_in, p.w_pool, p.pool_scale, p.w_out, p.norm_ffn, p.w_query, p.sub_keys, p.expert_u, p.expert_v, p.final_norm, p.out, p.ws, p.ph_lo, p.ph_hi);
#endif
    const hipError_t le = hipPeekAtLastError();
    if (le != hipSuccess) fprintf(stderr, "kernel_launch: launch failed: %s\n", hipGetErrorName(le));
}
```

```cpp
#include <hip/hip_runtime.h>
#include <stdint.h>
#include <stdio.h>

#ifndef MK_STAMP
#define MK_STAMP 0
#endif
#ifndef MK_STAMP_PH
#define MK_STAMP_PH 9
#endif
#ifndef MK_GATHER_RANGE
#define MK_GATHER_RANGE 1
#endif
#ifndef MK_DUP
#define MK_DUP 0
#endif
#ifndef MK_DUPVAR
#define MK_DUPVAR 0
#endif
#ifndef MK_MULTI
#define MK_MULTI 0
#endif

#define LAS __attribute__((address_space(3)))
typedef unsigned short bf16_t;
typedef short bf16x8 __attribute__((ext_vector_type(8)));
typedef float f32x16 __attribute__((ext_vector_type(16)));
typedef float f32x4 __attribute__((ext_vector_type(4)));
typedef float f32x2 __attribute__((ext_vector_type(2)));
typedef unsigned u32x4 __attribute__((ext_vector_type(4)));
typedef unsigned u32x2 __attribute__((ext_vector_type(2)));
typedef __bf16 bf16v2 __attribute__((ext_vector_type(2)));
typedef LAS unsigned char* lds_t;
typedef float v32f_t __attribute__((ext_vector_type(32)));
typedef float v16f_t __attribute__((ext_vector_type(16)));
typedef unsigned v6u_t __attribute__((ext_vector_type(6)));
constexpr int EROW = 768;

constexpr int D = 1024, NB = 8, S = 8192, T = NB * S, DEPTH = 2;
constexpr int NIN = 2816;
constexpr int DIN = 2632;
constexpr int NEXP = 16384;
constexpr int NTHREADS = 512;
constexpr int LDS_BYTES = 148480;

constexpr size_t MBy = 1u << 20;
constexpr size_t WS_CTL = 0;
constexpr size_t WS_MOD = 64 * 1024;
constexpr size_t WS_ROPE = 1 * MBy;
constexpr size_t WS_WIN = 5 * MBy;
constexpr size_t WS_WOUT = 16 * MBy;
constexpr size_t WS_WQ = 20 * MBy;
constexpr size_t WS_WPOOL = 28 * MBy;
constexpr size_t WS_SK = 29 * MBy;
constexpr size_t WS_EU = 30 * MBy;
constexpr size_t WS_EV = 94 * MBy;
constexpr size_t WS_H = 158 * MBy;
constexpr size_t WS_XP = 286 * MBy;
constexpr size_t WS_Q = 350 * MBy;
constexpr size_t WS_K = 414 * MBy;
constexpr size_t WS_VT = 478 * MBy;
constexpr size_t WS_QP = WS_XP;
constexpr size_t WS_QI = 542 * MBy;
constexpr size_t WS_KI = 606 * MBy;
constexpr size_t WS_WI = 614 * MBy;
constexpr size_t WS_MASK = 616 * MBy;
constexpr size_t WS_PIDX = 680 * MBy;
constexpr size_t WS_PG = 712 * MBy;
constexpr size_t WS_ES = 744 * MBy;
constexpr size_t WS_END = 745 * MBy;
constexpr int NPH = 20;

struct Params {
    const float *x, *c; const int* pos;
    const float *w_ada, *b_ada, *norm_mix, *w_in, *w_pool, *pool_scale, *w_out, *norm_ffn, *w_query, *sub_keys, *expert_u, *expert_v, *final_norm;
    float* out; unsigned char* ws; int ph_lo, ph_hi;
};

#define XB_TMO      128
#define XB_XCNT(j)  (256  + 64 * (j))
#define XB_XSUB(j)  (1280 + 64 * (j))
#define XB_XGEN(j)  (2304 + 64 * (j))
#define XB_TOP      3328
#define XB_TOPGEN   3392
#define XCD_BAR_WORDS 3456
#define XB_SPIN_CAP (1u << 22)

__device__ __forceinline__ unsigned xb_ld(unsigned* p)              { return __hip_atomic_load(p, __ATOMIC_RELAXED, __HIP_MEMORY_SCOPE_AGENT); }
__device__ __forceinline__ unsigned xb_add(unsigned* p, unsigned v) { return __hip_atomic_fetch_add(p, v, __ATOMIC_RELAXED, __HIP_MEMORY_SCOPE_AGENT); }
__device__ __forceinline__ unsigned xb_xcc_id() { return (unsigned)__builtin_amdgcn_s_getreg((3 << 11) | 20) & 0xFu; }
#define XB_SPIN(cond, bar) do { unsigned _sp = 0; while (cond) { __builtin_amdgcn_s_sleep(1); \
    if ((++_sp & 255u) == 0u) { if (xb_ld(&(bar)[XB_TMO])) break; if (_sp > XB_SPIN_CAP) { atomicAdd(&(bar)[XB_TMO], 1u); break; } } } } while (0)

struct XcdBarrier { unsigned* bar; unsigned x; volatile LAS unsigned* st; };

__device__ __forceinline__ XcdBarrier xcd_barrier_post(unsigned* bar, volatile LAS unsigned* st) {
    XcdBarrier b; b.bar = bar; b.x = xb_xcc_id(); b.st = st;
    if (threadIdx.x == 0) (void)xb_add(&bar[XB_XCNT(b.x)], 1u);
    return b;
}
__device__ __forceinline__ void xcd_barrier_complete(unsigned* bar, unsigned x, unsigned& nloc, unsigned& nx) {
    const unsigned G = gridDim.x * gridDim.y * gridDim.z;
    unsigned sum, cnt, mine, sp = 0u;
    for (;;) {
        sum = 0u; cnt = 0u; mine = 0u;
#pragma unroll
        for (unsigned j = 0; j < 16; ++j) { const unsigned c = xb_ld(&bar[XB_XCNT(j)]); sum += c; cnt += (c > 0u) ? 1u : 0u; mine = (j == x) ? c : mine; }
        if (sum == G) break;
        __builtin_amdgcn_s_sleep(1);
        if ((++sp & 255u) == 0u) { if (xb_ld(&bar[XB_TMO])) break; if (sp > XB_SPIN_CAP) { atomicAdd(&bar[XB_TMO], 1u); break; } }
    }
    nloc = mine > 0u ? mine : 1u; nx = cnt > 0u ? cnt : 1u;
}
__device__ __forceinline__ void xcd_barrier(const XcdBarrier& b) {
    asm volatile("s_waitcnt vmcnt(0)" ::: "memory");
    __syncthreads();
    if (threadIdx.x == 0) {
        unsigned* bar = b.bar;
        __builtin_amdgcn_s_waitcnt(0);
        unsigned nloc = b.st[0], nx = b.st[1];
        if (nloc == 0u) { xcd_barrier_complete(bar, b.x, nloc, nx); b.st[0] = nloc; b.st[1] = nx; }
        const unsigned old = xb_add(&bar[XB_XSUB(b.x)], 1u);
        const unsigned gen = old / nloc;
        if (old + 1u == (gen + 1u) * nloc) {
            __builtin_amdgcn_fence(__ATOMIC_RELEASE, "agent");
            asm volatile("s_waitcnt vmcnt(0)" ::: "memory");
            const unsigned og = xb_add(&bar[XB_TOP], 1u);
            const unsigned tg = og / nx;
            if (og + 1u == (tg + 1u) * nx) xb_add(&bar[XB_TOPGEN], 1u);
            else XB_SPIN(xb_ld(&bar[XB_TOPGEN]) == tg, bar);
            __builtin_amdgcn_fence(__ATOMIC_ACQUIRE, "agent");
            xb_add(&bar[XB_XGEN(b.x)], 1u);
            asm volatile("s_waitcnt vmcnt(0)" ::: "memory");
        } else {
            XB_SPIN(xb_ld(&bar[XB_XGEN(b.x)]) == gen, bar);
            __builtin_amdgcn_fence(__ATOMIC_ACQUIRE, "agent");
            asm volatile("s_waitcnt vmcnt(0)" ::: "memory");
        }
    }
    __syncthreads();
}

#define MFMA32(a, b, c) __builtin_amdgcn_mfma_f32_32x32x16_bf16((a), (b), (c), 0, 0, 0)
__device__ __forceinline__ unsigned pk_bf16(float lo, float hi) { const f32x2 v = {lo, hi}; return __builtin_bit_cast(unsigned, __builtin_convertvector(v, bf16v2)); }
__device__ __forceinline__ float dot2bf(unsigned a, unsigned b, float c) { return __builtin_amdgcn_fdot2_f32_bf16(__builtin_bit_cast(bf16v2, a), __builtin_bit_cast(bf16v2, b), c, false); }
__device__ __forceinline__ float bf_lo(unsigned u) { return __uint_as_float(u << 16); }
__device__ __forceinline__ float bf_hi(unsigned u) { return __uint_as_float(u & 0xffff0000u); }
__device__ __forceinline__ float wave_sum(float v) {
#pragma unroll
    for (int o = 32; o > 0; o >>= 1) v += __shfl_xor(v, o);
    return v;
}
__device__ __forceinline__ int otid() { int t = threadIdx.x; asm volatile("" : "+v"(t)); return t; }
__device__ __forceinline__ void lds_fence() { asm volatile("s_waitcnt lgkmcnt(0)" ::: "memory"); }

__device__ __forceinline__ void transpose_tile(const float* __restrict__ src, int ldsrc, int Nvalid, bf16_t* __restrict__ dst, int lddst, int k0, int n0, lds_t lds) {
    LAS float* tile = (LAS float*)lds;
    const int tid = otid();
    {
        const int r = tid >> 6, c = tid & 63, n = n0 + c;
#pragma unroll
        for (int i = 0; i < 8; ++i) { const int k = r + 8 * i; tile[k * 65 + c] = (n < Nvalid) ? src[(size_t)(k0 + k) * ldsrc + n] : 0.f; }
    }
    __syncthreads();
    {
        const int nn = tid >> 3, kc = tid & 7;
        float v[8];
#pragma unroll
        for (int j = 0; j < 8; ++j) v[j] = tile[(kc * 8 + j) * 65 + nn];
        u32x4 w; w.x = pk_bf16(v[0], v[1]); w.y = pk_bf16(v[2], v[3]); w.z = pk_bf16(v[4], v[5]); w.w = pk_bf16(v[6], v[7]);
        *(u32x4*)(dst + (size_t)(n0 + nn) * lddst + k0 + kc * 8) = w;
    }
    __syncthreads();
}

__device__ __forceinline__ void convert_bf16(const float* __restrict__ src, bf16_t* __restrict__ dst, size_t n8) {
    const size_t stride = (size_t)gridDim.x * NTHREADS;
    for (size_t i = (size_t)blockIdx.x * NTHREADS + otid(); i < n8; i += stride) {
        const f32x4 a = *(const f32x4*)(src + i * 8), b = *(const f32x4*)(src + i * 8 + 4);
        u32x4 w; w.x = pk_bf16(a[0], a[1]); w.y = pk_bf16(a[2], a[3]); w.z = pk_bf16(b[0], b[1]); w.w = pk_bf16(b[2], b[3]);
        *(u32x4*)(dst + i * 8) = w;
    }
}

__device__ __forceinline__ void sincos_d(double a, float& sn, float& cs) {
    const double kq = rint(a * 0.63661977236758134308);
    double r = fma(-kq, 1.57079632679489655800e+00, a);
    r = fma(-kq, 6.12323399573676603587e-17, r);
    const int q = ((int)kq) & 3;
    const double r2 = r * r;
    double sp = -7.647163731819816476e-13;
    sp = fma(sp, r2, 1.605904383682161460e-10);
    sp = fma(sp, r2, -2.505210838544171878e-08);
    sp = fma(sp, r2, 2.755731922398589065e-06);
    sp = fma(sp, r2, -1.984126984126984127e-04);
    sp = fma(sp, r2, 8.333333333333333333e-03);
    sp = fma(sp, r2, -1.666666666666666667e-01);
    const double s = fma(sp * r2, r, r);
    double cp = 4.779477332387385297e-14;
    cp = fma(cp, r2, -1.147074559772972471e-11);
    cp = fma(cp, r2, 2.087675698786809898e-09);
    cp = fma(cp, r2, -2.755731922398589065e-07);
    cp = fma(cp, r2, 2.480158730158730159e-05);
    cp = fma(cp, r2, -1.388888888888888889e-03);
    cp = fma(cp, r2, 4.166666666666666667e-02);
    cp = fma(cp, r2, -0.5);
    const double c = fma(cp, r2, 1.0);
    const double ss = (q & 1) ? c : s, cc = (q & 1) ? s : c;
    sn = (float)((q & 2) ? -ss : ss);
    cs = (float)(((q + 1) & 2) ? -cc : cc);
}

__device__ __forceinline__ void phase_prologue(const Params& p, lds_t lds) {
    const int tid = otid(), bid = blockIdx.x, G = gridDim.x;
    unsigned char* ws = p.ws;
    {
        const int J_IN = 16 * 44, J_OUT = 16 * 16, J_Q = 16 * 32, J_P = 4;
        const int total = 2 * (J_IN + J_OUT + J_Q) + 8 * J_P;
        for (int j = bid; j < total; j += G) {
            int r = j;
            if (r < 2 * J_IN) { const int l = r / J_IN, t = r % J_IN; transpose_tile(p.w_in + (size_t)l * D * DIN, DIN, DIN, (bf16_t*)(ws + WS_WIN) + (size_t)l * NIN * D, D, (t / 44) * 64, (t % 44) * 64, lds); continue; }
            r -= 2 * J_IN;
            if (r < 2 * J_OUT) { const int l = r / J_OUT, t = r % J_OUT; transpose_tile(p.w_out + (size_t)l * D * D, D, D, (bf16_t*)(ws + WS_WOUT) + (size_t)l * D * D, D, (t / 16) * 64, (t % 16) * 64, lds); continue; }
            r -= 2 * J_OUT;
            if (r < 2 * J_Q) { const int l = r / J_Q, t = r % J_Q; transpose_tile(p.w_query + (size_t)l * D * 2048, 2048, 2048, (bf16_t*)(ws + WS_WQ) + (size_t)l * 2048 * D, D, (t / 32) * 64, (t % 32) * 64, lds); continue; }
            r -= 2 * J_Q;
            { const int m = r / J_P, t = r % J_P; transpose_tile(p.w_pool + (size_t)m * 128 * 128, 128, 128, (bf16_t*)(ws + WS_WPOOL) + (size_t)m * 128 * 128, 128, (t / 2) * 64, (t % 2) * 64, lds); }
        }
    }
    {
        const int lane = tid & 63, wid = tid >> 6, nw = G * 8, l5 = lane & 31, hf = lane >> 5;
        for (int r2 = bid * 8 + wid; r2 < DEPTH * NEXP; r2 += nw) {
            const int tab = r2 / (DEPTH * NEXP / 2), row = (r2 % (DEPTH * NEXP / 2)) * 2 + hf;
            const float* src = (tab ? p.expert_v : p.expert_u) + (size_t)row * D + l5 * 32;
            f32x4 v[8]; float am = 0.f;
#pragma unroll
            for (int i = 0; i < 8; ++i) { v[i] = *(const f32x4*)(src + 4 * i); am = fmaxf(am, fmaxf(fmaxf(fabsf(v[i][0]), fabsf(v[i][1])), fmaxf(fabsf(v[i][2]), fabsf(v[i][3])))); }
#pragma unroll
            for (int o = 16; o > 0; o >>= 1) am = fmaxf(am, __shfl_xor(am, o));
            const unsigned ab = __float_as_uint(am), eb = (ab >> 23) & 255u, mant = ab & 0x7fffffu;
            const bool ok = eb >= 8u && eb <= 250u;
            const unsigned se = (mant <= 0x700000u) ? eb - 2u : eb - 1u;
            const float sc = ok ? __uint_as_float(se << 23) : 1.0f;
            v16f_t ea, eo;
#pragma unroll
            for (int i = 0; i < 8; ++i) { ea[2 * i] = v[i][0]; eo[2 * i] = v[i][1]; ea[2 * i + 1] = v[i][2]; eo[2 * i + 1] = v[i][3]; }
            const v6u_t pk = __builtin_amdgcn_cvt_scalef32_2xpk16_fp6_f32(ea, eo, sc);
            unsigned char* dst = ws + (tab ? WS_EV : WS_EU) + (size_t)row * EROW + l5 * 24;
            *(u32x2*)(dst) = (u32x2){pk[0], pk[1]}; *(u32x2*)(dst + 8) = (u32x2){pk[2], pk[3]}; *(u32x2*)(dst + 16) = (u32x2){pk[4], pk[5]};
            if (l5 == 0) ((float*)(ws + WS_ES))[(size_t)row * 2 + tab] = sc;
        }
    }
    convert_bf16(p.sub_keys, (bf16_t*)(ws + WS_SK), (size_t)DEPTH * 16 * 128 * 128 / 8);
    {
        LAS float* sc = (LAS float*)lds;
        LAS float* part = (LAS float*)(lds + 32768);
        for (int i = tid; i < NB * D; i += NTHREADS) { const float v = p.c[i]; sc[i] = v / (1.f + __expf(-v)); }
        __syncthreads();
        const int lane = tid & 63, wid = tid >> 6;
        for (int j = bid; j < DEPTH * 96; j += G) {
            const int l = j / 96, col = (j % 96) * 64 + lane;
            const float* wp = p.w_ada + (size_t)l * D * 6144 + col;
            float a[8] = {0.f, 0.f, 0.f, 0.f, 0.f, 0.f, 0.f, 0.f};
            for (int k = wid * 128; k < wid * 128 + 128; ++k) {
                const float w = wp[(size_t)k * 6144];
#pragma unroll
                for (int b = 0; b < 8; ++b) a[b] = fmaf(sc[b * D + k], w, a[b]);
            }
#pragma unroll
            for (int b = 0; b < 8; ++b) part[(wid * 8 + b) * 64 + lane] = a[b];
            __syncthreads();
            {
                const int b = tid >> 6;
                float s = 0.f;
#pragma unroll
                for (int w = 0; w < 8; ++w) s += part[(w * 8 + b) * 64 + lane];
                ((float*)(ws + WS_MOD))[((size_t)l * NB + b) * 6144 + col] = s + p.b_ada[(size_t)l * 6144 + col];
            }
            __syncthreads();
        }
    }
    {
        const float inv[8] = {1.0f, 0.1939227432012558f, 0.03760603070259094f, 0.007292664609849453f, 0.0014142135623842478f, 0.00027424818836152554f, 5.318296098266728e-05f, 1.0313386155758053e-05f};
        const size_t stride = (size_t)G * NTHREADS;
        for (size_t i = (size_t)bid * NTHREADS + tid; i < (size_t)T * 8; i += stride) {
            const int t = (int)(i >> 3), f = (int)(i & 7);
            float iv = inv[0];
#pragma unroll
            for (int q = 1; q < 8; ++q) iv = (f == q) ? inv[q] : iv;
            const float ang = (float)p.pos[t] * iv;
            float sn, cs; sincos_d((double)ang, sn, cs);
            float* rp = (float*)(ws + WS_ROPE) + (size_t)t * 16;
            rp[f] = cs; rp[8 + f] = sn;
        }
    }
}

template <int MODE>
__device__ __forceinline__ void phase_norm(const float* xin, const float* __restrict__ gw, const float* __restrict__ sh, const float* __restrict__ scl, bf16_t* hout, float* fout) {
    const int tid = otid(), lane = tid & 63, wid = tid >> 6;
    const int nw = gridDim.x * 8;
    for (int gwv = blockIdx.x * 8 + wid; gwv * 32 < T; gwv += nw) {
        const int row0 = gwv * 32, b = row0 / S;
        f32x4 g4[4], a4[4], s4[4];
#pragma unroll
        for (int i = 0; i < 4; ++i) {
            const int col = 4 * lane + 256 * i;
            g4[i] = *(const f32x4*)(gw + col);
            if (MODE == 0) { a4[i] = *(const f32x4*)(scl + (size_t)b * 6144 + col) + 1.0f; s4[i] = *(const f32x4*)(sh + (size_t)b * 6144 + col); }
        }
        for (int r = 0; r < 32; ++r) {
            const float* xr = xin + (size_t)(row0 + r) * D;
            f32x4 v[4]; float ss = 0.f;
#pragma unroll
            for (int i = 0; i < 4; ++i) { v[i] = *(const f32x4*)(xr + 4 * lane + 256 * i); ss += v[i][0] * v[i][0] + v[i][1] * v[i][1] + v[i][2] * v[i][2] + v[i][3] * v[i][3]; }
            ss = wave_sum(ss);
            const float rstd = rsqrtf(ss * (1.0f / D) + 1e-6f);
            int ozn = 0; asm volatile("" : "+v"(ozn));
#pragma unroll
            for (int i = 0; i < 4; ++i) {
                f32x4 y = v[i] * rstd * g4[i];
                if (MODE == 0) {
                    y = y * a4[i] + s4[i];
                    u32x2 w; w.x = pk_bf16(y[0], y[1]); w.y = pk_bf16(y[2], y[3]);
                    *(u32x2*)(hout + (size_t)(row0 + r) * D + 4 * lane + 256 * i) = w;
                } else {
                    *(f32x4*)(fout + (size_t)(row0 + r) * D + 4 * lane + 256 * i) = y;
                }
            }
        }
    }
}
constexpr int GROW = 144;
constexpr int GTILE = 256 * GROW;

__device__ __forceinline__ bool tile_order(int i, int N, int& pm, int& pn) {
    const int nM = T / 256, nN = N / 256, nwg = nM * nN, G = gridDim.x;
    const long L = (long)i * G + blockIdx.x; if (L >= nwg) return false;
    int wgid = (int)L; { const int q = nwg / 8, r = nwg % 8, xcd = wgid % 8, off = wgid / 8; wgid = (xcd < r ? xcd * (q + 1) : r * (q + 1) + (xcd - r) * q) + off; }
    const int nig = 8 * nN, gid = wgid / nig, fm = gid * 8, gsz = (nM - fm) < 8 ? (nM - fm) : 8;
    pm = fm + ((wgid % nig) % gsz); pn = (wgid % nig) / gsz; return true;
}

template <int MODE = 0, class Epi>
__device__ __forceinline__ void gemm_phase(const bf16_t* __restrict__ A, const bf16_t* __restrict__ Wt, int N, const Epi& epi, lds_t lds) {
    const int tid = otid(), lane = tid & 63, wid = tid >> 6;
    const int wr = wid >> 2, wc = wid & 3, l31 = lane & 31, hh = lane >> 5;
    const int srow = tid >> 3, scc = tid & 7;
    int pm, pn;
    for (int it = 0; tile_order(it, N, pm, pn); ++it) {
        const bf16_t* Ag = A + (size_t)(pm * 256 + srow) * D + scc * 8;
        const bf16_t* Wg = Wt + (size_t)(pn * 256 + srow) * D + scc * 8;
        f32x16 acc[2][4];
#pragma unroll
        for (int a = 0; a < 2; ++a)
#pragma unroll
            for (int b = 0; b < 4; ++b)
#pragma unroll
                for (int r = 0; r < 16; ++r) acc[a][b][r] = 0.f;
        u32x4 ra[4], rw[4];
#pragma unroll
        for (int i = 0; i < 4; ++i) { ra[i] = *(const u32x4*)(Ag + (size_t)i * 64 * D); rw[i] = *(const u32x4*)(Wg + (size_t)i * 64 * D); }
#pragma unroll
        for (int i = 0; i < 4; ++i) { *(LAS u32x4*)(lds + (srow + 64 * i) * GROW + scc * 16) = ra[i]; *(LAS u32x4*)(lds + GTILE + (srow + 64 * i) * GROW + scc * 16) = rw[i]; }
#pragma unroll
        for (int i = 0; i < 4; ++i) { ra[i] = *(const u32x4*)(Ag + (size_t)i * 64 * D + 64); rw[i] = *(const u32x4*)(Wg + (size_t)i * 64 * D + 64); }
        __syncthreads();
        for (int kt = 0; kt < 16; ++kt) {
#pragma unroll
            for (int half = 0; half < 2; ++half) {
                if (wr == half) {
                    const lds_t sb = lds + (kt & 1) * 2 * GTILE;
#pragma unroll
                    for (int ks = 0; ks < 4; ++ks) {
                        bf16x8 af[4], wf[2];
#pragma unroll
                        for (int tt = 0; tt < 4; ++tt) af[tt] = *(LAS bf16x8*)(sb + (wr * 128 + tt * 32 + l31) * GROW + (ks * 2 + hh) * 16);
#pragma unroll
                        for (int nt = 0; nt < 2; ++nt) wf[nt] = *(LAS bf16x8*)(sb + GTILE + (wc * 64 + nt * 32 + l31) * GROW + (ks * 2 + hh) * 16);
#pragma unroll
                        for (int nt = 0; nt < 2; ++nt)
#pragma unroll
                            for (int tt = 0; tt < 4; ++tt) acc[nt][tt] = MFMA32(wf[nt], af[tt], acc[nt][tt]);
                    }
                } else {
                    if (kt + 1 < 16) {
                        const lds_t nb = lds + ((kt + 1) & 1) * 2 * GTILE;
#pragma unroll
                        for (int i = 0; i < 4; ++i) { *(LAS u32x4*)(nb + (srow + 64 * i) * GROW + scc * 16) = ra[i]; *(LAS u32x4*)(nb + GTILE + (srow + 64 * i) * GROW + scc * 16) = rw[i]; }
                    }
                    if (kt + 2 < 16) {
#pragma unroll
                        for (int i = 0; i < 4; ++i) { ra[i] = *(const u32x4*)(Ag + (size_t)i * 64 * D + (kt + 2) * 64); rw[i] = *(const u32x4*)(Wg + (size_t)i * 64 * D + (kt + 2) * 64); }
                    }
                }
                __syncthreads();
            }
        }
        epi(acc, pm, pn, wr, wc, l31, hh);
    }
}

struct EpiIn {
    bf16_t *xp, *q, *k, *vt, *qi, *ki; float* wi; const float* rope;
    __device__ __forceinline__ void operator()(const f32x16 (&acc)[2][4], int pm, int pn, int wr, int wc, int l31, int hh) const {
        const int seg = pn >> 1;
        const int cb = (pn & 1) * 256 + wc * 64;
#pragma unroll
        for (int tt = 0; tt < 4; ++tt) {
            const int t = pm * 256 + wr * 128 + tt * 32 + l31;
            if (seg == 0) {
#pragma unroll
                for (int nt = 0; nt < 2; ++nt)
#pragma unroll
                    for (int rq = 0; rq < 4; ++rq) {
                        u32x2 w; w.x = pk_bf16(acc[nt][tt][4 * rq], acc[nt][tt][4 * rq + 1]); w.y = pk_bf16(acc[nt][tt][4 * rq + 2], acc[nt][tt][4 * rq + 3]);
                        *(u32x2*)(xp + (size_t)t * 512 + cb + nt * 32 + 8 * rq + 4 * hh) = w;
                    }
            } else if (seg == 3) {
                const int b = t / S, s = t % S, head = cb >> 6;
                bf16_t* vb = vt + ((size_t)(b * 8 + head) * 64) * S + s;
#pragma unroll
                for (int nt = 0; nt < 2; ++nt)
#pragma unroll
                    for (int r = 0; r < 16; ++r) {
                        const int d = nt * 32 + (r & 3) + 8 * (r >> 2) + 4 * hh;
                        vb[(size_t)d * S] = (bf16_t)(pk_bf16(acc[nt][tt][r], 0.f) & 0xffffu);
                    }
            } else if (seg == 1 || seg == 2 || seg == 4 || (seg == 5 && wc == 0)) {
                const f32x4 cs = *(const f32x4*)(rope + (size_t)t * 16 + 4 * hh), sn = *(const f32x4*)(rope + (size_t)t * 16 + 8 + 4 * hh);
                const float scale = (seg == 1 || seg == 4) ? 0.125f : 1.0f;
                bf16_t* dst; size_t off;
                if (seg == 1) { dst = q; off = (size_t)t * 512 + cb; } else if (seg == 2) { dst = k; off = (size_t)t * 512 + cb; } else if (seg == 4) { dst = qi; off = (size_t)t * 512 + cb; } else { dst = ki; off = (size_t)t * 64; }
                float v0[16];
#pragma unroll
                for (int r = 0; r < 16; ++r) v0[r] = acc[0][tt][r];
#pragma unroll
                for (int j = 0; j < 4; ++j) { const float x1 = acc[0][tt][j], x2 = acc[0][tt][4 + j]; v0[j] = x1 * cs[j] - x2 * sn[j]; v0[4 + j] = x1 * sn[j] + x2 * cs[j]; }
#pragma unroll
                for (int rq = 0; rq < 4; ++rq) {
                    u32x2 w; w.x = pk_bf16(v0[4 * rq] * scale, v0[4 * rq + 1] * scale); w.y = pk_bf16(v0[4 * rq + 2] * scale, v0[4 * rq + 3] * scale);
                    *(u32x2*)(dst + off + 8 * rq + 4 * hh) = w;
                    u32x2 w2; w2.x = pk_bf16(acc[1][tt][4 * rq] * scale, acc[1][tt][4 * rq + 1] * scale); w2.y = pk_bf16(acc[1][tt][4 * rq + 2] * scale, acc[1][tt][4 * rq + 3] * scale);
                    *(u32x2*)(dst + off + 32 + 8 * rq + 4 * hh) = w2;
                }
            } else if (seg == 5 && wc == 1) {
                f32x4 w;
#pragma unroll
                for (int j = 0; j < 4; ++j) w[j] = acc[0][tt][j] * 0.35355339059327373f;
                *(f32x4*)(wi + (size_t)t * 8 + 4 * hh) = w;
            }
        }
    }
};

struct EpiOut {
    const float* xin; float* xout; const float* gate;
    __device__ __forceinline__ void operator()(const f32x16 (&acc)[2][4], int pm, int pn, int wr, int wc, int l31, int hh) const {
        const int b = (pm * 256) / S;
#pragma unroll
        for (int nt = 0; nt < 2; ++nt)
#pragma unroll
            for (int rq = 0; rq < 4; ++rq) {
                const int n0 = pn * 256 + wc * 64 + nt * 32 + 8 * rq + 4 * hh;
                const f32x4 g = *(const f32x4*)(gate + (size_t)b * 6144 + n0);
#pragma unroll
                for (int tt = 0; tt < 4; ++tt) {
                    const int t = pm * 256 + wr * 128 + tt * 32 + l31;
                    const f32x4 xo = *(const f32x4*)(xin + (size_t)t * D + n0);
                    f32x4 a; a[0] = acc[nt][tt][4 * rq]; a[1] = acc[nt][tt][4 * rq + 1]; a[2] = acc[nt][tt][4 * rq + 2]; a[3] = acc[nt][tt][4 * rq + 3];
                    *(f32x4*)(xout + (size_t)t * D + n0) = xo + g * a;
                }
            }
    }
};

struct EpiNull { float* sink; __device__ __forceinline__ void operator()(const f32x16 (&acc)[2][4], int pm, int pn, int wr, int wc, int l31, int hh) const { float t = 0.f;
#pragma unroll
    for (int a = 0; a < 2; ++a)
#pragma unroll
        for (int b = 0; b < 4; ++b)
#pragma unroll
            for (int r = 0; r < 16; ++r) t += acc[a][b][r];
    sink[((size_t)(pm * 11 + pn) * 512 + (wr * 4 + wc) * 64 + hh * 32 + l31)] = t; } };
struct EpiBf {
    bf16_t* C; int ldc;
    __device__ __forceinline__ void operator()(const f32x16 (&acc)[2][4], int pm, int pn, int wr, int wc, int l31, int hh) const {
#pragma unroll
        for (int tt = 0; tt < 4; ++tt) {
            const int t = pm * 256 + wr * 128 + tt * 32 + l31;
#pragma unroll
            for (int nt = 0; nt < 2; ++nt)
#pragma unroll
                for (int rq = 0; rq < 4; ++rq) {
                    u32x2 w; w.x = pk_bf16(acc[nt][tt][4 * rq], acc[nt][tt][4 * rq + 1]); w.y = pk_bf16(acc[nt][tt][4 * rq + 2], acc[nt][tt][4 * rq + 3]);
                    *(u32x2*)(C + (size_t)t * ldc + pn * 256 + wc * 64 + nt * 32 + 8 * rq + 4 * hh) = w;
                }
        }
    }
};

__device__ __forceinline__ void pool_item(int e, const bf16_t* __restrict__ xp, const bf16_t* __restrict__ wpool  , const float* __restrict__ pscale  , bf16_t* __restrict__ mixed, lds_t lds) {
    const int tid = otid(), lane = tid & 63, wid = tid >> 6, l31 = lane & 31, hh = lane >> 5;
    const int g = e & 3, tile = e >> 2;
    const int t0 = tile * 128, s0 = t0 % S;
    lds_t xs = lds;
    lds_t ps = lds + 144 * 256;
    for (int c = tid; c < 144 * 16; c += NTHREADS) {
        const int r = c >> 4, cc = c & 15;
        u32x4 v = {0u, 0u, 0u, 0u};
        if (s0 - 16 + r >= 0) v = *(const u32x4*)(xp + (size_t)(t0 - 16 + r) * 512 + g * 128 + cc * 8);
        *(LAS u32x4*)(xs + r * 256 + cc * 16) = v;
    }
    __syncthreads();
    {
        const int cp = tid & 63, ts = tid >> 6, w = 2 << g;
        const int tl0 = ts * 16;
        float s0 = 0.f, s1 = 0.f;
        for (int j = 1; j < w; ++j) { const unsigned v = *(LAS unsigned*)(xs + (16 + tl0 - j) * 256 + cp * 4); s0 += bf_lo(v); s1 += bf_hi(v); }
        for (int tl = tl0; tl < tl0 + 16; ++tl) {
            const unsigned vn = *(LAS unsigned*)(xs + (16 + tl) * 256 + cp * 4);
            const float x0 = bf_lo(vn), x1 = bf_hi(vn);
            s0 += x0; s1 += x1;
            const int spos = (t0 % S) + tl;
            const float rc = 1.0f / (float)((spos + 1 < w) ? (spos + 1) : w);
            *(LAS unsigned*)(ps + tl * 272 + cp * 4) = pk_bf16(s0 * rc - x0, s1 * rc - x1);
            const unsigned vo = *(LAS unsigned*)(xs + (16 + tl - w + 1) * 256 + cp * 4);
            s0 -= bf_lo(vo); s1 -= bf_hi(vo);
        }
    }
    __syncthreads();
    {
        const int dt = wid & 3, tb = (wid >> 2) * 2;
        f32x16 acc[2];
#pragma unroll
        for (int a = 0; a < 2; ++a)
#pragma unroll
            for (int r = 0; r < 16; ++r) acc[a][r] = 0.f;
        const bf16_t* wg = wpool + (size_t)g * 128 * 128 + (size_t)(dt * 32 + l31) * 128 + 8 * hh;
#pragma unroll
        for (int ks = 0; ks < 8; ++ks) {
            const bf16x8 wf = *(const bf16x8*)(wg + ks * 16);
#pragma unroll
            for (int a = 0; a < 2; ++a) {
                const bf16x8 pf = *(LAS bf16x8*)(ps + ((tb + a) * 32 + l31) * 272 + (ks * 2 + hh) * 16);
                acc[a] = MFMA32(wf, pf, acc[a]);
            }
        }
#pragma unroll
        for (int a = 0; a < 2; ++a) {
            const int t = t0 + (tb + a) * 32 + l31;
#pragma unroll
            for (int rq = 0; rq < 4; ++rq) {
                const int d = dt * 32 + 8 * rq + 4 * hh;
                const f32x4 sc = *(const f32x4*)(pscale + g * 128 + d);
                u32x2 w; w.x = pk_bf16(acc[a][4 * rq] * sc[0], acc[a][4 * rq + 1] * sc[1]); w.y = pk_bf16(acc[a][4 * rq + 2] * sc[2], acc[a][4 * rq + 3] * sc[3]);
                *(u32x2*)(mixed + (size_t)t * D + g * 128 + d) = w;
            }
        }
    }
    __syncthreads();
}
__host__ __device__ __forceinline__ size_t mask_idx(int b, int tq, int tile) { return (((size_t)(b * 256 + (tq >> 5)) * 256 + tile) * 32) + (tq & 31); }
constexpr int TK_CAP = 512, TK_NE = 8, TK_TRIG = 448, TK_SOFT = 384;
constexpr int TK_FLAG = 133120;
constexpr int TK_CS = 0;
constexpr int TK_CI = 65536;
constexpr int TK_KST = 98304;
constexpr int TK_HIST = 116736;

__device__ __forceinline__ unsigned f2key(float s) { const unsigned b = __float_as_uint(s); return b ^ ((b >> 31) ? 0xffffffffu : 0x80000000u); }
__device__ __forceinline__ float key2f(unsigned k) { return __uint_as_float((k & 0x80000000u) ? (k ^ 0x80000000u) : ~k); }
__device__ __forceinline__ int bcount(bool p) { return __builtin_popcountll(__ballot(p)); }

template <int CTRL> __device__ __forceinline__ unsigned dpp_z(unsigned v) { return (unsigned)__builtin_amdgcn_update_dpp(0, (int)v, CTRL, 0xf, 0xf, true); }
__device__ __forceinline__ unsigned rdl(unsigned v, int l) { return (unsigned)__builtin_amdgcn_readlane((int)v, l); }

__device__ __forceinline__ void prune4(LAS float* cs, LAS bf16_t* ci, int (&cnt)[4], float (&tau)[2], LAS unsigned* hist, int lane, int hh) {
    unsigned key[4][TK_NE], idx[4][TK_NE];
    bool act[4];
#pragma unroll
    for (int q = 0; q < 4; ++q) {
        act[q] = cnt[q] > 256;
#pragma unroll
        for (int e = 0; e < TK_NE; ++e) {
            const int i = lane + 64 * e; const bool v = act[q] && i < cnt[q];
            const float sv_ = cs[q * TK_CAP + i]; const unsigned iv_ = ci[q * TK_CAP + i];
            key[q][e] = v ? f2key(sv_) : 0u; idx[q][e] = v ? iv_ : 0xffffu;
        }
    }
    unsigned prefix[4] = {0u, 0u, 0u, 0u}; int need[4] = {256, 256, 256, 256};
    const int row = lane >> 4;
#pragma unroll
    for (int pass = 3; pass >= 0; --pass) {
        const int sh = pass * 8;
        *(LAS u32x4*)(hist + lane * 8) = (u32x4){0u, 0u, 0u, 0u}; *(LAS u32x4*)(hist + lane * 8 + 4) = (u32x4){0u, 0u, 0u, 0u};
        lds_fence();
#pragma unroll
        for (int q = 0; q < 4; ++q)
#pragma unroll
            for (int e = 0; e < TK_NE; ++e) {
                const bool a = (key[q][e] != 0u) && (pass == 3 ? true : (((key[q][e] ^ prefix[q]) >> ((sh + 8) & 31)) == 0u));
                const unsigned b = (key[q][e] >> sh) & 255u;
                __hip_atomic_fetch_add(hist + (b >> 2) * 8 + q * 2 + ((b >> 1) & 1u), a ? (1u << (16 * (b & 1u))) : 0u, __ATOMIC_RELAXED, __HIP_MEMORY_SCOPE_WORKGROUP);
            }
        lds_fence();
        const u32x4 w0 = *(LAS u32x4*)(hist + lane * 8), w1 = *(LAS u32x4*)(hist + lane * 8 + 4);
#pragma unroll
        for (int q = 0; q < 4; ++q) {
            const unsigned wk0 = q == 0 ? w0[0] : q == 1 ? w0[2] : q == 2 ? w1[0] : w1[2], wk1 = q == 0 ? w0[1] : q == 1 ? w0[3] : q == 2 ? w1[1] : w1[3];
            const unsigned b0 = wk0 & 0xffffu, b1 = wk0 >> 16, b2 = wk1 & 0xffffu, b3 = wk1 >> 16, sb = b0 + b1 + b2 + b3;
            unsigned P = sb;
            P += dpp_z<0x111>(P); P += dpp_z<0x112>(P); P += dpp_z<0x114>(P); P += dpp_z<0x118>(P);
            const unsigned R0 = rdl(P, 15), R1 = rdl(P, 31), R2 = rdl(P, 47), R3 = rdl(P, 63);
            const unsigned Gp = P + (row > 0 ? R0 : 0u) + (row > 1 ? R1 : 0u) + (row > 2 ? R2 : 0u);
            const unsigned suf = (R0 + R1 + R2 + R3) - Gp + sb;
            const unsigned long long bm = __ballot(suf >= (unsigned)need[q]);
            const int Ls = 63 - __builtin_clzll(bm | 1ull);
            const unsigned above = rdl(suf - sb, Ls), c1 = rdl(b1, Ls), c2 = rdl(b2, Ls), c3 = rdl(b3, Ls);
            unsigned c = above; int bin;
            if (c + c3 >= (unsigned)need[q]) bin = 3;
            else { c += c3; if (c + c2 >= (unsigned)need[q]) bin = 2; else { c += c2; if (c + c1 >= (unsigned)need[q]) bin = 1; else { c += c1; bin = 0; } } }
            need[q] -= (int)c;
            prefix[q] |= (unsigned)(Ls * 4 + bin) << sh;
        }
    }
#pragma unroll
    for (int q = 0; q < 4; ++q) {
        if (act[q]) {
            int eq = 0;
#pragma unroll
            for (int e = 0; e < TK_NE; ++e) eq += bcount(key[q][e] == prefix[q]);
            unsigned ithr = 0xffffu;
            if (eq > need[q]) {
                unsigned lo = 0u;
                for (int bit = 12; bit >= 0; --bit) {
                    const unsigned mid = lo + (1u << bit);
                    int c = 0;
#pragma unroll
                    for (int e = 0; e < TK_NE; ++e) c += bcount(key[q][e] == prefix[q] && idx[q][e] < mid);
                    if (c < need[q]) lo = mid;
                }
                ithr = lo;
            }
            int base = 0;
#pragma unroll
            for (int e = 0; e < TK_NE; ++e) {
                const bool keep = (key[q][e] > prefix[q]) || (key[q][e] == prefix[q] && idx[q][e] <= ithr);
                const unsigned long long m = __ballot(keep);
                const int pos = base + (int)__builtin_amdgcn_mbcnt_hi((unsigned)(m >> 32), __builtin_amdgcn_mbcnt_lo((unsigned)m, 0u));
                if (keep) { cs[q * TK_CAP + pos] = key2f(key[q][e]); ci[q * TK_CAP + pos] = (bf16_t)idx[q][e]; }
                base += __builtin_popcountll(m);
            }
            cnt[q] = 256;
            const float nt_ = key2f(prefix[q]);
            if ((q >> 1) == hh) { if ((q & 1) == 0) tau[0] = nt_; else tau[1] = nt_; }
        }
    }
    lds_fence();
}


__device__ __forceinline__ float wave_max_f(float v) {
    v = fmaxf(v, __uint_as_float((unsigned)__builtin_amdgcn_update_dpp((int)__float_as_uint(v), (int)__float_as_uint(v), 0x111, 0xf, 0xf, false)));
    v = fmaxf(v, __uint_as_float((unsigned)__builtin_amdgcn_update_dpp((int)__float_as_uint(v), (int)__float_as_uint(v), 0x112, 0xf, 0xf, false)));
    v = fmaxf(v, __uint_as_float((unsigned)__builtin_amdgcn_update_dpp((int)__float_as_uint(v), (int)__float_as_uint(v), 0x114, 0xf, 0xf, false)));
    v = fmaxf(v, __uint_as_float((unsigned)__builtin_amdgcn_update_dpp((int)__float_as_uint(v), (int)__float_as_uint(v), 0x118, 0xf, 0xf, false)));
    const float a = __uint_as_float(rdl(__float_as_uint(v), 15)), b = __uint_as_float(rdl(__float_as_uint(v), 31)), c = __uint_as_float(rdl(__float_as_uint(v), 47)), d = __uint_as_float(rdl(__float_as_uint(v), 63));
    return fmaxf(fmaxf(a, b), fmaxf(c, d));
}
__device__ __forceinline__ void prune4_fast(LAS float* cs, LAS bf16_t* ci, int (&cnt)[4], float (&tau)[2], LAS unsigned* hist, int lane, int hh) {
    float sv[4][TK_NE]; unsigned idx[4][TK_NE]; bool val[4][TK_NE];
    float lo[4], scale[4];
#pragma unroll
    for (int q = 0; q < 4; ++q) {
        float mx = -INFINITY, mn = INFINITY;
#pragma unroll
        for (int e = 0; e < TK_NE; ++e) {
            const int i = lane + 64 * e; val[q][e] = i < cnt[q];
            sv[q][e] = cs[q * TK_CAP + i]; idx[q][e] = ci[q * TK_CAP + i];
            mx = fmaxf(mx, val[q][e] ? sv[q][e] : -INFINITY); mn = fminf(mn, val[q][e] ? sv[q][e] : INFINITY);
        }
        mx = wave_max_f(mx); mn = -wave_max_f(-mn);
        lo[q] = mn; const float d = mx - mn; scale[q] = d > 0.f ? 255.9f / d : 0.f;
    }
    *(LAS u32x4*)(hist + lane * 8) = (u32x4){0u, 0u, 0u, 0u}; *(LAS u32x4*)(hist + lane * 8 + 4) = (u32x4){0u, 0u, 0u, 0u};
    lds_fence();
    unsigned bin[4][TK_NE];
#pragma unroll
    for (int q = 0; q < 4; ++q)
#pragma unroll
        for (int e = 0; e < TK_NE; ++e) {
            int b = (int)((sv[q][e] - lo[q]) * scale[q]); b = b < 0 ? 0 : (b > 255 ? 255 : b);
            bin[q][e] = val[q][e] ? (unsigned)b : 0u;
            __hip_atomic_fetch_add(hist + (bin[q][e] >> 2) * 8 + q * 2 + ((bin[q][e] >> 1) & 1u), val[q][e] ? (1u << (16 * (bin[q][e] & 1u))) : 0u, __ATOMIC_RELAXED, __HIP_MEMORY_SCOPE_WORKGROUP);
        }
    lds_fence();
    const u32x4 w0 = *(LAS u32x4*)(hist + lane * 8), w1 = *(LAS u32x4*)(hist + lane * 8 + 4);
    const int row = lane >> 4;
    bool fail = false;
#pragma unroll
    for (int q = 0; q < 4; ++q) {
        const unsigned wk0 = q == 0 ? w0[0] : q == 1 ? w0[2] : q == 2 ? w1[0] : w1[2], wk1 = q == 0 ? w0[1] : q == 1 ? w0[3] : q == 2 ? w1[1] : w1[3];
        const unsigned b0 = wk0 & 0xffffu, b1 = wk0 >> 16, b2 = wk1 & 0xffffu, b3 = wk1 >> 16, sb = b0 + b1 + b2 + b3;
        unsigned P = sb;
        P += dpp_z<0x111>(P); P += dpp_z<0x112>(P); P += dpp_z<0x114>(P); P += dpp_z<0x118>(P);
        const unsigned R0 = rdl(P, 15), R1 = rdl(P, 31), R2 = rdl(P, 47), R3 = rdl(P, 63);
        const unsigned Gp = P + (row > 0 ? R0 : 0u) + (row > 1 ? R1 : 0u) + (row > 2 ? R2 : 0u);
        const unsigned suf = (R0 + R1 + R2 + R3) - Gp + sb;
        const unsigned long long bm = __ballot(suf >= 256u);
        const int Ls = 63 - __builtin_clzll(bm | 1ull);
        const unsigned above = rdl(suf - sb, Ls), c1 = rdl(b1, Ls), c2 = rdl(b2, Ls), c3 = rdl(b3, Ls);
        unsigned c = above; int bsel;
        if (c + c3 >= 256u) bsel = 3;
        else { c += c3; if (c + c2 >= 256u) bsel = 2; else { c += c2; if (c + c1 >= 256u) bsel = 1; else bsel = 0; } }
        const unsigned B = (unsigned)(Ls * 4 + bsel);
        if (cnt[q] > 256) {
            int base = 0; float kmin = INFINITY;
#pragma unroll
            for (int e = 0; e < TK_NE; ++e) {
                const bool keep = val[q][e] && bin[q][e] >= B;
                const unsigned long long m = __ballot(keep);
                const int pos = base + (int)__builtin_amdgcn_mbcnt_hi((unsigned)(m >> 32), __builtin_amdgcn_mbcnt_lo((unsigned)m, 0u));
                if (keep) { cs[q * TK_CAP + pos] = sv[q][e]; ci[q * TK_CAP + pos] = (bf16_t)idx[q][e]; }
                kmin = fminf(kmin, keep ? sv[q][e] : INFINITY);
                base += __builtin_popcountll(m);
            }
            kmin = -wave_max_f(-kmin);
            if (base > TK_TRIG - 64) fail = true;
            cnt[q] = base;
            const float nt_ = key2f(f2key(kmin) - 1u);
            if ((q >> 1) == hh) { if ((q & 1) == 0) tau[0] = nt_; else tau[1] = nt_; }
        }
    }
    lds_fence();
    if (fail) prune4(cs, ci, cnt, tau, hist, lane, hh);
}

template <bool EXACT>
__device__ __forceinline__ void prune4_lin(LAS float* cs, LAS bf16_t* ci, int (&cnt)[4], float (&tau)[2], LAS unsigned* hist, int lane, int hh) {
    float sv[4][TK_NE]; unsigned idx[4][TK_NE];
    float lo[4], scale[4];
#pragma unroll
    for (int q = 0; q < 4; ++q) {
        float mx = -INFINITY, mn = INFINITY;
#pragma unroll
        for (int e = 0; e < TK_NE; ++e) {
            const int i = lane + 64 * e; const bool v = i < cnt[q];
            sv[q][e] = cs[q * TK_CAP + i]; idx[q][e] = ci[q * TK_CAP + i];
            mx = fmaxf(mx, v ? sv[q][e] : -INFINITY); mn = fminf(mn, v ? sv[q][e] : INFINITY);
        }
        mx = wave_max_f(mx); mn = -wave_max_f(-mn);
        lo[q] = mn; const float d = mx - mn; scale[q] = d > 0.f ? 127.9f / d : 0.f;
    }
    { unsigned oz = 0u; asm volatile("" : "+v"(oz)); *(LAS u32x4*)(hist + lane * 8) = (u32x4){oz, oz, oz, oz}; *(LAS u32x4*)(hist + lane * 8 + 4) = (u32x4){oz, oz, oz, oz}; }
    lds_fence();
#pragma unroll
    for (int q = 0; q < 4; ++q)
#pragma unroll
        for (int e = 0; e < TK_NE; ++e) {
            const bool v = lane + 64 * e < cnt[q];
            int b = (int)((sv[q][e] - lo[q]) * scale[q]); b = b < 0 ? 0 : (b > 127 ? 127 : b);
            const unsigned bq = v ? (unsigned)b : 0u;
            idx[q][e] |= bq << 16;
            __hip_atomic_fetch_add(hist + q * 128 + bq, v ? 1u : 0u, __ATOMIC_RELAXED, __HIP_MEMORY_SCOPE_WORKGROUP);
        }
    lds_fence();
    const int row = lane >> 4, j16 = lane & 15;
    unsigned bsel, babove, bcnt;
    {
        const u32x4 w0 = *(LAS u32x4*)(hist + row * 128 + j16 * 8), w1 = *(LAS u32x4*)(hist + row * 128 + j16 * 8 + 4);
        const unsigned bb[8] = {w0[0], w0[1], w0[2], w0[3], w1[0], w1[1], w1[2], w1[3]};
        const unsigned sb = (bb[0] + bb[1]) + (bb[2] + bb[3]) + (bb[4] + bb[5]) + (bb[6] + bb[7]);
        unsigned P = sb;
        P += dpp_z<0x111>(P); P += dpp_z<0x112>(P); P += dpp_z<0x114>(P); P += dpp_z<0x118>(P);
        const unsigned R0 = rdl(P, 15), R1 = rdl(P, 31), R2 = rdl(P, 47), R3 = rdl(P, 63);
        const unsigned tot = row == 0 ? R0 : row == 1 ? R1 : row == 2 ? R2 : R3;
        const unsigned suf = tot - P + sb;
        unsigned c = suf - sb; unsigned kb = 0u, ka = c, kc = bb[0]; bool found = false;
#pragma unroll
        for (int k = 7; k >= 0; --k) { const bool hit = !found && (c + bb[k] >= 256u); kb = hit ? (unsigned)k : kb; ka = hit ? c : ka; kc = hit ? bb[k] : kc; found = found || hit; c += bb[k]; }
        const unsigned long long bm = __ballot(suf >= 256u);
        const unsigned mrow_ = (unsigned)(bm >> (16 * row)) & 0xffffu;
        const int Lq = 16 * row + (31 - __builtin_clz(mrow_ | 1u));
        bsel = (unsigned)__shfl((int)(8u * (unsigned)j16 + kb), Lq); babove = (unsigned)__shfl((int)ka, Lq); bcnt = (unsigned)__shfl((int)kc, Lq);
    }
    bool fail = false;
#pragma unroll
    for (int q = 0; q < 4; ++q) {
        const unsigned B = rdl(bsel, 16 * q), above = rdl(babove, 16 * q), mB = rdl(bcnt, 16 * q);
        if (cnt[q] > 256) {
            unsigned kst = 0u, ist = 0xffffu;
            bool qfail = false;
            if (EXACT) {
                const int need2 = 256 - (int)above;
                if (mB > 64u) qfail = true;
                else if ((int)mB > need2) {
                    LAS unsigned* L = hist;
                    int base = 0;
#pragma unroll
                    for (int e = 0; e < TK_NE; ++e) {
                        const bool inb = (lane + 64 * e < cnt[q]) && (idx[q][e] >> 16) == B;
                        const unsigned long long m = __ballot(inb);
                        if (inb) { const int pos = base + (int)__builtin_amdgcn_mbcnt_hi((unsigned)(m >> 32), __builtin_amdgcn_mbcnt_lo((unsigned)m, 0u)); L[pos] = f2key(sv[q][e]); L[64 + pos] = idx[q][e] & 0xffffu; }
                        base += __builtin_popcountll(m);
                    }
                    lds_fence();
                    const unsigned myk = L[lane], myi = L[64 + lane];
                    int rank = 0;
                    for (int t = 0; t < (int)mB; ++t) { const unsigned ok = L[t], oi = L[64 + t]; rank += (ok > myk || (ok == myk && oi < myi)) ? 1 : 0; }
                    const unsigned long long hit = __ballot(lane < (int)mB && rank == need2 - 1);
                    const int src = __builtin_ctzll(hit | (1ull << 63));
                    kst = rdl(myk, src); ist = rdl(myi, src);
                    lds_fence();
                }
            }
            if (qfail) { fail = true; }
            else {
                int base = 0;
#pragma unroll
                for (int e = 0; e < TK_NE; ++e) {
                    const bool v = lane + 64 * e < cnt[q];
                    const unsigned be = idx[q][e] >> 16, ie = idx[q][e] & 0xffffu;
                    bool keep = v && be >= B;
                    if (EXACT) { const unsigned k = f2key(sv[q][e]); keep = v && (be > B || (be == B && (k > kst || (k == kst && ie <= ist)))); }
                    const unsigned long long m = __ballot(keep);
                    const int pos = base + (int)__builtin_amdgcn_mbcnt_hi((unsigned)(m >> 32), __builtin_amdgcn_mbcnt_lo((unsigned)m, 0u));
                    if (keep) { cs[q * TK_CAP + pos] = sv[q][e]; ci[q * TK_CAP + pos] = (bf16_t)ie; }
                    base += __builtin_popcountll(m);
                }
                if (!EXACT && base > TK_TRIG - 64) fail = true;
                cnt[q] = base;
                const float nt_ = EXACT ? key2f(kst) : (lo[q] + ((float)B - 1.0f) * (scale[q] > 0.f ? 1.0f / scale[q] : 0.f));
                if ((q >> 1) == hh) { if ((q & 1) == 0) tau[0] = nt_; else tau[1] = nt_; }
            }
        }
    }
    lds_fence();
    if (fail) prune4(cs, ci, cnt, tau, hist, lane, hh);
}

template <int VAR>
__device__ __forceinline__ void topk_item(int e, const bf16_t* __restrict__ QI, const bf16_t* __restrict__ KI, const float* __restrict__ WI, unsigned* __restrict__ MASK, lds_t lds) {
    const int tid = otid(), lane = tid & 63, wid = tid >> 6, l31 = lane & 31, hh = lane >> 5;
    const int r8 = e >> 8, c = e & 255, b = c & 7, j = c >> 3;
    const int qb = (r8 < 4) ? (j + 32 * r8) : (255 - (j + 32 * (r8 - 4)));
    const int t0 = qb * 32, tq0 = t0 + 4 * wid;
    const size_t tokb = (size_t)b * S;
    bf16x8 qf[4];
    {
        const int i = l31, qi_ = 2 * ((i >> 2) & 1) + (i >> 4), hd = (i & 3) + 4 * ((i >> 3) & 1);
        const bf16_t* qp = QI + (tokb + tq0 + qi_) * 512 + hd * 64 + 8 * hh;
#pragma unroll
        for (int ks = 0; ks < 4; ++ks) qf[ks] = *(const bf16x8*)(qp + ks * 16);
    }
    float wv[2][8];
#pragma unroll
    for (int a = 0; a < 2; ++a) {
        const f32x4 w0 = *(const f32x4*)(WI + (tokb + tq0 + 2 * hh + a) * 8), w1 = *(const f32x4*)(WI + (tokb + tq0 + 2 * hh + a) * 8 + 4);
#pragma unroll
        for (int q = 0; q < 4; ++q) { wv[a][q] = w0[q]; wv[a][4 + q] = w1[q]; }
    }
    float tau[2] = {-INFINITY, -INFINITY};
    int cnt[4] = {0, 0, 0, 0};
    LAS float* cs = (LAS float*)(lds + TK_CS) + (wid * 4) * TK_CAP;
    LAS bf16_t* ci = (LAS bf16_t*)(lds + TK_CI) + (wid * 4) * TK_CAP;
    LAS unsigned* hist = (LAS unsigned*)(lds + TK_HIST) + wid * 512;
    volatile LAS unsigned* flag = (volatile LAS unsigned*)(lds + TK_FLAG);
    if (tid < 3) flag[tid] = 0u;
    const int ntiles = qb + 1, nch = (ntiles + 1) >> 1;
    const int srow = tid >> 3, scc = tid & 7;
    const bf16_t* kg = KI + (tokb + srow) * 64 + scc * 8;
    u32x4 kr = *(const u32x4*)kg, kr2 = kr, kr3 = kr;
    if (1 < nch) kr2 = *(const u32x4*)(kg + (size_t)1 * 64 * 64);
    if (2 < nch) kr3 = *(const u32x4*)(kg + (size_t)2 * 64 * 64);
    *(LAS u32x4*)(lds + TK_KST + srow * GROW + scc * 16) = kr;
    kr = kr2; kr2 = kr3;
    __syncthreads();
    for (int ch = 0; ch < nch; ++ch) {
        if (ch + 3 < nch) kr3 = *(const u32x4*)(kg + (size_t)(ch + 3) * 64 * 64);
        const lds_t kb = lds + TK_KST + (ch & 1) * (64 * GROW);
        {
            f32x16 acc[2];
#pragma unroll
            for (int tl = 0; tl < 2; ++tl)
#pragma unroll
                for (int r = 0; r < 16; ++r) acc[tl][r] = 0.f;
            bf16x8 kf[2][4];
#pragma unroll
            for (int tl = 0; tl < 2; ++tl)
#pragma unroll
                for (int ks = 0; ks < 4; ++ks) kf[tl][ks] = *(LAS bf16x8*)(kb + (tl * 32 + l31) * GROW + (ks * 2 + hh) * 16);
            __builtin_amdgcn_sched_barrier(0);
#pragma unroll
            for (int ks = 0; ks < 4; ++ks)
#pragma unroll
                for (int tl = 0; tl < 2; ++tl) acc[tl] = MFMA32(qf[ks], kf[tl][ks], acc[tl]);
            float sc[2][2];
#pragma unroll
            for (int tl = 0; tl < 2; ++tl)
#pragma unroll
                for (int a = 0; a < 2; ++a) {
                    float sv = 0.f;
#pragma unroll
                    for (int h = 0; h < 8; ++h) sv = fmaf(wv[a][h], __int_as_float(max(__float_as_int(acc[tl][8 * a + h]), 0)), sv);
                    sc[tl][a] = sv;
                }
            const int key0 = ch * 64 + l31;
#pragma unroll
            for (int a = 0; a < 2; ++a) {
                const int tq = tq0 + 2 * hh + a;
                const bool p0 = (sc[0][a] > tau[a]) && (key0 <= tq), p1 = (sc[1][a] > tau[a]) && (key0 + 32 <= tq);
                const unsigned long long m0 = __ballot(p0), m1 = __ballot(p1);
                if ((m0 | m1) != 0ull) {
                    const unsigned m0h = hh ? (unsigned)(m0 >> 32) : (unsigned)m0;
                    const int p0i = hh ? (int)__builtin_amdgcn_mbcnt_hi((unsigned)(m0 >> 32), 0u) : (int)__builtin_amdgcn_mbcnt_lo((unsigned)m0, 0u);
                    const int p1i = hh ? (int)__builtin_amdgcn_mbcnt_hi((unsigned)(m1 >> 32), 0u) : (int)__builtin_amdgcn_mbcnt_lo((unsigned)m1, 0u);
                    const int bc = (hh ? cnt[2 + a] : cnt[a]) + (2 * hh + a) * TK_CAP;
                    if (VAR == 0 || VAR == 3) {
                        if (p0) { cs[bc + p0i] = sc[0][a]; ci[bc + p0i] = (bf16_t)key0; }
                        if (p1) { const int pos = bc + __builtin_popcount(m0h) + p1i; cs[pos] = sc[1][a]; ci[pos] = (bf16_t)(key0 + 32); }
                    } else if (VAR == 2 || VAR == 4) {
                        const int qo = (2 * hh + a) * TK_CAP, rel = (hh ? cnt[2 + a] : cnt[a]);
                        if (p0) { const int pp = qo + ((rel + p0i) % TK_CAP); cs[pp] = sc[0][a]; ci[pp] = (bf16_t)key0; }
                        if (p1) { const int pp = qo + ((rel + __builtin_popcount(m0h) + p1i) % TK_CAP); cs[pp] = sc[1][a]; ci[pp] = (bf16_t)(key0 + 32); }
                    }
                    cnt[a] += __builtin_popcount((unsigned)m0) + __builtin_popcount((unsigned)m1);
                    cnt[2 + a] += __builtin_popcount((unsigned)(m0 >> 32)) + __builtin_popcount((unsigned)(m1 >> 32));
                }
            }
            if (VAR == 0 || VAR == 3) { if (cnt[0] > TK_SOFT || cnt[1] > TK_SOFT || cnt[2] > TK_SOFT || cnt[3] > TK_SOFT) { if (lane == 0) flag[ch % 3] = 1u; } }
        }
        if (ch + 1 < nch) *(LAS u32x4*)(lds + TK_KST + ((ch + 1) & 1) * (64 * GROW) + srow * GROW + scc * 16) = kr;
        kr = kr2; kr2 = kr3;
        if (tid == 0) flag[(ch + 1) % 3] = 0u;
        __syncthreads();
        if (VAR == 0 || VAR == 3) { if (flag[ch % 3] != 0u) { prune4_lin<false>(cs, ci, cnt, tau, hist, lane, hh); } }
    }
    if (VAR == 1 || VAR == 2 || VAR == 3) { if (lane == 0) MASK[(tokb + tq0) * 256] = (unsigned)(cnt[0] + cnt[1] + cnt[2] + cnt[3]); __syncthreads(); return; }
    if (VAR == 4) {
#pragma unroll
        for (int q = 0; q < 4; ++q) cnt[q] = cnt[q] > TK_CAP ? TK_CAP : cnt[q];
    }
    lds_fence();
    prune4_lin<true>(cs, ci, cnt, tau, hist, lane, hh);
    LAS unsigned* mrow = hist;
    LAS unsigned* stg = (LAS unsigned*)(lds + TK_CS);
    __syncthreads();
#pragma unroll
    for (int q = 0; q < 4; ++q) {
        { unsigned oz = 0u; asm volatile("" : "+v"(oz)); *(LAS u32x4*)(mrow + lane * 4) = (u32x4){oz, oz, oz, oz}; }
        lds_fence();
#pragma unroll
        for (int e8 = 0; e8 < 8; ++e8) {
            const int i = lane + 64 * e8;
            if (i < cnt[q]) { const unsigned ix = ci[q * TK_CAP + i]; __hip_atomic_fetch_or(mrow + (ix >> 5), 1u << (ix & 31u), __ATOMIC_RELAXED, __HIP_MEMORY_SCOPE_WORKGROUP); }
        }
        lds_fence();
#pragma unroll
        for (int k = 0; k < 4; ++k) stg[(lane + 64 * k) * 33 + 4 * wid + q] = mrow[lane + 64 * k];
        lds_fence();
    }
    __syncthreads();
    {
        unsigned* mo = MASK + mask_idx(b, t0, 0);
#pragma unroll
        for (int k = 0; k < 16; ++k) { const int idx = tid + 512 * k; mo[idx] = stg[(idx >> 5) * 33 + (idx & 31)]; }
    }
    __syncthreads();
}

constexpr int AT_STAGE = 2 * 64 * GROW;

__device__ __forceinline__ void attn_qk(f32x16 (&sacc)[2], const bf16x8 (&qf)[4], lds_t sb, int kap, int hh) {
#pragma unroll
    for (int kt = 0; kt < 2; ++kt)
#pragma unroll
        for (int r = 0; r < 16; ++r) sacc[kt][r] = 0.f;
#pragma unroll
    for (int ks = 0; ks < 4; ++ks)
#pragma unroll
        for (int kt = 0; kt < 2; ++kt) {
            const bf16x8 kf = *(LAS bf16x8*)(sb + (kt * 32 + kap) * GROW + (ks * 2 + hh) * 16);
            sacc[kt] = MFMA32(kf, qf[ks], sacc[kt]);
        }
}
template <int VAR>
__device__ __forceinline__ void attn_item(int e, const bf16_t* __restrict__ Q, const bf16_t* __restrict__ K, const bf16_t* __restrict__ VT, const unsigned* __restrict__ MASK, bf16_t* __restrict__ mixed, lds_t lds) {
    const int tid = otid(), lane = tid & 63, wid = tid >> 6, l31 = lane & 31, hh = lane >> 5;
    const int r8 = e >> 8, c = e & 255, pr = (c & 7) * 8 + (c >> 5), b = pr >> 3, head = pr & 7, jj = (c >> 3) & 3;
    const int qb = (r8 < 4) ? (jj + 4 * r8) : (31 - (jj + 4 * (r8 - 4)));
    const size_t tokb = (size_t)b * S;
    const int tq = qb * 256 + 32 * wid + l31;
    const size_t tok = tokb + tq;
    bf16x8 qf[4];
#pragma unroll
    for (int ks = 0; ks < 4; ++ks) qf[ks] = *(const bf16x8*)(Q + tok * 512 + head * 64 + ks * 16 + 8 * hh);
    const int nchb = (qb + 1) * 4, nchw = qb * 4 + (wid >> 1) + 1;
    f32x16 O[2];
#pragma unroll
    for (int a = 0; a < 2; ++a)
#pragma unroll
        for (int r = 0; r < 16; ++r) O[a][r] = 0.f;
    float mrun = -1e30f, lrun = 0.f;
    const float L2E = 1.4426950408889634f;
    const int srow = tid >> 3, scc = tid & 7;
    const bf16_t* kg = K + (tokb + srow) * 512 + head * 64 + scc * 8;
    const bf16_t* vg = VT + ((size_t)(b * 8 + head) * 64 + srow) * S + scc * 8;
    const unsigned* mg = MASK + mask_idx(b, tq, 0);
    const int kap = (l31 & 0x13) | ((l31 & 4) << 1) | ((l31 & 8) >> 1);
    u32x4 kr = *(const u32x4*)kg, vr = *(const u32x4*)vg, kr2, vr2;
    kr2 = *(const u32x4*)(kg + (size_t)1 * 64 * 512); vr2 = *(const u32x4*)(vg + 1 * 64);
    *(LAS u32x4*)(lds + srow * GROW + scc * 16) = kr;
    *(LAS u32x4*)(lds + 64 * GROW + srow * GROW + scc * 16) = vr;
    *(LAS u32x4*)(lds + AT_STAGE + srow * GROW + scc * 16) = kr2;
    *(LAS u32x4*)(lds + AT_STAGE + 64 * GROW + srow * GROW + scc * 16) = vr2;
    kr = *(const u32x4*)(kg + (size_t)2 * 64 * 512); vr = *(const u32x4*)(vg + 2 * 64);
    u32x2 mwn = (u32x2){mg[0], mg[32]};
    __syncthreads();
    f32x16 scur[2];
    if (VAR != 2 && VAR < 3) attn_qk(scur, qf, lds, kap, hh);
    else {
#pragma unroll
        for (int kt = 0; kt < 2; ++kt)
#pragma unroll
            for (int r = 0; r < 16; ++r) scur[kt][r] = (float)(r + l31) * 0.01f;
    }
    for (int ch = 0; ch < nchb; ++ch) {
        if (ch + 3 < nchb && VAR != 4) { kr2 = *(const u32x4*)(kg + (size_t)(ch + 3) * 64 * 512); vr2 = *(const u32x4*)(vg + (ch + 3) * 64); }
        const lds_t sb = lds + (ch % 3) * AT_STAGE;
        if (ch < nchw) {
            const u32x2 mw = mwn;
            if (ch + 1 < nchw) mwn = (u32x2){mg[(ch + 1) * 64], mg[(ch + 1) * 64 + 32]};
            f32x16 snext[2];
            if (ch + 1 < nchw) { if (VAR != 2 && VAR < 3) attn_qk(snext, qf, lds + ((ch + 1) % 3) * AT_STAGE, kap, hh); else {
#pragma unroll
                for (int kt = 0; kt < 2; ++kt)
#pragma unroll
                    for (int r = 0; r < 16; ++r) snext[kt][r] = scur[kt][r] * 0.999f + 0.001f * (float)ch;
            } }
            float mt = -INFINITY;
            if (VAR != 1 && VAR < 3)
#pragma unroll
            for (int kt = 0; kt < 2; ++kt) {
                const unsigned wsh = (kt == 0 ? mw.x : mw.y) >> (8 * hh);
#pragma unroll
                for (int r = 0; r < 16; ++r) {
                    const int bit = (r & 7) + 16 * (r >> 3);
                    const unsigned msk = (unsigned)__builtin_amdgcn_sbfe((int)wsh, bit, 1);
                    const float v = __uint_as_float((__float_as_uint(scur[kt][r]) & msk) | (~msk & 0xff800000u));
                    scur[kt][r] = v; mt = fmaxf(mt, v);
                }
            }
            if (VAR != 1 && VAR < 3) mt = fmaxf(mt, __shfl_xor(mt, 32));
            const float mnew = fmaxf(mrun, mt);
            if (VAR != 1 && VAR < 3 && __ballot(mnew != mrun) != 0ull) {
                const float alpha = __builtin_amdgcn_exp2f((mrun - mnew) * L2E);
                lrun *= alpha;
#pragma unroll
                for (int a = 0; a < 2; ++a)
#pragma unroll
                    for (int r = 0; r < 16; ++r) O[a][r] *= alpha;
                mrun = mnew;
            }
            const float mb = mrun * L2E;
            bf16x8 pf[2][2];
#pragma unroll
            for (int kt = 0; kt < 2; ++kt) {
                float pv[16];
#pragma unroll
                for (int r = 0; r < 16; ++r) { if (VAR == 1 || VAR >= 3) { pv[r] = scur[kt][r] + __uint_as_float(mw.x); } else { pv[r] = __builtin_amdgcn_exp2f(fmaf(scur[kt][r], L2E, -mb)); lrun += pv[r]; } }
#pragma unroll
                for (int s2 = 0; s2 < 2; ++s2) {
                    u32x4 w; w.x = pk_bf16(pv[8 * s2], pv[8 * s2 + 1]); w.y = pk_bf16(pv[8 * s2 + 2], pv[8 * s2 + 3]); w.z = pk_bf16(pv[8 * s2 + 4], pv[8 * s2 + 5]); w.w = pk_bf16(pv[8 * s2 + 6], pv[8 * s2 + 7]);
                    pf[kt][s2] = __builtin_bit_cast(bf16x8, w);
                }
            }
#pragma unroll
            for (int dt = 0; dt < 2; ++dt)
#pragma unroll
                for (int kt = 0; kt < 2; ++kt)
#pragma unroll
                    for (int s2 = 0; s2 < 2; ++s2) {
                        if (VAR != 2 && VAR < 3) {
                            const bf16x8 vf = *(LAS bf16x8*)(sb + 64 * GROW + (dt * 32 + l31) * GROW + (kt * 32 + 16 * s2 + 8 * hh) * 2);
                            O[dt] = MFMA32(vf, pf[kt][s2], O[dt]);
                        } else { O[dt][(kt * 2 + s2) * 4] += __uint_as_float((unsigned)pf[kt][s2][0] << 16); }
                    }
            if (ch + 1 < nchw) {
#pragma unroll
                for (int kt = 0; kt < 2; ++kt) scur[kt] = snext[kt];
            }
        }
        if (ch + 2 < nchb && VAR != 4) {
            const lds_t nb = lds + ((ch + 2) % 3) * AT_STAGE;
            *(LAS u32x4*)(nb + srow * GROW + scc * 16) = kr;
            *(LAS u32x4*)(nb + 64 * GROW + srow * GROW + scc * 16) = vr;
        }
        kr = kr2; vr = vr2;
        __syncthreads();
    }
    const float ltot = lrun + __shfl_xor(lrun, 32);
    const float inv = 1.0f / ltot;
#pragma unroll
    for (int dt = 0; dt < 2; ++dt)
#pragma unroll
        for (int rq = 0; rq < 4; ++rq) {
            u32x2 w; w.x = pk_bf16(O[dt][4 * rq] * inv, O[dt][4 * rq + 1] * inv); w.y = pk_bf16(O[dt][4 * rq + 2] * inv, O[dt][4 * rq + 3] * inv);
            *(u32x2*)(mixed + tok * D + 512 + head * 64 + dt * 32 + 8 * rq + 4 * hh) = w;
        }
}

template <int N> __device__ __forceinline__ void bitonic_desc(int (&a)[N]) {
#pragma unroll
    for (int k = 2; k <= N; k <<= 1)
#pragma unroll
        for (int j = k >> 1; j > 0; j >>= 1)
#pragma unroll
            for (int i = 0; i < N; ++i) {
                const int l = i ^ j;
                if (l > i) {
                    const int hi = max(a[i], a[l]), lo = min(a[i], a[l]);
                    const bool desc = ((i & k) == 0);
                    a[i] = desc ? hi : lo; a[l] = desc ? lo : hi;
                }
            }
}
__device__ __forceinline__ void merge16(int (&a)[16], const int (&b)[16]) {
#pragma unroll
    for (int i = 0; i < 16; ++i) a[i] = max(a[i], b[15 - i]);
#pragma unroll
    for (int j = 8; j > 0; j >>= 1)
#pragma unroll
        for (int i = 0; i < 16; ++i) { const int l = i ^ j; if (l > i) { const int hi = max(a[i], a[l]), lo = min(a[i], a[l]); a[i] = hi; a[l] = lo; } }
}
__device__ __forceinline__ void merge_partner(int (&a)[16]) {
    int b[16];
#pragma unroll
    for (int i = 0; i < 16; ++i) b[i] = __shfl_xor(a[i], 32);
    merge16(a, b);
}
__device__ __forceinline__ int f2skey(float s) { const int b = (int)__float_as_uint(s); return b ^ ((b >> 31) & 0x7fffffff); }
__device__ __forceinline__ float skey2f(int k) { return __uint_as_float((unsigned)(k ^ ((k >> 31) & 0x7fffffff))); }

__device__ __forceinline__ float sel_f(bool c, float a, float b) { asm volatile("" : "+v"(a), "+v"(b)); return c ? a : b; }
__device__ __forceinline__ int sel_i(bool c, int a, int b) { asm volatile("" : "+v"(a), "+v"(b)); return c ? a : b; }
struct CandTab { int ci[64], cj[64]; };
__host__ __device__ constexpr CandTab make_cand() { CandTab t{}; int n = 0; for (int i = 0; i < 16; ++i) for (int j = 0; j < 16; ++j) if ((i + 1) * (j + 1) <= 16) { t.ci[n] = i; t.cj[n] = j; ++n; } return t; }

__device__ __forceinline__ void peersel_item(int tg, int l, const bf16_t* __restrict__ QP, const bf16_t* __restrict__ SK, unsigned* __restrict__ PIDX, float* __restrict__ PG, lds_t lds) {
    const int tid = otid(), lane = tid & 63, head = tid >> 6, l31 = lane & 31, hh = lane >> 5;
    const size_t tok = (size_t)tg * 32 + l31;
    int L[2][16];
#pragma unroll
    for (int p = 0; p < 2; ++p) {
        f32x16 acc[4];
#pragma unroll
        for (int nt = 0; nt < 4; ++nt)
#pragma unroll
            for (int r = 0; r < 16; ++r) acc[nt][r] = 0.f;
        const bf16_t* qp = QP + tok * 2048 + (head * 2 + p) * 128 + 8 * hh;
        const bf16_t* sk = SK + ((size_t)((l * 8 + head) * 2 + p) * 128 + l31) * 128 + 8 * hh;
        { int oz = 0; asm volatile("" : "+v"(oz)); sk += oz; }
#pragma unroll 2
        for (int ks = 0; ks < 8; ++ks) {
            const bf16x8 qv = *(const bf16x8*)(qp + ks * 16);
#pragma unroll
            for (int nt = 0; nt < 4; ++nt) { const bf16x8 sv = *(const bf16x8*)(sk + (size_t)nt * 32 * 128 + ks * 16); acc[nt] = MFMA32(sv, qv, acc[nt]); }
        }
#pragma unroll
        for (int nt = 0; nt < 4; ++nt) {
            int g[16];
#pragma unroll
            for (int r = 0; r < 16; ++r) { const int n0 = nt * 32 + (r & 3) + 8 * (r >> 2); g[r] = (f2skey(acc[nt][r]) & ~127) | ((127 - n0) - 4 * hh); }
            bitonic_desc<16>(g);
            if (nt == 0) {
#pragma unroll
                for (int r = 0; r < 16; ++r) L[p][r] = g[r];
            } else merge16(L[p], g);
            __builtin_amdgcn_sched_barrier(0);
        }
        merge_partner(L[p]);
        __builtin_amdgcn_sched_barrier(0);
    }
    LAS unsigned char* nl = (LAS unsigned char*)lds + (size_t)tid * 32;
#pragma unroll
    for (int i = 0; i < 16; ++i) { nl[i] = (unsigned char)(127 - (L[0][i] & 127)); nl[16 + i] = (unsigned char)(127 - (L[1][i] & 127)); }
    float va[16], vb[16];
#pragma unroll
    for (int i = 0; i < 16; ++i) { va[i] = skey2f(L[0][i] & ~127); vb[i] = skey2f(L[1][i] & ~127); }
    constexpr CandTab ct = make_cand();
    int cA[16], cB[16];
#pragma unroll
    for (int m = 0; m < 16; ++m) {
        const float s = sel_f(hh, va[ct.ci[2 * m + 1]], va[ct.ci[2 * m]]) + sel_f(hh, vb[ct.cj[2 * m + 1]], vb[ct.cj[2 * m]]);
        const int code = hh ? (ct.ci[2 * m + 1] * 16 + ct.cj[2 * m + 1]) : (ct.ci[2 * m] * 16 + ct.cj[2 * m]);
        cA[m] = (f2skey(s) & ~255) | (255 - code);
    }
#pragma unroll
    for (int m = 16; m < 32; ++m) {
        if (m < 25) {
            const float s = sel_f(hh, va[ct.ci[2 * m + 1]], va[ct.ci[2 * m]]) + sel_f(hh, vb[ct.cj[2 * m + 1]], vb[ct.cj[2 * m]]);
            const int code = hh ? (ct.ci[2 * m + 1] * 16 + ct.cj[2 * m + 1]) : (ct.ci[2 * m] * 16 + ct.cj[2 * m]);
            cB[m - 16] = (f2skey(s) & ~255) | (255 - code);
        } else cB[m - 16] = (int)0x80000000;
    }
    __builtin_amdgcn_sched_barrier(0);
    bitonic_desc<16>(cA); bitonic_desc<16>(cB);
    merge16(cA, cB);
    merge_partner(cA);
    lds_fence();
    float val[16], ex[16], sum = 0.f;
#pragma unroll
    for (int r = 0; r < 16; ++r) val[r] = skey2f(cA[r] & ~255);
#pragma unroll
    for (int r = 0; r < 16; ++r) { ex[r] = __expf(val[r] - val[0]); sum += ex[r]; }
    const float inv = 1.0f / sum;
#pragma unroll
    for (int r = 0; r < 8; ++r) {
        const int kk = sel_i(hh, cA[8 + r], cA[r]);
        const float gk = sel_f(hh, ex[8 + r], ex[r]) * inv;
        const int code = 255 - (kk & 255);
        const unsigned ia = nl[code >> 4], ib = nl[16 + (code & 15)];
        PIDX[tok * 128 + head * 16 + 8 * hh + r] = ia * 128u + ib;
        PG[tok * 128 + head * 16 + 8 * hh + r] = gk;
    }
}

__device__ __forceinline__ v6u_t ld_pack(const unsigned char* p) { const u32x2 a = *(const u32x2*)p, b = *(const u32x2*)(p + 8), c = *(const u32x2*)(p + 16); return (v6u_t){a[0], a[1], b[0], b[1], c[0], c[1]}; }
__device__ __forceinline__ void peer_gather(int l, const bf16_t* __restrict__ H, const unsigned* __restrict__ PIDX, const float* __restrict__ PG, const unsigned char* __restrict__ EU, const unsigned char* __restrict__ EV,
                                            const float* __restrict__ ES, const float* __restrict__ gate  , float* x, float* xout,
                                            const float* __restrict__ nrmw  , const float* __restrict__ nsh, const float* __restrict__ nsc  , bf16_t* hnext, float* fout) {
    const int tid = otid(), lane = tid & 63, wid = tid >> 6, g = lane >> 4, j = lane & 15, l5 = lane & 31, hf = lane >> 5;
    const int nw = gridDim.x * 8;
    const unsigned char* eu = EU + (size_t)l * NEXP * EROW;
    const unsigned char* ev = EV + (size_t)l * NEXP * EROW;
    const f32x2* es = (const f32x2*)ES + (size_t)l * NEXP;
    for (int gw = blockIdx.x * 8 + wid; gw * 32 < T; gw += nw) {
        const int b = (gw * 32) / S;
        for (int tr = 0; tr < 32; ++tr) {
            const size_t t = (size_t)gw * 32 + tr;
            unsigned hp[32];
#pragma unroll
            for (int i = 0; i < 8; ++i) {
                const u32x4 a = *(const u32x4*)(H + t * D + j * 64 + i * 8);
#pragma unroll
                for (int q = 0; q < 4; ++q) hp[4 * i + q] = a[q];
            }
            const unsigned e0 = PIDX[t * 128 + lane], e1 = PIDX[t * 128 + 64 + lane];
            const float g0 = PG[t * 128 + lane], g1 = PG[t * 128 + 64 + lane];
            float acc[32];
#pragma unroll
            for (int i = 0; i < 32; ++i) acc[i] = 0.f;
            unsigned eid_n[2]; float gt_n[2]; v6u_t un[2][2]; f32x2 sc_n[2];
#pragma unroll
            for (int h2 = 0; h2 < 2; ++h2) {
                eid_n[h2] = (unsigned)__shfl((int)e0, 4 * h2 + g); gt_n[h2] = __shfl(g0, 4 * h2 + g);
                const unsigned char* ur = eu + (size_t)eid_n[h2] * EROW + j * 48;
                un[h2][0] = ld_pack(ur); un[h2][1] = ld_pack(ur + 24);
                sc_n[h2] = es[eid_n[h2]];
            }
            for (int it = 0; it < 16; ++it) {
                unsigned eid[2]; float gt[2]; f32x2 sc[2]; v6u_t uc[2][2], vv[2][2];
#pragma unroll
                for (int h2 = 0; h2 < 2; ++h2) {
                    eid[h2] = eid_n[h2]; gt[h2] = gt_n[h2]; sc[h2] = sc_n[h2]; uc[h2][0] = un[h2][0]; uc[h2][1] = un[h2][1];
#pragma unroll
                    for (int pr = 0; pr < 2; ++pr) {
                        const unsigned va = (unsigned)__builtin_amdgcn_readlane((int)eid[h2], (2 * pr) * 16), vb = (unsigned)__builtin_amdgcn_readlane((int)eid[h2], (2 * pr + 1) * 16);
                        vv[h2][pr] = ld_pack(ev + (size_t)(hf ? vb : va) * EROW + l5 * 24);
                    }
                }
                if (it + 1 < 16) {
#pragma unroll
                    for (int h2 = 0; h2 < 2; ++h2) {
                        const int ent = (it + 1) * 8 + 4 * h2 + g;
                        eid_n[h2] = (unsigned)__shfl((int)(it + 1 < 8 ? e0 : e1), ent & 63); gt_n[h2] = __shfl(it + 1 < 8 ? g0 : g1, ent & 63);
                        const unsigned char* ur = eu + (size_t)eid_n[h2] * EROW + j * 48;
                        un[h2][0] = ld_pack(ur); un[h2][1] = ld_pack(ur + 24);
                        sc_n[h2] = es[eid_n[h2]];
                    }
                }
#pragma unroll
                for (int h2 = 0; h2 < 2; ++h2) {
                    float part = 0.f;
#pragma unroll
                    for (int pk = 0; pk < 2; ++pk) {
                        const v32f_t uf = __builtin_amdgcn_cvt_scalef32_pk32_f32_fp6(uc[h2][pk], 1.0f);
#pragma unroll
                        for (int q = 0; q < 16; ++q) part = dot2bf(pk_bf16(uf[2 * q], uf[2 * q + 1]), hp[16 * pk + q], part);
                    }
                    part += __shfl_xor(part, 1); part += __shfl_xor(part, 2); part += __shfl_xor(part, 4); part += __shfl_xor(part, 8);
                    const float a = part * sc[h2][0];
                    const float act = gt[h2] * 0.5f * a * (1.0f + erff(a * 0.70710678118654752f)) * sc[h2][1];
#pragma unroll
                    for (int pr = 0; pr < 2; ++pr) {
                        const float aa = __uint_as_float((unsigned)__builtin_amdgcn_readlane((int)__float_as_uint(act), (2 * pr) * 16));
                        const float ab = __uint_as_float((unsigned)__builtin_amdgcn_readlane((int)__float_as_uint(act), (2 * pr + 1) * 16));
                        const v32f_t vf = __builtin_amdgcn_cvt_scalef32_pk32_f32_fp6(vv[h2][pr], 1.0f);
                        const float av = hf ? ab : aa;
#pragma unroll
                        for (int q = 0; q < 32; ++q) acc[q] = fmaf(av, vf[q], acc[q]);
                    }
                }
            }
            float a16[16];
#pragma unroll
            for (int q = 0; q < 16; ++q) {
                const float lo_ = acc[q] + __shfl_xor(acc[q], 32), hi_ = acc[16 + q] + __shfl_xor(acc[16 + q], 32);
                a16[q] = sel_f(hf, hi_, lo_);
            }
            const int cb = 32 * l5 + 16 * hf;
            float* xr = x + t * D + cb; float* xw = xout + t * D + cb;
            const float* gr = gate + (size_t)b * 6144 + cb;
            f32x4 xn[4]; float ss = 0.f;
#pragma unroll
            for (int q = 0; q < 4; ++q) {
                const f32x4 xo = *(const f32x4*)(xr + 4 * q), gg4 = *(const f32x4*)(gr + 4 * q);
                f32x4 a4; a4[0] = a16[4 * q]; a4[1] = a16[4 * q + 1]; a4[2] = a16[4 * q + 2]; a4[3] = a16[4 * q + 3];
                xn[q] = xo + gg4 * a4;
                ss += xn[q][0] * xn[q][0] + xn[q][1] * xn[q][1] + xn[q][2] * xn[q][2] + xn[q][3] * xn[q][3];
            }
            ss = wave_sum(ss);
            const float rstd = rsqrtf(ss * (1.0f / D) + 1e-6f);
            int ozn = 0; asm volatile("" : "+v"(ozn));
#pragma unroll
            for (int q = 0; q < 4; ++q) {
                const f32x4 w4 = *(const f32x4*)(nrmw + cb + 4 * q + ozn);
                f32x4 y = xn[q] * rstd * w4;
                if (nsc) {
                    *(f32x4*)(xw + 4 * q) = xn[q];
                    const f32x4 c4 = *(const f32x4*)(nsc + (size_t)b * 6144 + cb + 4 * q + ozn) + 1.0f, s4 = *(const f32x4*)(nsh + (size_t)b * 6144 + cb + 4 * q + ozn);
                    y = y * c4 + s4;
                    u32x2 w; w.x = pk_bf16(y[0], y[1]); w.y = pk_bf16(y[2], y[3]);
                    *(u32x2*)(hnext + t * D + cb + 4 * q) = w;
                } else {
                    *(f32x4*)(fout + t * D + cb + 4 * q) = y;
                }
            }
        }
    }
}

__device__ __forceinline__ void peer_gather_rng(int l, const bf16_t* __restrict__ H, const unsigned* __restrict__ PIDX, const float* __restrict__ PG, const unsigned char* __restrict__ EU, const unsigned char* __restrict__ EV,
                                            const float* __restrict__ ES, const float* __restrict__ gate  , float* x, float* xout,
                                            const float* __restrict__ nrmw  , const float* __restrict__ nsh, const float* __restrict__ nsc, bf16_t* hnext, float* fout, lds_t lds, unsigned* xctr, unsigned nloc) {
    const int tid = otid(), lane = tid & 63, wid = tid >> 6, g = lane >> 4, j = lane & 15, l5 = lane & 31, hf = lane >> 5;
    const int nw = gridDim.x * 8;
    const unsigned char* eu = EU + (size_t)l * NEXP * EROW;
    const unsigned char* ev = EV + (size_t)l * NEXP * EROW;
    const f32x2* es = (const f32x2*)ES + (size_t)l * NEXP;
    for (int gw = blockIdx.x * 8 + wid; gw * 32 < T; gw += nw) {
        const int b = (gw * 32) / S;
        for (int tr = 0; tr < 32; ++tr) {
            const size_t t = (size_t)gw * 32 + tr;
            if (nloc != 0u && tid == 0) {
                __hip_atomic_fetch_add(xctr, 1u, __ATOMIC_RELAXED, __HIP_MEMORY_SCOPE_AGENT);
                const unsigned target = (unsigned)(tr + 1) * nloc;
                for (int sp = 0; sp < 20000 && __hip_atomic_load(xctr, __ATOMIC_RELAXED, __HIP_MEMORY_SCOPE_AGENT) < target; ++sp) __builtin_amdgcn_s_sleep(1);
            }
            __syncthreads();
            unsigned hp[32];
#pragma unroll
            for (int i = 0; i < 8; ++i) {
                const u32x4 a = *(const u32x4*)(H + t * D + j * 64 + i * 8);
#pragma unroll
                for (int q = 0; q < 4; ++q) hp[4 * i + q] = a[q];
            }
            unsigned e0, e1; float g0, g1;
            {
                const unsigned r0 = PIDX[t * 128 + lane], r1 = PIDX[t * 128 + 64 + lane];
                const float q0 = PG[t * 128 + lane], q1 = PG[t * 128 + 64 + lane];
                LAS unsigned* sid = (LAS unsigned*)(lds + wid * 1024); LAS float* sgt = (LAS float*)(lds + wid * 1024 + 512);
                int base = 0;
                for (int r = 0; r < 16; ++r) {
                    const bool m0 = (int)(r0 >> 10) == r, m1 = (int)(r1 >> 10) == r;
                    const unsigned long long b0 = __ballot(m0), b1 = __ballot(m1);
                    const int n0 = __builtin_popcountll(b0);
                    if (m0) { const int pos = base + (int)__builtin_amdgcn_mbcnt_hi((unsigned)(b0 >> 32), __builtin_amdgcn_mbcnt_lo((unsigned)b0, 0u)); sid[pos] = r0; sgt[pos] = q0; }
                    if (m1) { const int pos = base + n0 + (int)__builtin_amdgcn_mbcnt_hi((unsigned)(b1 >> 32), __builtin_amdgcn_mbcnt_lo((unsigned)b1, 0u)); sid[pos] = r1; sgt[pos] = q1; }
                    base += n0 + __builtin_popcountll(b1);
                }
                lds_fence();
                e0 = sid[lane]; e1 = sid[64 + lane]; g0 = sgt[lane]; g1 = sgt[64 + lane];
                lds_fence();
            }
            float acc[32];
#pragma unroll
            for (int i = 0; i < 32; ++i) acc[i] = 0.f;
            unsigned eid_n[2]; float gt_n[2]; v6u_t un[2][2]; f32x2 sc_n[2];
#pragma unroll
            for (int h2 = 0; h2 < 2; ++h2) {
                eid_n[h2] = (unsigned)__shfl((int)e0, 4 * h2 + g); gt_n[h2] = __shfl(g0, 4 * h2 + g);
                const unsigned char* ur = eu + (size_t)eid_n[h2] * EROW + j * 48;
                un[h2][0] = ld_pack(ur); un[h2][1] = ld_pack(ur + 24);
                sc_n[h2] = es[eid_n[h2]];
            }
            for (int it = 0; it < 16; ++it) {
                unsigned eid[2]; float gt[2]; f32x2 sc[2]; v6u_t uc[2][2], vv[2][2];
#pragma unroll
                for (int h2 = 0; h2 < 2; ++h2) {
                    eid[h2] = eid_n[h2]; gt[h2] = gt_n[h2]; sc[h2] = sc_n[h2]; uc[h2][0] = un[h2][0]; uc[h2][1] = un[h2][1];
#pragma unroll
                    for (int pr = 0; pr < 2; ++pr) {
                        const unsigned va = (unsigned)__builtin_amdgcn_readlane((int)eid[h2], (2 * pr) * 16), vb = (unsigned)__builtin_amdgcn_readlane((int)eid[h2], (2 * pr + 1) * 16);
                        vv[h2][pr] = ld_pack(ev + (size_t)(hf ? vb : va) * EROW + l5 * 24);
                    }
                }
                if (it + 1 < 16) {
#pragma unroll
                    for (int h2 = 0; h2 < 2; ++h2) {
                        const int ent = (it + 1) * 8 + 4 * h2 + g;
                        eid_n[h2] = (unsigned)__shfl((int)(it + 1 < 8 ? e0 : e1), ent & 63); gt_n[h2] = __shfl(it + 1 < 8 ? g0 : g1, ent & 63);
                        const unsigned char* ur = eu + (size_t)eid_n[h2] * EROW + j * 48;
                        un[h2][0] = ld_pack(ur); un[h2][1] = ld_pack(ur + 24);
                        sc_n[h2] = es[eid_n[h2]];
                    }
                }
#pragma unroll
                for (int h2 = 0; h2 < 2; ++h2) {
                    float part = 0.f;
#pragma unroll
                    for (int pk = 0; pk < 2; ++pk) {
                        const v32f_t uf = __builtin_amdgcn_cvt_scalef32_pk32_f32_fp6(uc[h2][pk], 1.0f);
#pragma unroll
                        for (int q = 0; q < 16; ++q) part = dot2bf(pk_bf16(uf[2 * q], uf[2 * q + 1]), hp[16 * pk + q], part);
                    }
                    part += __shfl_xor(part, 1); part += __shfl_xor(part, 2); part += __shfl_xor(part, 4); part += __shfl_xor(part, 8);
                    const float a = part * sc[h2][0];
                    const float act = gt[h2] * 0.5f * a * (1.0f + erff(a * 0.70710678118654752f)) * sc[h2][1];
#pragma unroll
                    for (int pr = 0; pr < 2; ++pr) {
                        const float aa = __uint_as_float((unsigned)__builtin_amdgcn_readlane((int)__float_as_uint(act), (2 * pr) * 16));
                        const float ab = __uint_as_float((unsigned)__builtin_amdgcn_readlane((int)__float_as_uint(act), (2 * pr + 1) * 16));
                        const v32f_t vf = __builtin_amdgcn_cvt_scalef32_pk32_f32_fp6(vv[h2][pr], 1.0f);
                        const float av = hf ? ab : aa;
#pragma unroll
                        for (int q = 0; q < 32; ++q) acc[q] = fmaf(av, vf[q], acc[q]);
                    }
                }
            }
            float a16[16];
#pragma unroll
            for (int q = 0; q < 16; ++q) {
                const float lo_ = acc[q] + __shfl_xor(acc[q], 32), hi_ = acc[16 + q] + __shfl_xor(acc[16 + q], 32);
                a16[q] = sel_f(hf, hi_, lo_);
            }
            const int cb = 32 * l5 + 16 * hf;
            float* xr = x + t * D + cb; float* xw = xout + t * D + cb;
            const float* gr = gate + (size_t)b * 6144 + cb;
            f32x4 xn[4]; float ss = 0.f;
#pragma unroll
            for (int q = 0; q < 4; ++q) {
                const f32x4 xo = *(const f32x4*)(xr + 4 * q), gg4 = *(const f32x4*)(gr + 4 * q);
                f32x4 a4; a4[0] = a16[4 * q]; a4[1] = a16[4 * q + 1]; a4[2] = a16[4 * q + 2]; a4[3] = a16[4 * q + 3];
                xn[q] = xo + gg4 * a4;
                ss += xn[q][0] * xn[q][0] + xn[q][1] * xn[q][1] + xn[q][2] * xn[q][2] + xn[q][3] * xn[q][3];
            }
            ss = wave_sum(ss);
            const float rstd = rsqrtf(ss * (1.0f / D) + 1e-6f);
            int ozn = 0; asm volatile("" : "+v"(ozn));
#pragma unroll
            for (int q = 0; q < 4; ++q) {
                const f32x4 w4 = *(const f32x4*)(nrmw + cb + 4 * q + ozn);
                f32x4 y = xn[q] * rstd * w4;
                if (nsc) {
                    *(f32x4*)(xw + 4 * q) = xn[q];
                    const f32x4 c4 = *(const f32x4*)(nsc + (size_t)b * 6144 + cb + 4 * q + ozn) + 1.0f, s4 = *(const f32x4*)(nsh + (size_t)b * 6144 + cb + 4 * q + ozn);
                    y = y * c4 + s4;
                    u32x2 w; w.x = pk_bf16(y[0], y[1]); w.y = pk_bf16(y[2], y[3]);
                    *(u32x2*)(hnext + t * D + cb + 4 * q) = w;
                } else {
                    *(f32x4*)(fout + t * D + cb + 4 * q) = y;
                }
            }
        }
    }
}

__global__ void __launch_bounds__(NTHREADS, 2) mega(const float* x, const float* c, const int* pos, const float* w_ada, const float* b_ada, const float* norm_mix, const float* w_in, const float* w_pool,
                                                     const float* pool_scale, const float* w_out, const float* norm_ffn, const float* w_query, const float* sub_keys, const float* expert_u, const float* expert_v,
                                                     const float* final_norm, float* out, unsigned char* wsp, int ph_lo, int ph_hi) {
    Params p; p.x = x; p.c = c; p.pos = pos; p.w_ada = w_ada; p.b_ada = b_ada; p.norm_mix = norm_mix; p.w_in = w_in; p.w_pool = w_pool; p.pool_scale = pool_scale; p.w_out = w_out; p.norm_ffn = norm_ffn;
    p.w_query = w_query; p.sub_keys = sub_keys; p.expert_u = expert_u; p.expert_v = expert_v; p.final_norm = final_norm; p.out = out; p.ws = wsp; p.ph_lo = ph_lo; p.ph_hi = ph_hi;
    __shared__ __attribute__((aligned(16))) unsigned char smem_raw[LDS_BYTES];
    lds_t lds = (lds_t)smem_raw;
    unsigned char* ws = p.ws;
    volatile LAS unsigned* st = (volatile LAS unsigned*)(lds + 147456);
    if (threadIdx.x == 0) { st[0] = 0u; st[1] = 0u; st[2] = 0u; st[3] = 0u; }
    __syncthreads();
    XcdBarrier bar = xcd_barrier_post((unsigned*)(ws + WS_CTL), st);
    const int lo = p.ph_lo, hi = p.ph_hi, G = gridDim.x, bid = blockIdx.x;
#if MK_STAMP
    unsigned long long* stamps = (unsigned long long*)(ws + 1010 * MBy) + (size_t)blockIdx.x * 64;
    if (threadIdx.x == 0) stamps[63] = wall_clock64();
#define RUN(n) ((n) >= lo && (n) < hi)
#define SEAM(n) do { if (threadIdx.x == 0) stamps[2 * (n)] = wall_clock64(); if ((n) >= lo && (n) + 1 < hi) xcd_barrier(bar); if (threadIdx.x == 0) stamps[2 * (n) + 1] = wall_clock64(); } while (0)
#else
#define RUN(n) ((n) >= lo && (n) < hi)
#if MK_DUP & 1024
#define SEAM(n) do { if ((n) >= lo && (n) + 1 < hi) { xcd_barrier(bar); xcd_barrier(bar); } } while (0)
#else
#define SEAM(n) do { if ((n) >= lo && (n) + 1 < hi) xcd_barrier(bar); } while (0)
#endif
#endif

    float* modp = (float*)(ws + WS_MOD);
    bf16_t* Hb = (bf16_t*)(ws + WS_H);

    if (RUN(0)) phase_prologue(p, lds);
#if MK_DUP & 512
    if (RUN(0)) { __syncthreads(); phase_prologue(p, lds); }
#endif
    SEAM(0);
    for (int l = 0; l < DEPTH; ++l) {
        const int pb = 1 + 9 * l;
        unsigned char* const ws0 = p.ws;
        const float* xin = (l == 0) ? p.x : p.out;
        const float* modl = modp + (size_t)l * NB * 6144;
        if (RUN(pb + 0) && l == 0) { size_t oz = 0; asm volatile("" : "+s"(oz)); unsigned char* ws = ws0 + oz;     bf16_t* Hb = (bf16_t*)(ws + WS_H); float* modp = (float*)(ws + WS_MOD); const float* modl = modp + (size_t)l * NB * 6144; phase_norm<0>(xin, p.norm_mix + (size_t)l * D, modl + 0, modl + 1024, Hb, nullptr); }
        if (l == 0 || MK_STAMP) SEAM(pb + 0);
        if (RUN(pb + 1)) { size_t oz = 0; asm volatile("" : "+s"(oz)); unsigned char* ws = ws0 + oz;     bf16_t* Hb = (bf16_t*)(ws + WS_H); float* modp = (float*)(ws + WS_MOD); const float* modl = modp + (size_t)l * NB * 6144; { }
            EpiIn ep; ep.xp = (bf16_t*)(ws + WS_XP); ep.q = (bf16_t*)(ws + WS_Q); ep.k = (bf16_t*)(ws + WS_K); ep.vt = (bf16_t*)(ws + WS_VT); ep.qi = (bf16_t*)(ws + WS_QI); ep.ki = (bf16_t*)(ws + WS_KI);
            ep.wi = (float*)(ws + WS_WI); ep.rope = (const float*)(ws + WS_ROPE);
            gemm_phase(Hb, (const bf16_t*)(ws + WS_WIN) + (size_t)l * NIN * D, NIN, ep, lds);
#if MK_DUP & 1
            { __syncthreads(); if (MK_DUPVAR == 9) gemm_phase(Hb, (const bf16_t*)(ws + WS_WIN) + (size_t)l * NIN * D, NIN, ep, lds); else { EpiNull en; en.sink = (float*)(ws + 746 * MBy); gemm_phase<MK_DUPVAR>(Hb, (const bf16_t*)(ws + WS_WIN) + (size_t)l * NIN * D, NIN, en, lds); } }
#endif
        }
        SEAM(pb + 1);
        if (RUN(pb + 2)) { size_t oz = 0; asm volatile("" : "+s"(oz)); unsigned char* ws = ws0 + oz;     bf16_t* Hb = (bf16_t*)(ws + WS_H); float* modp = (float*)(ws + WS_MOD); const float* modl = modp + (size_t)l * NB * 6144; { }
            for (int e = bid; e < 2048; e += G) topk_item<0>(e, (const bf16_t*)(ws + WS_QI), (const bf16_t*)(ws + WS_KI), (const float*)(ws + WS_WI), (unsigned*)(ws + WS_MASK), lds);
#if MK_DUP & 2
            for (int e = bid; e < 2048; e += G) topk_item<MK_DUPVAR>(e, (const bf16_t*)(ws + WS_QI), (const bf16_t*)(ws + WS_KI), (const float*)(ws + WS_WI), (unsigned*)(ws + 746 * MBy), lds);
#endif
            for (int e = bid; e < 2048; e += G) pool_item(e, (const bf16_t*)(ws + WS_XP), (const bf16_t*)(ws + WS_WPOOL) + (size_t)l * 4 * 128 * 128, p.pool_scale + (size_t)l * 512, Hb, lds);
#if MK_DUP & 4
            for (int e = bid; e < 2048; e += G) pool_item(e, (const bf16_t*)(ws + WS_XP), (const bf16_t*)(ws + WS_WPOOL) + (size_t)l * 4 * 128 * 128, p.pool_scale + (size_t)l * 512, Hb, lds);
#endif
        }
        SEAM(pb + 2);
        if (RUN(pb + 3)) { size_t oz = 0; asm volatile("" : "+s"(oz)); unsigned char* ws = ws0 + oz;     bf16_t* Hb = (bf16_t*)(ws + WS_H); float* modp = (float*)(ws + WS_MOD); const float* modl = modp + (size_t)l * NB * 6144; { }
            for (int e = bid; e < 2048; e += G) attn_item<0>(e, (const bf16_t*)(ws + WS_Q), (const bf16_t*)(ws + WS_K), (const bf16_t*)(ws + WS_VT), (const unsigned*)(ws + WS_MASK), Hb, lds);
#if MK_DUP & 8
            __syncthreads(); for (int e = bid; e < 2048; e += G) attn_item<MK_DUPVAR>(e, (const bf16_t*)(ws + WS_Q), (const bf16_t*)(ws + WS_K), (const bf16_t*)(ws + WS_VT), (const unsigned*)(ws + WS_MASK), (bf16_t*)(ws + 746 * MBy), lds);
#endif
        }
        SEAM(pb + 3);
        if (RUN(pb + 4)) { size_t oz = 0; asm volatile("" : "+s"(oz)); unsigned char* ws = ws0 + oz;     bf16_t* Hb = (bf16_t*)(ws + WS_H); float* modp = (float*)(ws + WS_MOD); const float* modl = modp + (size_t)l * NB * 6144; { }
            EpiOut ep; ep.xin = xin; ep.xout = p.out; ep.gate = modl + 2 * 1024;
            gemm_phase(Hb, (const bf16_t*)(ws + WS_WOUT) + (size_t)l * D * D, D, ep, lds);
        }
        SEAM(pb + 4);
        if (RUN(pb + 5)) { size_t oz = 0; asm volatile("" : "+s"(oz)); unsigned char* ws = ws0 + oz;     bf16_t* Hb = (bf16_t*)(ws + WS_H); float* modp = (float*)(ws + WS_MOD); const float* modl = modp + (size_t)l * NB * 6144; phase_norm<0>(p.out, p.norm_ffn + (size_t)l * D, modl + 3 * 1024, modl + 4 * 1024, Hb, nullptr);
#if MK_DUP & 256
            phase_norm<0>(p.out, p.norm_ffn + (size_t)l * D, modl + 3 * 1024, modl + 4 * 1024, Hb, nullptr);
#endif
        }
        SEAM(pb + 5);
        if (RUN(pb + 6)) { size_t oz = 0; asm volatile("" : "+s"(oz)); unsigned char* ws = ws0 + oz;     bf16_t* Hb = (bf16_t*)(ws + WS_H); float* modp = (float*)(ws + WS_MOD); const float* modl = modp + (size_t)l * NB * 6144; { }
            EpiBf ep; ep.C = (bf16_t*)(ws + WS_QP); ep.ldc = 2048;
            gemm_phase(Hb, (const bf16_t*)(ws + WS_WQ) + (size_t)l * 2048 * D, 2048, ep, lds);
#if MK_DUP & 32
            __syncthreads(); gemm_phase(Hb, (const bf16_t*)(ws + WS_WQ) + (size_t)l * 2048 * D, 2048, ep, lds);
#endif
        }
        SEAM(pb + 6);
        if (RUN(pb + 7)) { size_t oz = 0; asm volatile("" : "+s"(oz)); unsigned char* ws = ws0 + oz;     bf16_t* Hb = (bf16_t*)(ws + WS_H); float* modp = (float*)(ws + WS_MOD); const float* modl = modp + (size_t)l * NB * 6144; { }
            for (int e = bid; e < 2048; e += G) peersel_item(e, l, (const bf16_t*)(ws + WS_QP), (const bf16_t*)(ws + WS_SK), (unsigned*)(ws + WS_PIDX), (float*)(ws + WS_PG), lds);
#if MK_DUP & 64
            for (int e = bid; e < 2048; e += G) peersel_item(e, l, (const bf16_t*)(ws + WS_QP), (const bf16_t*)(ws + WS_SK), (unsigned*)(ws + WS_PIDX), (float*)(ws + WS_PG), lds);
#endif
        }
        SEAM(pb + 7);
        if (RUN(pb + 8)) { size_t oz = 0; asm volatile("" : "+s"(oz)); unsigned char* ws = ws0 + oz;     bf16_t* Hb = (bf16_t*)(ws + WS_H); float* modp = (float*)(ws + WS_MOD); const float* modl = modp + (size_t)l * NB * 6144;
#if MK_DUP & 128
            peer_gather(l, Hb, (const unsigned*)(ws + WS_PIDX), (const float*)(ws + WS_PG), (const unsigned char*)(ws + WS_EU), (const unsigned char*)(ws + WS_EV), (const float*)(ws + WS_ES), modl + 5 * 1024, p.out, (float*)(ws + 746 * MBy), p.final_norm, nullptr, nullptr, nullptr, (float*)(ws + 746 * MBy));
#endif
#if MK_GATHER_RANGE
            peer_gather_rng(l, Hb, (const unsigned*)(ws + WS_PIDX), (const float*)(ws + WS_PG), (const unsigned char*)(ws + WS_EU), (const unsigned char*)(ws + WS_EV), (const float*)(ws + WS_ES), modl + 5 * 1024, p.out, p.out,
                        l + 1 < DEPTH ? p.norm_mix + (size_t)(l + 1) * D : p.final_norm, l + 1 < DEPTH ? modp + (size_t)(l + 1) * NB * 6144 : nullptr, l + 1 < DEPTH ? modp + (size_t)(l + 1) * NB * 6144 + 1024 : nullptr, Hb, p.out, lds, (unsigned*)(ws + WS_CTL + 49152) + (bar.x * 2 + l) * 64, 0u  ); }
#else
            peer_gather(l, Hb, (const unsigned*)(ws + WS_PIDX), (const float*)(ws + WS_PG), (const unsigned char*)(ws + WS_EU), (const unsigned char*)(ws + WS_EV), (const float*)(ws + WS_ES), modl + 5 * 1024, p.out, p.out,
                        l + 1 < DEPTH ? p.norm_mix + (size_t)(l + 1) * D : p.final_norm, l + 1 < DEPTH ? modp + (size_t)(l + 1) * NB * 6144 : nullptr, l + 1 < DEPTH ? modp + (size_t)(l + 1) * NB * 6144 + 1024 : nullptr, Hb, p.out); }
#endif
        if (l + 1 < DEPTH) SEAM(pb + 8);
    }
#if MK_STAMP
    {
        if (threadIdx.x == 0) stamps[2 * 18] = wall_clock64();
        xcd_barrier(bar);
        LAS unsigned long long* red = (LAS unsigned long long*)lds;
        const int P = MK_STAMP_PH;
        if (threadIdx.x < 256 && (int)threadIdx.x < (int)gridDim.x) {
            const unsigned long long* sb = (const unsigned long long*)(ws + 1010 * MBy) + (size_t)threadIdx.x * 64;
            red[threadIdx.x] = (P == 0) ? sb[63] : sb[2 * (P - 1) + 1];
            red[256 + threadIdx.x] = sb[2 * P];
        }
        __syncthreads();
        unsigned long long mn = ~0ull, mx = 0ull;
        const int nb = (int)gridDim.x < 256 ? (int)gridDim.x : 256;
        for (int i = 0; i < nb; ++i) { mn = red[i] < mn ? red[i] : mn; mx = red[256 + i] > mx ? red[256 + i] : mx; }
        const float E = (float)(mx - mn) * 1e-3f;
        const size_t n = (size_t)T * D, stride = (size_t)gridDim.x * NTHREADS;
        for (size_t i = (size_t)blockIdx.x * NTHREADS + threadIdx.x; i < n; i += stride) p.out[i] = E;
    }
#endif
#undef RUN
#undef SEAM
}


#ifndef MK_CHECK
#define MK_CHECK 0
#endif
#ifndef MK_CHECK_LAYER
#define MK_CHECK_LAYER 0
#endif
#ifndef MK_CHECK_SLOT0
#define MK_CHECK_SLOT0 4
#endif
#if MK_CHECK
__device__ __forceinline__ unsigned hash32(unsigned x) { x ^= x >> 16; x *= 0x7feb352dU; x ^= x >> 15; x *= 0x846ca68bU; x ^= x >> 16; return x; }
__device__ __forceinline__ float bfv(const bf16_t* p, size_t i) { return __uint_as_float((unsigned)p[i] << 16); }
__device__ __forceinline__ bool badrel(float got, float ref, float rtol, float atol) { return !(fabsf(got - ref) <= atol + rtol * fabsf(ref)); }
#define DIAG(p) ((unsigned*)((p).ws + WS_CTL + 32768))
constexpr size_t WS_XCOPY = 746 * MBy;

__global__ void chk_mod(Params p) {
    const unsigned id = blockIdx.x * blockDim.x + threadIdx.x;
    const unsigned h = hash32(id * 3u + 1u);
    const int l = h & 1, b = (h >> 1) & 7, j = (h >> 4) % 6144;
    float s = 0.f;
    for (int k = 0; k < D; ++k) { const float c = p.c[b * D + k]; s += (c / (1.f + expf(-c))) * p.w_ada[((size_t)l * D + k) * 6144 + j]; }
    s += p.b_ada[l * 6144 + j];
    const float got = ((const float*)(p.ws + WS_MOD))[((size_t)l * NB + b) * 6144 + j];
    if (badrel(got, s, 1e-3f, 1e-4f)) atomicAdd(DIAG(p) + 0, 1u);
}
__global__ void chk_norm(Params p, int l, int which, const float* xin, int slot) {
    const unsigned id = blockIdx.x * blockDim.x + threadIdx.x;
    const unsigned h = hash32(id * 7u + 3u);
    const int t = h % T, b = t / S;
    const float* xr = xin + (size_t)t * D;
    float ss = 0.f; for (int k = 0; k < D; ++k) ss += xr[k] * xr[k];
    const float rstd = 1.0f / sqrtf(ss / D + 1e-6f);
    const float* modl = (const float*)(p.ws + WS_MOD) + ((size_t)l * NB + b) * 6144;
    const float* gw = (which ? p.norm_ffn : p.norm_mix) + (size_t)l * D;
    const float* sh = modl + (which ? 3 : 0) * 1024; const float* sc = modl + (which ? 4 : 1) * 1024;
    const bf16_t* hb = (const bf16_t*)(p.ws + WS_H);
    for (int q = 0; q < 4; ++q) {
        const int n = hash32(h + q) % D;
        const float ref = xr[n] * rstd * gw[n] * (1.f + sc[n]) + sh[n];
        if (badrel(bfv(hb, (size_t)t * D + n), ref, 1e-2f, 1e-2f)) atomicAdd(DIAG(p) + slot, 1u);
    }
}
__device__ float dot_h_w(const bf16_t* hrow, const float* w, int ldw, int n) { float s = 0.f; for (int k = 0; k < D; ++k) s += bfv(hrow, k) * w[(size_t)k * ldw + n]; return s; }
__global__ void chk_in(Params p, int l) {
    const unsigned id = blockIdx.x * blockDim.x + threadIdx.x;
    const unsigned h = hash32(id * 11u + 5u);
    const int t = h % T; const int n = hash32(h) % DIN;
    const bf16_t* hrow = (const bf16_t*)(p.ws + WS_H) + (size_t)t * D;
    const float* w = p.w_in + (size_t)l * D * DIN;
    const float* rope = (const float*)(p.ws + WS_ROPE) + (size_t)t * 16;
    const int b = t / S, s = t % S;
    float ref, got; int slot = 2;
    auto roped = [&](int base, int d) -> float {
        if (d >= 16) return dot_h_w(hrow, w, DIN, base + d);
        const int f = d & 7; const float x1 = dot_h_w(hrow, w, DIN, base + f), x2 = dot_h_w(hrow, w, DIN, base + 8 + f);
        return d < 8 ? x1 * rope[f] - x2 * rope[8 + f] : x1 * rope[8 + f] + x2 * rope[f];
    };
    if (n < 512) { ref = dot_h_w(hrow, w, DIN, n); got = bfv((const bf16_t*)(p.ws + WS_XP), (size_t)t * 512 + n); }
    else if (n < 1024) { const int c = n - 512; ref = roped(512 + (c & ~63), c & 63) * 0.125f; got = bfv((const bf16_t*)(p.ws + WS_Q), (size_t)t * 512 + c); }
    else if (n < 1536) { const int c = n - 1024; ref = roped(1024 + (c & ~63), c & 63); got = bfv((const bf16_t*)(p.ws + WS_K), (size_t)t * 512 + c); }
    else if (n < 2048) { const int c = n - 1536; ref = dot_h_w(hrow, w, DIN, n); got = bfv((const bf16_t*)(p.ws + WS_VT), ((size_t)(b * 8 + (c >> 6)) * 64 + (c & 63)) * S + s); }
    else if (n < 2560) { const int c = n - 2048; ref = roped(2048 + (c & ~63), c & 63) * 0.125f; got = bfv((const bf16_t*)(p.ws + WS_QI), (size_t)t * 512 + c); }
    else if (n < 2624) { const int c = n - 2560; ref = roped(2560, c); got = bfv((const bf16_t*)(p.ws + WS_KI), (size_t)t * 64 + c); }
    else { const int c = n - 2624; ref = dot_h_w(hrow, w, DIN, n) * 0.35355339f; got = ((const float*)(p.ws + WS_WI))[(size_t)t * 8 + c]; }
    if (badrel(got, ref, 2e-2f, 3e-2f)) atomicAdd(DIAG(p) + slot, 1u);
}
__global__ void chk_pool(Params p, int l) {
    const unsigned id = blockIdx.x * blockDim.x + threadIdx.x;
    const unsigned h = hash32(id * 13u + 7u);
    const int t = h % T, s = t % S; const int n = hash32(h) % 512, g = n >> 7, d = n & 127, w = 2 << g;
    const bf16_t* xp = (const bf16_t*)(p.ws + WS_XP);
    float ref = 0.f;
    for (int c = 0; c < 128; ++c) {
        float sum = 0.f; int cnt = 0;
        for (int jj = 0; jj < w; ++jj) if (s - jj >= 0) { sum += bfv(xp, (size_t)(t - jj) * 512 + g * 128 + c); ++cnt; }
        const float pooled = sum / (float)cnt - bfv(xp, (size_t)t * 512 + g * 128 + c);
        ref += pooled * p.w_pool[(((size_t)l * 4 + g) * 128 + c) * 128 + d];
    }
    ref *= p.pool_scale[l * 512 + n];
    if (badrel(bfv((const bf16_t*)(p.ws + WS_H), (size_t)t * D + n), ref, 3e-2f, 3e-2f)) atomicAdd(DIAG(p) + 3, 1u);
}
__global__ void __launch_bounds__(512) chk_topk(Params p) {
    __shared__ float sc[S];
    __shared__ int nbad;
    const unsigned h = hash32(blockIdx.x * 17u + 9u);
    const int b = h & 7; int tq = (h >> 3) % S; if (blockIdx.x < 8) tq = blockIdx.x * 40;
    const size_t tokb = (size_t)b * S;
    const bf16_t* QI = (const bf16_t*)(p.ws + WS_QI); const bf16_t* KI = (const bf16_t*)(p.ws + WS_KI); const float* WI = (const float*)(p.ws + WS_WI);
    if (threadIdx.x == 0) nbad = 0;
    for (int s = threadIdx.x; s <= tq; s += 512) {
        float tot = 0.f;
        for (int hd = 0; hd < 8; ++hd) { float dsum = 0.f; for (int d = 0; d < 64; ++d) dsum += bfv(QI, (tokb + tq) * 512 + hd * 64 + d) * bfv(KI, (tokb + s) * 64 + d); tot += WI[(tokb + tq) * 8 + hd] * fmaxf(dsum, 0.f); }
        sc[s] = tot;
    }
    __syncthreads();
    int bad = 0;
    for (int s = threadIdx.x; s < S; s += 512) {
        bool sel = false;
        if (s <= tq) { const float v = sc[s]; int rank = 0; for (int s2 = 0; s2 <= tq; ++s2) { const float v2 = sc[s2]; rank += (v2 > v || (v2 == v && s2 < s)) ? 1 : 0; } sel = rank < 256; }
        const unsigned wmask = ((const unsigned*)(p.ws + WS_MASK))[mask_idx(b, tq, s >> 5)];
        if (((wmask >> (s & 31)) & 1u) != (sel ? 1u : 0u)) ++bad;
    }
    atomicAdd(&nbad, bad);
    __syncthreads();
    if (threadIdx.x == 0 && nbad > 6) atomicAdd(DIAG(p) + 4, 1u);
}
__global__ void chk_attn(Params p) {
    const unsigned id = blockIdx.x * blockDim.x + threadIdx.x;
    const unsigned h = hash32(id * 19u + 11u);
    const int t = h % T, b = t / S, tq = t % S, head = (h >> 20) & 7, d = (h >> 24) & 63;
    const size_t tokb = (size_t)b * S;
    const bf16_t* Q = (const bf16_t*)(p.ws + WS_Q); const bf16_t* K = (const bf16_t*)(p.ws + WS_K); const bf16_t* VT = (const bf16_t*)(p.ws + WS_VT);
    const unsigned* M = (const unsigned*)(p.ws + WS_MASK);
    float mx = -1e30f;
    for (int s = 0; s <= tq; ++s) if ((M[mask_idx(b, tq, s >> 5)] >> (s & 31)) & 1u) { float lg = 0.f; for (int e = 0; e < 64; ++e) lg += bfv(Q, (size_t)t * 512 + head * 64 + e) * bfv(K, (tokb + s) * 512 + head * 64 + e); mx = fmaxf(mx, lg); }
    float den = 0.f, num = 0.f;
    for (int s = 0; s <= tq; ++s) if ((M[mask_idx(b, tq, s >> 5)] >> (s & 31)) & 1u) { float lg = 0.f; for (int e = 0; e < 64; ++e) lg += bfv(Q, (size_t)t * 512 + head * 64 + e) * bfv(K, (tokb + s) * 512 + head * 64 + e); const float pe = expf(lg - mx); den += pe; num += pe * bfv(VT, ((size_t)(b * 8 + head) * 64 + d) * S + s); }
    const float ref = num / den;
    if (badrel(bfv((const bf16_t*)(p.ws + WS_H), (size_t)t * D + 512 + head * 64 + d), ref, 3e-2f, 1e-2f)) atomicAdd(DIAG(p) + 5, 1u);
}
__global__ void chk_out(Params p, int l, const float* xin) {
    const unsigned id = blockIdx.x * blockDim.x + threadIdx.x;
    const unsigned h = hash32(id * 23u + 13u);
    const int t = h % T, b = t / S, n = hash32(h) % D;
    const bf16_t* mrow = (const bf16_t*)(p.ws + WS_H) + (size_t)t * D;
    float s = 0.f; for (int k = 0; k < D; ++k) s += bfv(mrow, k) * p.w_out[((size_t)l * D + k) * D + n];
    const float g1 = ((const float*)(p.ws + WS_MOD))[((size_t)l * NB + b) * 6144 + 2048 + n];
    const float ref = xin[(size_t)t * D + n] + g1 * s;
    if (badrel(p.out[(size_t)t * D + n], ref, 1e-2f, 1e-2f)) atomicAdd(DIAG(p) + 6, 1u);
}
__global__ void chk_q(Params p, int l) {
    const unsigned id = blockIdx.x * blockDim.x + threadIdx.x;
    const unsigned h = hash32(id * 29u + 17u);
    const int t = h % T, n = hash32(h) % 2048;
    const bf16_t* hrow = (const bf16_t*)(p.ws + WS_H) + (size_t)t * D;
    const float ref = dot_h_w(hrow, p.w_query + (size_t)l * D * 2048, 2048, n);
    if (badrel(bfv((const bf16_t*)(p.ws + WS_QP), (size_t)t * 2048 + n), ref, 2e-2f, 3e-2f)) atomicAdd(DIAG(p) + 8, 1u);
}
__global__ void __launch_bounds__(64) chk_sel(Params p, int l) {
    __shared__ float tv[2][16][64]; __shared__ int ti[2][16][64]; __shared__ float cv[16][64]; __shared__ int cid[16][64];
    const int x = threadIdx.x;
    const unsigned id = blockIdx.x * blockDim.x + threadIdx.x;
    const unsigned h = hash32(id * 31u + 19u);
    const int t = h % T, head = (h >> 20) & 7;
    const bf16_t* QP = (const bf16_t*)(p.ws + WS_QP);
    for (int pp = 0; pp < 2; ++pp) {
        for (int i = 0; i < 16; ++i) { tv[pp][i][x] = -1e30f; ti[pp][i][x] = -1; }
        for (int n = 0; n < 128; ++n) {
            float s = 0.f; for (int d = 0; d < 128; ++d) s += bfv(QP, (size_t)t * 2048 + (head * 2 + pp) * 128 + d) * p.sub_keys[((((size_t)l * 8 + head) * 2 + pp) * 128 + n) * 128 + d];
            int pos = 16; for (int i = 15; i >= 0; --i) if (s > tv[pp][i][x]) pos = i;
            for (int i = 15; i > pos; --i) { tv[pp][i][x] = tv[pp][i - 1][x]; ti[pp][i][x] = ti[pp][i - 1][x]; }
            if (pos < 16) { tv[pp][pos][x] = s; ti[pp][pos][x] = n; }
        }
    }
    for (int i = 0; i < 16; ++i) { cv[i][x] = -1e30f; cid[i][x] = -1; }
    for (int i = 0; i < 16; ++i) for (int j = 0; j < 16; ++j) {
        const float s = tv[0][i][x] + tv[1][j][x];
        int pos = 16; for (int q = 15; q >= 0; --q) if (s > cv[q][x]) pos = q;
        for (int q = 15; q > pos; --q) { cv[q][x] = cv[q - 1][x]; cid[q][x] = cid[q - 1][x]; }
        if (pos < 16) { cv[pos][x] = s; cid[pos][x] = ti[0][i][x] * 128 + ti[1][j][x]; }
    }
    float den = 0.f; for (int i = 0; i < 16; ++i) den += expf(cv[i][x] - cv[0][x]);
    const unsigned* PI = (const unsigned*)(p.ws + WS_PIDX) + (size_t)t * 128 + head * 16; const float* PGp = (const float*)(p.ws + WS_PG) + (size_t)t * 128 + head * 16;
    int miss = 0;
    for (int i = 0; i < 16; ++i) {
        const float g = expf(cv[i][x] - cv[0][x]) / den; bool found = false;
        for (int q = 0; q < 16; ++q) if ((int)PI[q] == cid[i][x]) { found = true; if (badrel(PGp[q], g, 5e-2f, 2e-3f)) ++miss; }
        if (!found) ++miss;
    }
    if (miss > 2) atomicAdd(DIAG(p) + 9, 1u);
}
__global__ void chk_gather(Params p, int l) {
    const unsigned id = blockIdx.x * blockDim.x + threadIdx.x;
    const unsigned h = hash32(id * 37u + 23u);
    const int t = h % T, b = t / S, n = hash32(h) % D;
    const bf16_t* hrow = (const bf16_t*)(p.ws + WS_H) + (size_t)t * D;
    const unsigned* PI = (const unsigned*)(p.ws + WS_PIDX) + (size_t)t * 128; const float* PGp = (const float*)(p.ws + WS_PG) + (size_t)t * 128;
    float o = 0.f;
    for (int e = 0; e < 128; ++e) {
        const size_t ex = (size_t)l * NEXP + PI[e];
        float a = 0.f; for (int k = 0; k < D; ++k) a += bfv(hrow, k) * p.expert_u[ex * D + k];
        const float act = PGp[e] * 0.5f * a * (1.f + erff(a * 0.70710678f));
        o += act * p.expert_v[ex * D + n];
    }
    const float g2 = ((const float*)(p.ws + WS_MOD))[((size_t)l * NB + b) * 6144 + 5 * 1024 + n];
    const float ref = ((const float*)(p.ws + WS_XCOPY))[(size_t)t * D + n] + g2 * o;
    if (badrel(p.out[(size_t)t * D + n], ref, 1e-2f, 1e-2f)) atomicAdd(DIAG(p) + 10, 1u);
}
__global__ void chk_fill(Params p, int s0) {
    const unsigned* dg = DIAG(p);
    const unsigned total[11] = {4096, 4096, 4096, 4096, 64, 1024, 4096, 4096, 4096, 1024, 512};
    float E = 0.f;
    for (int i = 0; i < 5; ++i) { const int sl = s0 + i; if (sl < 11 && dg[sl] * 50u > total[sl]) E += (float)(1 << i); }
    const size_t n = (size_t)T * D, stride = (size_t)gridDim.x * blockDim.x;
    for (size_t i = (size_t)blockIdx.x * blockDim.x + threadIdx.x; i < n; i += stride) p.out[i] = E;
}
#endif

#ifndef MK_FP6TEST
#define MK_FP6TEST 0
#endif
#if MK_FP6TEST
__global__ void fp6_test(float* out, unsigned* scratch) {
    const int t = threadIdx.x;
    v16f_t a, b;
#pragma unroll
    for (int i = 0; i < 16; ++i) { a[i] = (float)(i - 16) * 0.25f; b[i] = (float)i * 0.25f; }
    const v6u_t e1 = __builtin_amdgcn_cvt_scalef32_2xpk16_fp6_f32(a, b, 1.0f);
    const v32f_t d1 = __builtin_amdgcn_cvt_scalef32_pk32_f32_fp6(e1, 1.0f);
    bool ok_order = true, ok_inter = true;
#pragma unroll
    for (int i = 0; i < 16; ++i) { ok_order = ok_order && d1[i] == a[i] && d1[16 + i] == b[i]; ok_inter = ok_inter && d1[2 * i] == a[i] && d1[2 * i + 1] == b[i]; }
    const v32f_t d2 = __builtin_amdgcn_cvt_scalef32_pk32_f32_fp6(e1, 2.0f);
    bool dec_mul = true, dec_div = true;
#pragma unroll
    for (int i = 0; i < 32; ++i) { dec_mul = dec_mul && d2[i] == 2.0f * d1[i]; dec_div = dec_div && d2[i] == 0.5f * d1[i]; }
    v16f_t a2, b2;
#pragma unroll
    for (int i = 0; i < 16; ++i) { a2[i] = a[i] * 0.5f; b2[i] = b[i] * 0.5f; }
    const v6u_t e2 = __builtin_amdgcn_cvt_scalef32_2xpk16_fp6_f32(a2, b2, 0.5f);
    const v6u_t e3 = __builtin_amdgcn_cvt_scalef32_2xpk16_fp6_f32(a2, b2, 2.0f);
    bool enc_div = true, enc_mul = true;
#pragma unroll
    for (int i = 0; i < 6; ++i) { enc_div = enc_div && e2[i] == e1[i]; enc_mul = enc_mul && e3[i] == e1[i]; }
    const bool low0 = ((e1[0] & 63u) == 0x30u  );
    float E = 0.f;
    E += ok_order ? 1.f : 0.f; E += ok_inter ? 2.f : 0.f; E += dec_mul ? 4.f : 0.f; E += dec_div ? 8.f : 0.f; E += enc_div ? 16.f : 0.f; E += enc_mul ? 32.f : 0.f; E += low0 ? 64.f : 0.f;
    const size_t n = (size_t)T * D, stride = (size_t)gridDim.x * blockDim.x;
    for (size_t i = (size_t)blockIdx.x * blockDim.x + t; i < n; i += stride) out[i] = E;
    (void)scratch;
}
#endif

#ifndef MK_TRUNC
#define MK_TRUNC 0
#endif
#if MK_TRUNC
__global__ void __launch_bounds__(256) dump_kernel(Params p, int which) {
    unsigned char* ws = p.ws;
    const size_t n = (size_t)T * D, stride = (size_t)gridDim.x * 256;
    for (size_t i = (size_t)blockIdx.x * 256 + threadIdx.x; i < n; i += stride) {
        const size_t t = i / D; const int c = (int)(i % D);
        float v = 0.f;
        if (which == 2) {
            const bf16_t* xp = (const bf16_t*)(ws + WS_XP); const bf16_t* q = (const bf16_t*)(ws + WS_Q); const bf16_t* k = (const bf16_t*)(ws + WS_K); const bf16_t* vt = (const bf16_t*)(ws + WS_VT);
            const bf16_t* qi = (const bf16_t*)(ws + WS_QI); const bf16_t* ki = (const bf16_t*)(ws + WS_KI); const float* wi = (const float*)(ws + WS_WI);
            const int cc = c & 511;
            v = bf_lo(xp[t * 512 + cc]) + bf_lo(q[t * 512 + cc]) + bf_lo(k[t * 512 + cc]) + bf_lo(vt[t * 512 + cc]) + bf_lo(qi[t * 512 + cc]) + bf_lo(ki[t * 64 + (cc & 63)]) + wi[t * 8 + (cc & 7)];
        } else if (which == 3) {
            const unsigned* m = (const unsigned*)(ws + WS_MASK); const bf16_t* hb = (const bf16_t*)(ws + WS_H);
            v = (float)(m[t * 256 + (c & 255)] & 0xffffu) + (float)(m[t * 256 + (c & 255)] >> 16) + bf_lo(hb[t * D + (c & 511)]);
        } else if (which == 4) {
            const bf16_t* hb = (const bf16_t*)(ws + WS_H); v = bf_lo(hb[t * D + c]);
        } else if (which == 7) {
            const bf16_t* qp = (const bf16_t*)(ws + WS_QP); v = bf_lo(qp[t * 2048 + c]) + bf_lo(qp[t * 2048 + 1024 + c]);
        } else if (which == 8) {
            const unsigned* pi = (const unsigned*)(ws + WS_PIDX); const float* pg = (const float*)(ws + WS_PG);
            v = (float)pi[t * 128 + (c & 127)] + pg[t * 128 + (c & 127)];
        }
        p.out[i] = v;
    }
}
#endif

extern "C" void kernel_launch(void* const* d_in, const int* in_sizes, int n_in, void* d_out, int out_size, void* d_ws, size_t ws_size, hipStream_t stream) {
    static int grid = 0;
    if (grid == 0) {
        if (n_in != 16 || out_size != T * D || ws_size < WS_END) { fprintf(stderr, "kernel_launch: unexpected shapes (n_in %d, out %d, ws %zu)\n", n_in, out_size, ws_size); grid = -1; return; }
        int dev = 0, cus = 0, per_cu = 0;
        if (hipGetDevice(&dev) != hipSuccess || hipDeviceGetAttribute(&cus, hipDeviceAttributeMultiprocessorCount, dev) != hipSuccess) { grid = -1; return; }
        if (hipOccupancyMaxActiveBlocksPerMultiprocessor(&per_cu, (const void*)mega, NTHREADS, 0) != hipSuccess || per_cu < 1) fprintf(stderr, "kernel_launch: occupancy query says %d\n", per_cu);
        (void)hipGetLastError();
        grid = cus;
    }
    if (grid < 0) return;
    (void)hipMemsetAsync((char*)d_ws + WS_CTL, 0, 64 * 1024, stream);
#ifdef MK_DBG_CLEAR
    (void)hipMemsetAsync((char*)d_ws, 0, WS_END, stream); (void)hipMemsetAsync(d_out, 0, (size_t)T * D * 4, stream);
#endif
    Params p{};
    p.x = (const float*)d_in[0]; p.c = (const float*)d_in[1]; p.pos = (const int*)d_in[2];
    p.w_ada = (const float*)d_in[3]; p.b_ada = (const float*)d_in[4]; p.norm_mix = (const float*)d_in[5]; p.w_in = (const float*)d_in[6]; p.w_pool = (const float*)d_in[7];
    p.pool_scale = (const float*)d_in[8]; p.w_out = (const float*)d_in[9]; p.norm_ffn = (const float*)d_in[10]; p.w_query = (const float*)d_in[11]; p.sub_keys = (const float*)d_in[12];
    p.expert_u = (const float*)d_in[13]; p.expert_v = (const float*)d_in[14]; p.final_norm = (const float*)d_in[15];
    p.out = (float*)d_out; p.ws = (unsigned char*)d_ws;
#if MK_FP6TEST
    hipLaunchKernelGGL(fp6_test, dim3(1024), dim3(256), 0, stream, (float*)d_out, (unsigned*)d_ws);
#elif MK_CHECK
    {
        auto run = [&](int ph) { p.ph_lo = ph; p.ph_hi = ph + 1; hipLaunchKernelGGL(mega, dim3(grid), dim3(NTHREADS), 0, stream, p.x, p.c, p.pos, p.w_ada, p.b_ada, p.norm_mix, p.w_in, p.w_pool, p.pool_scale, p.w_out, p.norm_ffn, p.w_query, p.sub_keys, p.expert_u, p.expert_v, p.final_norm, p.out, p.ws, p.ph_lo, p.ph_hi); };
        const int L = MK_CHECK_LAYER; const int pb = 1 + 9 * L;
        for (int ph = 0; ph < pb; ++ph) run(ph);
        const float* xin = (L == 0) ? p.x : p.out;
        hipLaunchKernelGGL(chk_mod, dim3(16), dim3(256), 0, stream, p);
        run(pb + 0); hipLaunchKernelGGL(chk_norm, dim3(4), dim3(256), 0, stream, p, L, 0, xin, 1);
        run(pb + 1); hipLaunchKernelGGL(chk_in, dim3(16), dim3(256), 0, stream, p, L);
        run(pb + 2); hipLaunchKernelGGL(chk_pool, dim3(16), dim3(256), 0, stream, p, L); hipLaunchKernelGGL(chk_topk, dim3(64), dim3(512), 0, stream, p);
        run(pb + 3); hipLaunchKernelGGL(chk_attn, dim3(4), dim3(256), 0, stream, p);
        if (L == 1) (void)hipMemcpyAsync((char*)d_ws + WS_XCOPY, d_out, (size_t)T * D * 4, hipMemcpyDeviceToDevice, stream);
        run(pb + 4); hipLaunchKernelGGL(chk_out, dim3(16), dim3(256), 0, stream, p, L, (L == 0) ? p.x : (const float*)((char*)d_ws + WS_XCOPY));
        run(pb + 5); hipLaunchKernelGGL(chk_norm, dim3(4), dim3(256), 0, stream, p, L, 1, (const float*)p.out, 7);
        run(pb + 6); hipLaunchKernelGGL(chk_q, dim3(16), dim3(256), 0, stream, p, L);
        run(pb + 7); hipLaunchKernelGGL(chk_sel, dim3(16), dim3(64), 0, stream, p, L);
        (void)hipMemcpyAsync((char*)d_ws + WS_XCOPY, d_out, (size_t)T * D * 4, hipMemcpyDeviceToDevice, stream);
        run(pb + 8); hipLaunchKernelGGL(chk_gather, dim3(2), dim3(256), 0, stream, p, L);
        hipLaunchKernelGGL(chk_fill, dim3(2048), dim3(256), 0, stream, p, (int)MK_CHECK_SLOT0);
    }
#elif MK_TRUNC
    for (int ph = 0; ph <= MK_TRUNC; ++ph) { p.ph_lo = ph; p.ph_hi = ph + 1; hipLaunchKernelGGL(mega, dim3(grid), dim3(NTHREADS), 0, stream, p.x, p.c, p.pos, p.w_ada, p.b_ada, p.norm_mix, p.w_in, p.w_pool, p.pool_scale, p.w_out, p.norm_ffn, p.w_query, p.sub_keys, p.expert_u, p.expert_v, p.final_norm, p.out, p.ws, p.ph_lo, p.ph_hi); }
    if (MK_TRUNC != 5 && MK_TRUNC != 9) hipLaunchKernelGGL(dump_kernel, dim3(2048), dim3(256), 0, stream, p, (int)MK_TRUNC);
#elif MK_MULTI
    for (int ph = 0; ph < NPH; ++ph) { p.ph_lo = ph; p.ph_hi = ph + 1; hipLaunchKernelGGL(mega, dim3(grid), dim3(NTHREADS), 0, stream, p.x, p.c, p.pos, p.w_ada, p.b_ada, p.norm_mix, p.w_in, p.w_pool, p.pool_scale, p.w_out, p.norm_ffn, p.w_query, p.sub_keys, p.expert_u, p.expert_v, p.final_norm, p.out, p.ws, p.ph_lo, p.ph_hi); }
#else
    p.ph_lo = 0; p.ph_hi = NPH;
    hipLaunchKernelGGL(mega, dim3(grid), dim3(NTHREADS), 0, stream, p.x, p.c, p.pos, p.w_ada, p.b_ada, p.norm_mix, p.w_in, p.w_pool, p.pool_scale, p.w_out, p.norm_ffn, p.w_query, p.sub_keys, p.expert_u, p.expert_v, p.final_norm, p.out, p.ws, p.ph_lo, p.ph_hi);
#endif
    const hipError_t le = hipPeekAtLastError();
    if (le != hipSuccess) fprintf(stderr, "kernel_launch: launch failed: %s\n", hipGetErrorName(le));
}
```
